# Optimizing an MI355X kernel written in HIP

```python
import jax, jax.numpy as jnp
from jax import lax
import numpy as np


D_MODEL = 1024
BATCH = 8
SEQ = 2048
DEPTH = 2

MLA_HEADS = 8
MLA_NOPE = 64
MLA_ROPE = 32
MLA_V = 64
Q_LORA = 384
KV_LORA = 256
ROPE_BASE = 10000.0
DSA_HEADS = 8
DSA_DIM = 64
IDX_HEADS = 8
IDX_DIM = 32
TOPK_MAX = 256
D_MIX = MLA_HEADS * MLA_V + DSA_HEADS * DSA_DIM
N_EXPERTS = 16
N_GROUPS = 4
EXPERTS_PER_GROUP = N_EXPERTS // N_GROUPS
TOP_K_EXPERTS = 2
GROUP_SCORE_K = 2
D_FF_EXPERT = 512
ALPHA = (2.0 * DEPTH) ** 0.25
BETA = (8.0 * DEPTH) ** -0.25
Q_BLOCK = 128
LN_EPS = 1e-5
RMS_EPS = 1e-6

SPLIT_SIZES = (Q_LORA, KV_LORA, MLA_ROPE, DSA_HEADS * DSA_DIM, DSA_DIM, DSA_DIM,
               IDX_HEADS * IDX_DIM, IDX_DIM, IDX_HEADS)
SPLIT_POINTS = tuple(int(v) for v in np.cumsum(SPLIT_SIZES)[:-1])
IN_COLS = int(sum(SPLIT_SIZES))
DSA_V_START = int(sum(SPLIT_SIZES[:5]))

kernel_name = 'hybrid_mla_dsa_grouped_moe_deepnorm'


def layer_norm(x, g, b):
    xf = x.astype(jnp.float32)
    mu = jnp.mean(xf, axis=-1, keepdims=True)
    var = jnp.mean(jnp.square(xf - mu), axis=-1, keepdims=True)
    y = (xf - mu) * lax.rsqrt(var + LN_EPS) * g.astype(jnp.float32) + b.astype(jnp.float32)
    return y.astype(x.dtype)


def rms_norm(x, g):
    xf = x.astype(jnp.float32)
    y = xf * lax.rsqrt(jnp.mean(jnp.square(xf), axis=-1, keepdims=True) + RMS_EPS)
    return (y * g.astype(jnp.float32)).astype(x.dtype)


def rope(x, pos):
    half = x.shape[-1] // 2
    inv = ROPE_BASE ** (-jnp.arange(half, dtype=jnp.float32) / half)
    ang = pos[:, None] * inv[None, :]
    cos = jnp.cos(ang)[None, :, None, :]
    sin = jnp.sin(ang)[None, :, None, :]
    xf = x.astype(jnp.float32)
    x1, x2 = xf[..., :half], xf[..., half:]
    return jnp.concatenate([x1 * cos - x2 * sin, x1 * sin + x2 * cos], axis=-1).astype(x.dtype)


def sweep_query_blocks(block_fn, seq_len):
    starts = jnp.arange(seq_len // Q_BLOCK, dtype=jnp.int32) * Q_BLOCK
    out = lax.map(block_fn, starts)
    nb, b, qb, h, d = out.shape
    return jnp.transpose(out, (1, 0, 2, 3, 4)).reshape(b, nb * qb, h * d)


def mla_group(qa, kva, kr, q_norm_g, w_q_up, kv_norm_g, w_uk, w_uv, pos):
    B, T, _ = qa.shape
    q = (rms_norm(qa, q_norm_g) @ w_q_up).reshape(B, T, MLA_HEADS, MLA_NOPE + MLA_ROPE)
    q = jnp.concatenate([q[..., :MLA_NOPE], rope(q[..., MLA_NOPE:], pos)], axis=-1)
    c_kv = rms_norm(kva, kv_norm_g)
    k_nope = (c_kv @ w_uk).reshape(B, T, MLA_HEADS, MLA_NOPE)
    v = (c_kv @ w_uv).reshape(B, T, MLA_HEADS, MLA_V)
    k_rope = rope(kr[:, :, None, :], pos)
    k = jnp.concatenate([k_nope, jnp.broadcast_to(k_rope, (B, T, MLA_HEADS, MLA_ROPE))], axis=-1)
    scale = (MLA_NOPE + MLA_ROPE) ** -0.5
    key_idx = jnp.arange(T, dtype=jnp.int32)

    def block(start):
        qb = lax.dynamic_slice_in_dim(q, start, Q_BLOCK, axis=1)
        s = jnp.einsum('bthd,bshd->bhts', qb, k).astype(jnp.float32) * scale
        tq = start + jnp.arange(Q_BLOCK, dtype=jnp.int32)
        s = jnp.where(key_idx[None, :] <= tq[:, None], s, -jnp.inf)
        p = jax.nn.softmax(s, axis=-1).astype(v.dtype)
        return jnp.einsum('bhts,bshd->bthd', p, v)

    return sweep_query_blocks(block, T)


def dsa_group(dq, dk, dv, iq, ik, iw, slopes, n_keep):
    B, T, _ = dq.shape
    q = dq.reshape(B, T, DSA_HEADS, DSA_DIM)
    iq = iq.reshape(B, T, IDX_HEADS, IDX_DIM)
    iw = iw * (IDX_HEADS ** -0.5)
    key_idx = jnp.arange(T, dtype=jnp.int32)
    scale = DSA_DIM ** -0.5
    gather = jax.vmap(lambda arr, idx: arr[idx])

    def block(start):
        qb = lax.dynamic_slice_in_dim(q, start, Q_BLOCK, axis=1)
        iqb = lax.dynamic_slice_in_dim(iq, start, Q_BLOCK, axis=1)
        iwb = lax.dynamic_slice_in_dim(iw, start, Q_BLOCK, axis=1)
        tq = start + jnp.arange(Q_BLOCK, dtype=jnp.int32)
        rel = jax.nn.relu(jnp.einsum('bthd,bsd->bths', iqb, ik) * (IDX_DIM ** -0.5))
        score = jnp.einsum('bths,bth->bts', rel, iwb).astype(jnp.float32)
        score = jnp.where(key_idx[None, None, :] <= tq[None, :, None], score, -jnp.inf)
        _, sel = lax.top_k(score, n_keep)
        k_sel = gather(dk, sel)
        v_sel = gather(dv, sel)
        dist = (tq[None, :, None] - sel).astype(jnp.float32)
        s = jnp.einsum('bthd,btkd->bhtk', qb, k_sel).astype(jnp.float32) * scale
        s = s - slopes[None, :, None, None] * dist[:, None, :, :]
        s = jnp.where((dist >= 0.0)[:, None, :, :], s, -jnp.inf)
        p = jax.nn.softmax(s, axis=-1).astype(v_sel.dtype)
        return jnp.einsum('bhtk,btkd->bthd', p, v_sel)

    return sweep_query_blocks(block, T)


def hybrid_mixer(h, w_in, q_norm_g, w_q_up, kv_norm_g, w_uk, w_uv, w_o, pos, slopes, n_keep):
    proj = h @ w_in
    qa, kva, kr, dq, dk, dv, iq, ik, iw = jnp.split(proj, SPLIT_POINTS, axis=-1)
    out_a = mla_group(qa, kva, kr, q_norm_g, w_q_up, kv_norm_g, w_uk, w_uv, pos)
    out_b = dsa_group(dq, dk, dv, iq, ik, iw, slopes, n_keep)
    return jnp.concatenate([out_a, out_b], axis=-1) @ w_o


def grouped_moe(h, router_w, router_bias, w_gate, w_up, w_down):
    B, T, D = h.shape
    xt = h.reshape(B * T, D)
    aff = jax.nn.sigmoid((xt @ router_w).astype(jnp.float32))
    biased = aff + router_bias.astype(jnp.float32)
    grouped = biased.reshape(-1, N_GROUPS, EXPERTS_PER_GROUP)
    group_score = jnp.sum(lax.top_k(grouped, GROUP_SCORE_K)[0], axis=-1)
    g_sel = jnp.argmax(group_score, axis=-1)
    in_group = (jnp.arange(N_EXPERTS) // EXPERTS_PER_GROUP)[None, :] == g_sel[:, None]
    _, e_idx = lax.top_k(jnp.where(in_group, biased, -jnp.inf), TOP_K_EXPERTS)
    wts = jnp.take_along_axis(aff, e_idx, axis=-1)
    wts = wts / jnp.sum(wts, axis=-1, keepdims=True)
    gates = jnp.sum(jax.nn.one_hot(e_idx, N_EXPERTS, dtype=jnp.float32) * wts[..., None], axis=1)
    hg = jnp.einsum('nd,edf->nef', xt, w_gate)
    hu = jnp.einsum('nd,edf->nef', xt, w_up)
    act = jax.nn.silu(hg) * hu * gates[:, :, None].astype(hg.dtype)
    out = jnp.einsum('nef,efd->nd', act, w_down)
    return out.reshape(B, T, D)


def setup_inputs(seed: int = 0) -> dict:
    key = jax.random.key(seed)
    ks = jax.random.split(key, 20)
    f32 = jnp.float32
    nrm = lambda k, shape, s: jax.random.normal(k, shape, f32) * s
    col_scale = np.ones((IN_COLS,), np.float32)
    col_scale[DSA_V_START:DSA_V_START + DSA_DIM] = BETA
    w_in = nrm(ks[1], (DEPTH, D_MODEL, IN_COLS), D_MODEL ** -0.5) * jnp.asarray(col_scale)
    return {
        'x': jax.random.normal(ks[0], (BATCH, SEQ, D_MODEL), f32),
        'w_in': w_in,
        'q_norm_g': 1.0 + nrm(ks[2], (DEPTH, Q_LORA), 0.02),
        'w_q_up': nrm(ks[3], (DEPTH, Q_LORA, MLA_HEADS * (MLA_NOPE + MLA_ROPE)), Q_LORA ** -0.5),
        'kv_norm_g': 1.0 + nrm(ks[4], (DEPTH, KV_LORA), 0.02),
        'w_uk': nrm(ks[5], (DEPTH, KV_LORA, MLA_HEADS * MLA_NOPE), KV_LORA ** -0.5),
        'w_uv': nrm(ks[6], (DEPTH, KV_LORA, MLA_HEADS * MLA_V), BETA * KV_LORA ** -0.5),
        'w_o': nrm(ks[7], (DEPTH, D_MIX, D_MODEL), BETA * D_MIX ** -0.5),
        'ln1_g': 1.0 + nrm(ks[8], (DEPTH, D_MODEL), 0.02),
        'ln1_b': nrm(ks[9], (DEPTH, D_MODEL), 0.02),
        'router_w': nrm(ks[10], (D_MODEL, N_EXPERTS), D_MODEL ** -0.5),
        'router_bias': nrm(ks[11], (N_EXPERTS,), 0.01),
        'w_gate': nrm(ks[12], (DEPTH, N_EXPERTS, D_MODEL, D_FF_EXPERT), BETA * D_MODEL ** -0.5),
        'w_up': nrm(ks[13], (DEPTH, N_EXPERTS, D_MODEL, D_FF_EXPERT), BETA * D_MODEL ** -0.5),
        'w_down': nrm(ks[14], (DEPTH, N_EXPERTS, D_FF_EXPERT, D_MODEL), BETA * D_FF_EXPERT ** -0.5),
        'ln2_g': 1.0 + nrm(ks[15], (DEPTH, D_MODEL), 0.02),
        'ln2_b': nrm(ks[16], (DEPTH, D_MODEL), 0.02),
    }


def reference(x, w_in, q_norm_g, w_q_up, kv_norm_g, w_uk, w_uv, w_o, ln1_g, ln1_b,
              router_w, router_bias, w_gate, w_up, w_down, ln2_g, ln2_b):
    T = x.shape[1]
    pos = jnp.arange(T, dtype=jnp.float32)
    n_keep = min(TOPK_MAX, T // 4)
    slopes = 2.0 ** (-8.0 * jnp.arange(1, DSA_HEADS + 1, dtype=jnp.float32) / DSA_HEADS)
    for l in range(DEPTH):
        mix = hybrid_mixer(x, w_in[l], q_norm_g[l], w_q_up[l], kv_norm_g[l], w_uk[l], w_uv[l],
                           w_o[l], pos, slopes, n_keep)
        x = layer_norm(ALPHA * x + mix, ln1_g[l], ln1_b[l])
        ffn = grouped_moe(x, router_w, router_bias, w_gate[l], w_up[l], w_down[l])
        x = layer_norm(ALPHA * x + ffn, ln2_g[l], ln2_b[l])
    return x
```

```cpp
#include <hip/hip_runtime.h>
#include <hip/hip_cooperative_groups.h>
#include <cstdio>
#include <cstdint>
namespace cg = cooperative_groups;

#define LAS __attribute__((address_space(3)))
typedef unsigned short bf16_t;
typedef short bf16x8 __attribute__((ext_vector_type(8)));
typedef short s16x4 __attribute__((ext_vector_type(4)));
typedef float f32x2 __attribute__((ext_vector_type(2)));
typedef float f32x4 __attribute__((ext_vector_type(4)));
typedef float f32x16 __attribute__((ext_vector_type(16)));
typedef unsigned u32x2 __attribute__((ext_vector_type(2)));
typedef unsigned u32x4 __attribute__((ext_vector_type(4)));
typedef __bf16 bf16x2_t __attribute__((ext_vector_type(2)));

constexpr int DM = 1024, NBATCH = 8, SEQ = 2048, M = NBATCH * SEQ, DEPTH = 2;
constexpr int NPROJ = 1792;
constexpr int IN_COLS = 1608;
constexpr int C_QA = 0, C_KVA = 384, C_KR = 640, C_DQ = 672, C_DK = 1184, C_DV = 1248, C_IQ = 1312, C_IK = 1568, C_IW = 1600;
constexpr int NEXP = 16, DFF = 512;
constexpr float ALPHA = 1.4142135623730951f;
constexpr float LN_EPS = 1e-5f, RMS_EPS = 1e-6f;
constexpr float LOG2E = 1.4426950408889634f;
constexpr float MLA_QSCALE = 0.10206207261596575f * LOG2E;
constexpr float DSA_QSCALE = 0.125f * LOG2E;
constexpr int NTHREADS = 512, NWAVES = 8;
constexpr int LDS_BYTES = 147456;
constexpr int RING_BYTES = 131072;
constexpr int MISC_OFF = RING_BYTES;

constexpr size_t MiB = 1u << 20;
constexpr size_t WS_CTL   = 0;
constexpr size_t WS_BAR   = 65536;
constexpr size_t WS_ELIST = 1 * MiB;
constexpr size_t WS_GATE  = 3 * MiB;
constexpr size_t WS_ROPE  = 3 * MiB + 512 * 1024;
constexpr size_t WS_MASK  = 4 * MiB;
constexpr size_t WS_WIN   = 8 * MiB;
constexpr size_t WS_WQUP  = 15 * MiB;
constexpr size_t WS_WKV   = 17 * MiB;
constexpr size_t WS_WO    = 18 * MiB;
constexpr size_t WS_WGU   = 22 * MiB;
constexpr size_t WS_WD    = 54 * MiB;
constexpr size_t WS_R1    = 70 * MiB;
constexpr size_t WS_R2    = 134 * MiB;
constexpr size_t WS_R3    = 166 * MiB;
constexpr size_t WS_R4    = 198 * MiB;
constexpr size_t WS_R5    = 230 * MiB;
constexpr size_t WS_END   = 262 * MiB;
constexpr size_t WS_PROJ = WS_R1, WS_MIX = WS_R1, WS_X1B = WS_R3, WS_Y = WS_R1;
constexpr size_t WS_XB = WS_R5, WS_Q = WS_R2, WS_KR = WS_R2 + 24 * MiB, WS_RS = WS_R2 + 25 * MiB  , WS_H = WS_R2;
constexpr size_t WS_KVU = WS_R3, WS_CONCAT = WS_R4;

__device__ __forceinline__ unsigned pk2(float lo, float hi) { f32x2 v = {lo, hi}; bf16x2_t b = __builtin_convertvector(v, bf16x2_t); return __builtin_bit_cast(unsigned, b); }
__device__ __forceinline__ float bf_lo(unsigned w) { return __uint_as_float(w << 16); }
__device__ __forceinline__ float bf_hi(unsigned w) { return __uint_as_float(w & 0xffff0000u); }
__device__ __forceinline__ float bf2f(bf16_t h) { return __uint_as_float((unsigned)h << 16); }
template <int CTRL> __device__ __forceinline__ float dpp_f(float x) { return __builtin_bit_cast(float, __builtin_amdgcn_mov_dpp(__builtin_bit_cast(int, x), CTRL, 0xf, 0xf, true)); }
template <int CTRL> __device__ __forceinline__ int dpp_i(int x) { return __builtin_amdgcn_mov_dpp(x, CTRL, 0xf, 0xf, true); }
__device__ __forceinline__ float wave_sum(float v) {
    v += dpp_f<0xB1>(v); v += dpp_f<0x4E>(v); v += dpp_f<0x141>(v); v += dpp_f<0x140>(v);
    { auto s = __builtin_amdgcn_permlane16_swap(__float_as_uint(v), __float_as_uint(v), false, false); v = __uint_as_float(s[0]) + __uint_as_float(s[1]); }
    { auto t = __builtin_amdgcn_permlane32_swap(__float_as_uint(v), __float_as_uint(v), false, false); v = __uint_as_float(t[0]) + __uint_as_float(t[1]); }
    return v;
}
__device__ __forceinline__ int half32_sum(int v) {
    v += dpp_i<0xB1>(v); v += dpp_i<0x4E>(v); v += dpp_i<0x141>(v); v += dpp_i<0x140>(v);
    auto s = __builtin_amdgcn_permlane16_swap((unsigned)v, (unsigned)v, false, false); return (int)(s[0] + s[1]);
}
__device__ __forceinline__ unsigned half32_max(unsigned v) {
    v = max(v, (unsigned)dpp_i<0xB1>((int)v)); v = max(v, (unsigned)dpp_i<0x4E>((int)v)); v = max(v, (unsigned)dpp_i<0x141>((int)v)); v = max(v, (unsigned)dpp_i<0x140>((int)v));
    auto s = __builtin_amdgcn_permlane16_swap(v, v, false, false); return max(s[0], s[1]);
}
__device__ __forceinline__ float fast_exp2(float x) { return __builtin_amdgcn_exp2f(x); }

namespace pg8 {
constexpr int BM = 256, BK = 64, HALF = 128, HTB = HALF * BK * 2, NXCD = 8, WGM = 8;
__device__ __forceinline__ int lds_byte(int r, int c) { const int st = (r >> 4) * 2 + (c >> 5), rr = r & 15, cc = c & 31, ob = rr * 64 + cc * 2; return st * 1024 + (ob ^ (((ob >> 9) & 1) << 5)); }
__device__ __forceinline__ void stage_rc(int b, int& R, int& C) { const int st = b / 1024, sb = b % 1024, swz = sb ^ (((sb >> 9) & 1) << 5); R = (st >> 1) * 16 + swz / 64; C = (st & 1) * 32 + (swz % 64) / 2; }
__device__ __forceinline__ int perm32(int rho) { const int n = rho >> 4, i = rho & 15; return 8 * (i >> 2) + 4 * n + (i & 3); }

struct Unit { int pm, pn, e, nvalid; };

struct StaticOrder {
    int nM, nN, nwg, G, c, nrep;
    __device__ void init(int Mrows, int N, int G_, int c_, int nrep_ = 1) { nM = Mrows / BM; nN = N / BM; nwg = nM * nN; G = G_; c = c_; nrep = nrep_; }
    __device__ bool next(int i, Unit& u) const {
        long L = (long)i * G + c; if (c < 0 || L >= (long)nwg * nrep) return false;
        L %= nwg;
        int wgid = (int)L; { const int q = nwg / NXCD, r = nwg % NXCD, xcd = wgid % NXCD, off = wgid / NXCD; wgid = (xcd < r ? xcd * (q + 1) : r * (q + 1) + (xcd - r) * q) + off; }
        const int nig = WGM * nN, gid = wgid / nig, fm = gid * WGM, gsz = (nM - fm) < WGM ? (nM - fm) : WGM;
        u.pm = fm + ((wgid % nig) % gsz); u.pn = (wgid % nig) / gsz; u.e = 0; u.nvalid = 256; return true;
    }
};
struct DenseSched {
    static constexpr bool GATHER = false;
    const bf16_t* A; const bf16_t* Bt; int lda, K; StaticOrder so;
    __device__ __forceinline__ bool next(int i, Unit& u) const { return so.next(i, u); }
    __device__ __forceinline__ const char* a_base(const Unit& u) const { return (const char*)A + (size_t)u.pm * BM * lda * 2; }
    __device__ __forceinline__ const char* b_base(const Unit& u) const { return (const char*)Bt + (size_t)u.pn * BM * K * 2; }
    __device__ __forceinline__ unsigned a_off(const Unit&, int r) const { return (unsigned)r * (unsigned)lda * 2u; }
};
struct MoeSched {
    static constexpr bool GATHER = true;
    const bf16_t* A; const bf16_t* Bt; int lda, K; size_t b_estride; const int* elist; int rsh;
    const LAS int* tstart; const LAS int* ecnt; int G, v, nrep;
    __device__ __forceinline__ bool next(int i, Unit& u) const {
        int L = i * G + v; const int total = tstart[16] * 4; if (L >= total * nrep) return false;
        L %= total;
        const int mt = L >> 2; u.pn = L & 3; int e = 0;
#pragma unroll
        for (int k = 1; k < 16; ++k) if (mt >= tstart[k]) e = k;
        e = __builtin_amdgcn_readfirstlane(e);
        u.e = e; u.pm = __builtin_amdgcn_readfirstlane(mt - tstart[e]);
        int nv = ecnt[e] - u.pm * 256; nv = nv > 256 ? 256 : nv; u.nvalid = __builtin_amdgcn_readfirstlane(nv); return true;
    }
    __device__ __forceinline__ const char* a_base(const Unit&) const { return (const char*)A; }
    __device__ __forceinline__ const char* b_base(const Unit& u) const { return (const char*)Bt + (size_t)u.e * b_estride + (size_t)u.pn * BM * K * 2; }
    __device__ __forceinline__ int row_id(const Unit& u, int r) const { const int rr = r < u.nvalid ? r : 0; return elist[u.e * 16384 + u.pm * 256 + rr]; }
    __device__ __forceinline__ unsigned a_off(const Unit& u, int r) const { return (unsigned)(row_id(u, r) >> rsh) * (unsigned)lda * 2u; }
};

template <class Epi, class Sched>
__device__ __forceinline__ void gemm_phase(LAS unsigned char* lds, const Sched& S, const Epi& E, const int tid) {
    const int wid = __builtin_amdgcn_readfirstlane(tid >> 6), lane = tid & 63, wr = wid >> 2, wc = wid & 3, fr = lane & 15, fq = lane >> 4;
    const int K = S.K, nt = K / BK;
    int RA[2], CA[2]; unsigned voffB[2];
#pragma unroll
    for (int i = 0; i < 2; ++i) { int R, C; stage_rc(tid * 16 + i * 8192, R, C); const int Rb = Epi::PERM ? ((R & ~31) + perm32(R & 31)) : R;
        RA[i] = R; CA[i] = C; voffB[i] = (unsigned)(Rb * K + C) * 2u; }
    const size_t kstep = (size_t)(BK * 2);
    const size_t hstepB = (size_t)HALF * K * 2;
    const unsigned ldsw = (unsigned)wid * 1024u;
    const int aoff = lds_byte(wr * 64 + fr, fq * 8), boff = lds_byte(wc * 32 + fr, fq * 8);
#define PG8_SA(b, h) (((b) * 2 + (h)) * HTB)
#define PG8_SB(b, h) ((4 + (b) * 2 + (h)) * HTB)
#define PG8_STAGE2(bufoff, gbase, v0, v1) do { \
        __builtin_amdgcn_global_load_lds((const unsigned*)((const char*)(gbase) + (v0)), (LAS unsigned*)(lds + (bufoff) + ldsw), 16, 0, 0); \
        __builtin_amdgcn_global_load_lds((const unsigned*)((const char*)(gbase) + (v1)), (LAS unsigned*)(lds + (bufoff) + ldsw + 8192), 16, 0, 0); } while (0)
#define PG8_STAGEB(bufoff, gbase) PG8_STAGE2(bufoff, gbase, voffB[0], voffB[1])
#define PG8_LDA(dst, b, h) do { _Pragma("unroll") for (int m = 0; m < 4; ++m) _Pragma("unroll") for (int k = 0; k < 2; ++k) dst[m][k] = *(const LAS bf16x8*)(lds + PG8_SA(b, h) + aoff + m * 2048 + k * 1024); } while (0)
#define PG8_LDB(dst, b, h) do { _Pragma("unroll") for (int n = 0; n < 2; ++n) _Pragma("unroll") for (int k = 0; k < 2; ++k) dst[n][k] = *(const LAS bf16x8*)(lds + PG8_SB(b, h) + boff + n * 2048 + k * 1024); } while (0)
#define PG8_MMA(ai, bj, At, Bt) do { __builtin_amdgcn_s_setprio(1); _Pragma("unroll") for (int m = 0; m < 4; ++m) _Pragma("unroll") for (int n = 0; n < 2; ++n) _Pragma("unroll") for (int k = 0; k < 2; ++k) \
        acc[ai][bj][m][n] = __builtin_amdgcn_mfma_f32_16x16x32_bf16(Bt[n][k], At[m][k], acc[ai][bj][m][n], 0, 0, 0); __builtin_amdgcn_s_setprio(0); } while (0)
#define PG8_WAIT_V(n) asm volatile("s_waitcnt vmcnt(" #n ")" ::: "memory")
#define PG8_WAIT_L(n) asm volatile("s_waitcnt lgkmcnt(" #n ")" ::: "memory")
#define PG8_BAR __builtin_amdgcn_s_barrier()
#define PG8_SCHED __builtin_amdgcn_sched_barrier(0)
    Unit cur, nxt; int ui = 0;
    if (!S.next(0, cur)) return;
    f32x4 acc[2][2][4][2];
#pragma unroll
    for (int a = 0; a < 2; ++a)
#pragma unroll
        for (int b = 0; b < 2; ++b)
#pragma unroll
            for (int m = 0; m < 4; ++m)
#pragma unroll
                for (int n = 0; n < 2; ++n) acc[a][b][m][n] = (f32x4){0.f, 0.f, 0.f, 0.f};
    bf16x8 At[4][2], B0[2][2], B1[2][2];
    const char* cA = S.a_base(cur); const char* cB = S.b_base(cur);
    unsigned vc00, vc01, vc10, vc11, vn00, vn01, vn10, vn11;
    vc00 = S.a_off(cur, RA[0]) + CA[0] * 2; vc01 = S.a_off(cur, RA[1]) + CA[1] * 2; vc10 = S.a_off(cur, HALF + RA[0]) + CA[0] * 2; vc11 = S.a_off(cur, HALF + RA[1]) + CA[1] * 2;
    PG8_STAGEB(PG8_SB(0, 0), cB); PG8_STAGEB(PG8_SB(0, 1), cB + hstepB); PG8_STAGE2(PG8_SA(0, 0), cA, vc00, vc01); PG8_STAGE2(PG8_SA(0, 1), cA, vc10, vc11);
    if (wr == 1) PG8_BAR;
    PG8_WAIT_V(2); PG8_BAR;
    PG8_STAGEB(PG8_SB(1, 0), cB + kstep); PG8_STAGE2(PG8_SA(1, 0), cA + kstep, vc00, vc01); PG8_STAGEB(PG8_SB(1, 1), cB + hstepB + kstep);
    PG8_WAIT_V(6); PG8_BAR;
    for (;;) {
        const bool has_next = S.next(ui + 1, nxt);
        const char* nA = has_next ? S.a_base(nxt) : cA; const char* nB = has_next ? S.b_base(nxt) : cB;
        if (Sched::GATHER) {
            if (has_next) { vn00 = S.a_off(nxt, RA[0]) + CA[0] * 2; vn01 = S.a_off(nxt, RA[1]) + CA[1] * 2; vn10 = S.a_off(nxt, HALF + RA[0]) + CA[0] * 2; vn11 = S.a_off(nxt, HALF + RA[1]) + CA[1] * 2; }
            else { vn00 = vc00; vn01 = vc01; vn10 = vc10; vn11 = vc11; }
        } else { vn00 = vc00; vn01 = vc01; vn10 = vc10; vn11 = vc11; }
        for (int t = 0; t < nt; t += 2) {
            const bool last = (t == nt - 2);
            const char* a1 = cA + (size_t)(t + 1) * kstep;
            const char* a2 = last ? nA : cA + (size_t)(t + 2) * kstep; const char* b2 = last ? nB : cB + (size_t)(t + 2) * kstep;
            const char* a3 = a2 + kstep; const char* b3 = b2 + kstep;
            unsigned w00 = vc00, w01 = vc01, w10 = vc10, w11 = vc11;
            if (Sched::GATHER) { if (last) { w00 = vn00; w01 = vn01; w10 = vn10; w11 = vn11; } }
            PG8_LDB(B0, 0, 0); PG8_LDB(B1, 0, 1); PG8_SCHED; PG8_LDA(At, 0, 0); PG8_STAGE2(PG8_SA(1, 1), a1, vc10, vc11);
            PG8_WAIT_V(8); PG8_WAIT_L(0); PG8_BAR; PG8_MMA(0, 0, At, B0); PG8_MMA(0, 1, At, B1); PG8_BAR; PG8_SCHED;
            PG8_LDA(At, 0, 1); PG8_STAGEB(PG8_SB(0, 0), b2); PG8_STAGEB(PG8_SB(0, 1), b2 + hstepB); PG8_STAGE2(PG8_SA(0, 0), a2, w00, w01);
            PG8_WAIT_V(8); PG8_WAIT_L(0); PG8_BAR; PG8_MMA(1, 0, At, B0); PG8_MMA(1, 1, At, B1); PG8_BAR; PG8_SCHED;
            PG8_LDB(B0, 1, 0); PG8_LDB(B1, 1, 1); PG8_SCHED; PG8_LDA(At, 1, 0); PG8_STAGE2(PG8_SA(0, 1), a2, w10, w11);
            PG8_WAIT_V(8); PG8_WAIT_L(0); PG8_BAR; PG8_MMA(0, 0, At, B0); PG8_MMA(0, 1, At, B1); PG8_BAR; PG8_SCHED;
            PG8_LDA(At, 1, 1); PG8_STAGEB(PG8_SB(1, 0), b3); PG8_STAGEB(PG8_SB(1, 1), b3 + hstepB); PG8_STAGE2(PG8_SA(1, 0), a3, w00, w01);
            PG8_WAIT_V(8); PG8_WAIT_L(0); PG8_BAR; PG8_MMA(1, 0, At, B0); PG8_MMA(1, 1, At, B1); PG8_BAR; PG8_SCHED;
        }
        if (wr == 0) PG8_BAR;
        { int ln_; asm volatile("v_mbcnt_lo_u32_b32 %0, -1, 0\n\tv_mbcnt_hi_u32_b32 %0, -1, %0" : "=v"(ln_));
          E(acc, cur, S, wr, wc, ln_ & 15, ln_ >> 4); }
        if (!has_next) break;
#pragma unroll
        for (int a = 0; a < 2; ++a)
#pragma unroll
            for (int b = 0; b < 2; ++b)
#pragma unroll
                for (int m = 0; m < 4; ++m)
#pragma unroll
                    for (int n = 0; n < 2; ++n) acc[a][b][m][n] = (f32x4){0.f, 0.f, 0.f, 0.f};
        cur = nxt; cA = nA; cB = nB; ++ui; vc00 = vn00; vc01 = vn01; vc10 = vn10; vc11 = vn11;
        if (wr == 1) PG8_BAR;
    }
    PG8_WAIT_V(0);
    PG8_BAR;
#undef PG8_SA
#undef PG8_SB
#undef PG8_STAGE2
#undef PG8_STAGEB
#undef PG8_LDA
#undef PG8_LDB
#undef PG8_MMA
#undef PG8_WAIT_V
#undef PG8_WAIT_L
#undef PG8_BAR
#undef PG8_SCHED
}

#ifndef WT_STORES
#define WT_STORES 1
#endif
__device__ __forceinline__ void store16_wt(void* p, u32x4 w) {
#if WT_STORES
    asm volatile("global_store_dwordx4 %0, %1, off sc1\n\ts_nop 1" :: "v"(p), "v"(w) : "memory");
#else
    *(u32x4*)p = w;
#endif
}
__device__ __forceinline__ float xrow16_sum(float x) {
    auto s = __builtin_amdgcn_permlane16_swap(__float_as_uint(x), __float_as_uint(x), false, false); x = __uint_as_float(s[0]) + __uint_as_float(s[1]);
    auto t = __builtin_amdgcn_permlane32_swap(__float_as_uint(x), __float_as_uint(x), false, false); return __uint_as_float(t[0]) + __uint_as_float(t[1]);
}
__device__ __forceinline__ float rms_from_part(const float* part, int row, int g0, int nq, float inv_n) {
    float s = 0.f;
#pragma unroll
    for (int q = 0; q < 3; ++q) if (q < nq) { const f32x4 p = *(const f32x4*)(part + (size_t)row * 20 + g0 + 4 * q); s += (p[0] + p[1]) + (p[2] + p[3]); }
    return 1.0f / sqrtf(s * inv_n + RMS_EPS);
}
__device__ __forceinline__ void rms8_from_part(const float* part, int row0, int g0, int nq, float inv_n, float (&sc)[2][4]) {
#pragma unroll
    for (int ai = 0; ai < 2; ++ai) { f32x4 p[4][3];
#pragma unroll
        for (int m = 0; m < 4; ++m)
#pragma unroll
            for (int q = 0; q < 3; ++q) if (q < nq) p[m][q] = *(const f32x4*)(part + (size_t)(row0 + ai * HALF + m * 16) * 20 + g0 + 4 * q);
#pragma unroll
        for (int m = 0; m < 4; ++m) { float s = 0.f;
#pragma unroll
            for (int q = 0; q < 3; ++q) if (q < nq) s += (p[m][q][0] + p[m][q][1]) + (p[m][q][2] + p[m][q][3]);
            sc[ai][m] = 1.0f / sqrtf(s * inv_n + RMS_EPS); }
        asm volatile("" ::: "memory"); }
}
struct EpiBf16 {
    static constexpr bool PERM = true;
    bf16_t* O; int ldc; const float* part; int g0, nq; float inv_n;
    template <class Sched>
    __device__ __forceinline__ void operator()(const f32x4 (&acc)[2][2][4][2], const Unit& u, const Sched&, int wr, int wc, int fr, int fq) const {
        const int row0 = u.pm * BM + wr * 64 + fr; const int col0 = u.pn * BM + wc * 32 + 8 * fq;
        float scs[2][4];
        if (part) rms8_from_part(part, row0, g0, nq, inv_n, scs);
#pragma unroll
        for (int ai = 0; ai < 2; ++ai)
#pragma unroll
            for (int m = 0; m < 4; ++m) { const int row = row0 + ai * HALF + m * 16; bf16_t* rowp = O + (size_t)row * ldc + col0;
                const float sc = part ? scs[ai][m] : 1.f;
#pragma unroll
                for (int bj = 0; bj < 2; ++bj) { const f32x4 v0 = acc[ai][bj][m][0] * sc, v1 = acc[ai][bj][m][1] * sc;
                    u32x4 w; w.x = pk2(v0[0], v0[1]); w.y = pk2(v0[2], v0[3]); w.z = pk2(v1[0], v1[1]); w.w = pk2(v1[2], v1[3]);
                    store16_wt(rowp + bj * HALF, w); } }
    }
};
struct EpiProj {
    static constexpr bool PERM = true;
    bf16_t* O; int ldc; float* part; bf16_t* KR; const float* cs; const float* sn; bool wt;
    template <class Sched>
    __device__ __forceinline__ void operator()(const f32x4 (&acc)[2][2][4][2], const Unit& u, const Sched&, int wr, int wc, int fr, int fq) const {
        const int row0 = u.pm * BM + wr * 64 + fr; const int col0 = u.pn * BM + wc * 32 + 8 * fq;
#pragma unroll
        for (int ai = 0; ai < 2; ++ai)
#pragma unroll
            for (int m = 0; m < 4; ++m) { const int row = row0 + ai * HALF + m * 16; bf16_t* rowp = O + (size_t)row * ldc + col0;
#pragma unroll
                for (int bj = 0; bj < 2; ++bj) { const f32x4 v0 = acc[ai][bj][m][0], v1 = acc[ai][bj][m][1];
                    u32x4 w; w.x = pk2(v0[0], v0[1]); w.y = pk2(v0[2], v0[3]); w.z = pk2(v1[0], v1[1]); w.w = pk2(v1[2], v1[3]);
                    store16_wt(rowp + bj * HALF, w);
                    const int g = u.pn * 8 + bj * 4 + wc;
                    if (g < 20) { float ss = (v0[0] * v0[0] + v0[1] * v0[1]) + (v0[2] * v0[2] + v0[3] * v0[3]) + (v1[0] * v1[0] + v1[1] * v1[1]) + (v1[2] * v1[2] + v1[3] * v1[3]);
                        ss = xrow16_sum(ss); if (fq == 0) __hip_atomic_store(part + (size_t)row * 20 + g, ss, __ATOMIC_RELAXED, __HIP_MEMORY_SCOPE_AGENT); }
                    else if (g == 20) {
                        const int pos = row & (SEQ - 1); const int ib = 8 * (fq & 1);
                        const f32x4 c0 = *(const f32x4*)(cs + pos * 16 + ib), c1 = *(const f32x4*)(cs + pos * 16 + ib + 4), s0 = *(const f32x4*)(sn + pos * 16 + ib), s1 = *(const f32x4*)(sn + pos * 16 + ib + 4);
                        f32x4 y0, y1;
#pragma unroll
                        for (int j = 0; j < 4; ++j) {
                            auto e0 = __builtin_amdgcn_permlane32_swap(__float_as_uint(v0[j]), __float_as_uint(v0[j]), false, false); const float oth0 = __uint_as_float(fq < 2 ? e0[1] : e0[0]);
                            auto e1 = __builtin_amdgcn_permlane32_swap(__float_as_uint(v1[j]), __float_as_uint(v1[j]), false, false); const float oth1 = __uint_as_float(fq < 2 ? e1[1] : e1[0]);
                            y0[j] = fq < 2 ? v0[j] * c0[j] - oth0 * s0[j] : oth0 * s0[j] + v0[j] * c0[j];
                            y1[j] = fq < 2 ? v1[j] * c1[j] - oth1 * s1[j] : oth1 * s1[j] + v1[j] * c1[j]; }
                        u32x4 kw; kw.x = pk2(y0[0], y0[1]); kw.y = pk2(y0[2], y0[3]); kw.z = pk2(y1[0], y1[1]); kw.w = pk2(y1[2], y1[3]);
                        *(u32x4*)(KR + (size_t)row * 32 + 8 * fq) = kw; } }
                asm volatile("" ::: "memory"); }
    }
};
struct EpiQRope {
    static constexpr bool PERM = false;
    bf16_t* O; int ldc; const float* part; const float* cs; const float* sn;
    template <class Sched>
    __device__ __forceinline__ void operator()(const f32x4 (&acc)[2][2][4][2], const Unit& u, const Sched&, int wr, int wc, int fr, int fq) const {
        const int row0 = u.pm * BM + wr * 64 + fr;
        float scs[2][4]; rms8_from_part(part, row0, 0, 3, 1.f / 384.f, scs);
#pragma unroll
        for (int ai = 0; ai < 2; ++ai) {
            f32x4 cc[4], ss[4];
#pragma unroll
            for (int m = 0; m < 4; ++m) { const int pos = (row0 + ai * HALF + m * 16) & (SEQ - 1); cc[m] = *(const f32x4*)(cs + pos * 16 + 4 * fq); ss[m] = *(const f32x4*)(sn + pos * 16 + 4 * fq); }
#pragma unroll
            for (int m = 0; m < 4; ++m) { const int row = row0 + ai * HALF + m * 16; const float sc = scs[ai][m];
                const f32x4 c4 = cc[m], s4 = ss[m];
#pragma unroll
                for (int bj = 0; bj < 2; ++bj) { const int colg = u.pn * BM + bj * HALF + wc * 32;
                    f32x4 x1 = acc[ai][bj][m][0] * sc, x2 = acc[ai][bj][m][1] * sc;
                    if (((colg >> 5) % 3) == 2) { const f32x4 y1 = x1 * c4 - x2 * s4, y2 = x1 * s4 + x2 * c4; x1 = y1; x2 = y2; }
                    bf16_t* p = O + (size_t)row * ldc + colg + 4 * fq;
                    u32x2 w1, w2; w1.x = pk2(x1[0], x1[1]); w1.y = pk2(x1[2], x1[3]); w2.x = pk2(x2[0], x2[1]); w2.y = pk2(x2[2], x2[3]);
                    *(u32x2*)p = w1; *(u32x2*)(p + 16) = w2; } }
            asm volatile("" ::: "memory"); }
    }
};
struct EpiMoe1 {
    static constexpr bool PERM = true;
    bf16_t* H; const float* gatew;
    template <class Sched>
    __device__ __forceinline__ void operator()(const f32x4 (&acc)[2][2][4][2], const Unit& u, const Sched& S, int wr, int wc, int fr, int fq) const {
        int pr[2][4]; float gws[2][4];
#pragma unroll
        for (int ai = 0; ai < 2; ++ai)
#pragma unroll
            for (int m = 0; m < 4; ++m) { const int r = ai * HALF + wr * 64 + m * 16 + fr; pr[ai][m] = S.elist[u.e * 16384 + u.pm * 256 + (r < u.nvalid ? r : 0)]; }
#pragma unroll
        for (int ai = 0; ai < 2; ++ai)
#pragma unroll
            for (int m = 0; m < 4; ++m) gws[ai][m] = gatew[pr[ai][m]];
#pragma unroll
        for (int ai = 0; ai < 2; ++ai)
#pragma unroll
            for (int m = 0; m < 4; ++m) { const int r = ai * HALF + wr * 64 + m * 16 + fr;
                if (r < u.nvalid) { const int pair = pr[ai][m]; const float gw = gws[ai][m];
#pragma unroll
                    for (int bj = 0; bj < 2; ++bj) { const f32x4 g = acc[ai][bj][m][0], up = acc[ai][bj][m][1]; f32x4 a;
#pragma unroll
                        for (int j = 0; j < 4; ++j) { const float sg = g[j] / (1.f + __expf(-g[j])); a[j] = sg * up[j] * gw; }
                        const int f = u.pn * 128 + bj * 64 + wc * 16 + fq * 4;
                        u32x2 w; w.x = pk2(a[0], a[1]); w.y = pk2(a[2], a[3]);
                        __hip_atomic_store((unsigned long long*)(H + (size_t)pair * DFF + f), (unsigned long long)w.x | ((unsigned long long)w.y << 32), __ATOMIC_RELAXED, __HIP_MEMORY_SCOPE_AGENT); } } }
    }
};
struct EpiMoe2 {
    static constexpr bool PERM = true;
    bf16_t* Y;
    template <class Sched>
    __device__ __forceinline__ void operator()(const f32x4 (&acc)[2][2][4][2], const Unit& u, const Sched& S, int wr, int wc, int fr, int fq) const {
        const int col0 = u.pn * BM + wc * 32 + 8 * fq;
        int pr[2][4];
#pragma unroll
        for (int ai = 0; ai < 2; ++ai)
#pragma unroll
            for (int m = 0; m < 4; ++m) { const int r = ai * HALF + wr * 64 + m * 16 + fr; pr[ai][m] = S.elist[u.e * 16384 + u.pm * 256 + (r < u.nvalid ? r : 0)]; }
#pragma unroll
        for (int ai = 0; ai < 2; ++ai)
#pragma unroll
            for (int m = 0; m < 4; ++m) { const int r = ai * HALF + wr * 64 + m * 16 + fr;
                if (r < u.nvalid) { bf16_t* rowp = Y + (size_t)pr[ai][m] * DM + col0;
#pragma unroll
                    for (int bj = 0; bj < 2; ++bj) { const f32x4 v0 = acc[ai][bj][m][0], v1 = acc[ai][bj][m][1];
                        u32x4 w; w.x = pk2(v0[0], v0[1]); w.y = pk2(v0[2], v0[3]); w.z = pk2(v1[0], v1[1]); w.w = pk2(v1[2], v1[3]);
                        store16_wt(rowp + bj * HALF, w); } } }
    }
};

struct Unit2 : Unit { int kind, mt; };
struct Moe12Sched {
    const bf16_t* X1B; const bf16_t* H; const bf16_t* WGU; const bf16_t* WD; const int* elist; const LAS int* tstart; const LAS int* ecnt; unsigned* ready; int G, v;
    __device__ __forceinline__ bool next(int i, Unit2& u) const {
        const int T4 = tstart[16] * 4; const int q1 = T4 / G, rem = T4 - q1 * G; const int g1 = q1 + (v < rem ? 1 : 0);
        int L, kind;
        if (i < g1) { L = v + i * G; kind = 0; }
        else { if (rem > 0 && v < rem) return false; const int nl = G - rem; const int p = (v - rem) + nl * (i - g1); if (p >= T4) return false; L = p; kind = 1; }
        const int mt = L >> 2; u.pn = L & 3; int e = 0;
#pragma unroll
        for (int k = 1; k < 16; ++k) if (mt >= tstart[k]) e = k;
        e = __builtin_amdgcn_readfirstlane(e);
        u.e = e; u.pm = __builtin_amdgcn_readfirstlane(mt - tstart[e]); u.mt = __builtin_amdgcn_readfirstlane(mt); u.kind = __builtin_amdgcn_readfirstlane(kind);
        int nv = ecnt[e] - u.pm * 256; nv = nv > 256 ? 256 : nv; u.nvalid = __builtin_amdgcn_readfirstlane(nv); return true;
    }
    __device__ __forceinline__ int kdim(const Unit2& u) const { return u.kind ? DFF : DM; }
    __device__ __forceinline__ bool perm(const Unit2&) const { return true; }
    __device__ __forceinline__ int epi(const Unit2& u) const { return u.kind; }
    __device__ __forceinline__ const char* a_base(const Unit2& u) const { return u.kind ? (const char*)H : (const char*)X1B; }
    __device__ __forceinline__ const char* b_base(const Unit2& u) const { return u.kind ? (const char*)WD + (size_t)u.e * (DM * DFF * 2) + (size_t)u.pn * (BM * DFF * 2) : (const char*)WGU + (size_t)u.e * (DM * DM * 2) + (size_t)u.pn * (BM * DM * 2); }
    __device__ __forceinline__ int row_id(const Unit& u, int r) const { const int rr = r < u.nvalid ? r : 0; return elist[u.e * 16384 + u.pm * 256 + rr]; }
    __device__ __forceinline__ unsigned a_off(const Unit2& u, int r) const { const int id = row_id(u, r); return u.kind ? (unsigned)id * (unsigned)(DFF * 2) : (unsigned)(id >> 1) * (unsigned)(DM * 2); }
    __device__ __forceinline__ void a_ready(const Unit2& u, int tid) const {
        if (u.kind) {
            if (tid < 64) { unsigned sp = 0;
                while ((unsigned)__builtin_amdgcn_readfirstlane(__hip_atomic_load(ready + u.mt, __ATOMIC_RELAXED, __HIP_MEMORY_SCOPE_AGENT)) < 32u) { __builtin_amdgcn_s_sleep(2); if (++sp > (1u << 22)) break; }
                __builtin_amdgcn_fence(__ATOMIC_ACQUIRE, "agent");
                asm volatile("s_waitcnt vmcnt(0)" ::: "memory"); }
            asm volatile("" ::: "memory"); __builtin_amdgcn_s_barrier(); asm volatile("" ::: "memory");
        }
    }
    __device__ __forceinline__ void done(const Unit2& u, int lane) const {
        if (!u.kind) { asm volatile("s_waitcnt vmcnt(0)" ::: "memory"); if (lane == 0) __hip_atomic_fetch_add(ready + u.mt, 1u, __ATOMIC_RELAXED, __HIP_MEMORY_SCOPE_AGENT); }
    }
};


struct ProjSched {
    const bf16_t* XB; const bf16_t* PROJ; const bf16_t* WIN; const bf16_t* WQUP; const bf16_t* WKV; unsigned* c01; unsigned* c12; int G, v;
    __device__ __forceinline__ bool next(int i, Unit2& u) const {
        const int g0 = v < 192 ? 2 : 1; int kind, pm, pn;
        if (i < g0) { const int L = v + i * G; kind = 0; pm = L & 63; pn = L >> 6; }
        else { const int j = i - g0;
            if (v < 192) { if (j >= 1) return false; kind = 2; pm = v >> 2; pn = v & 3; }
            else { const int w = v - 192; if (j < 3) { kind = 1; pm = w; pn = j; } else if (j == 3) { kind = 2; pm = 48 + (w >> 2); pn = w & 3; } else return false; } }
        u.kind = __builtin_amdgcn_readfirstlane(kind); u.pm = __builtin_amdgcn_readfirstlane(pm); u.pn = __builtin_amdgcn_readfirstlane(pn); u.e = 0; u.nvalid = 256; u.mt = u.pm; return true;
    }
    __device__ __forceinline__ int kdim(const Unit2& u) const { return u.kind == 0 ? DM : (u.kind == 1 ? 384 : 256); }
    __device__ __forceinline__ bool perm(const Unit2& u) const { return u.kind != 1; }
    __device__ __forceinline__ int epi(const Unit2& u) const { return u.kind; }
    __device__ __forceinline__ const char* a_base(const Unit2& u) const {
        return u.kind == 0 ? (const char*)XB + (size_t)u.pm * (BM * DM * 2) : (const char*)PROJ + (size_t)u.pm * (BM * NPROJ * 2) + (u.kind == 1 ? C_QA * 2 : C_KVA * 2); }
    __device__ __forceinline__ const char* b_base(const Unit2& u) const {
        return u.kind == 0 ? (const char*)WIN + (size_t)u.pn * (BM * DM * 2) : (u.kind == 1 ? (const char*)WQUP + (size_t)u.pn * (BM * 384 * 2) : (const char*)WKV + (size_t)u.pn * (BM * 256 * 2)); }
    __device__ __forceinline__ unsigned a_off(const Unit2& u, int r) const { return (unsigned)r * (u.kind == 0 ? (unsigned)(DM * 2) : (unsigned)(NPROJ * 2)); }
    __device__ __forceinline__ void a_ready(const Unit2& u, int tid) const {
        if (u.kind) {
            if (tid < 64) { unsigned* c = (u.kind == 1 ? c01 : c12) + u.pm; unsigned sp = 0;
                while ((unsigned)__builtin_amdgcn_readfirstlane(__hip_atomic_load(c, __ATOMIC_RELAXED, __HIP_MEMORY_SCOPE_AGENT)) < 16u) { __builtin_amdgcn_s_sleep(2); if (++sp > (1u << 22)) break; }
                __builtin_amdgcn_fence(__ATOMIC_ACQUIRE, "agent");
                asm volatile("s_waitcnt vmcnt(0)" ::: "memory"); }
            asm volatile("" ::: "memory"); __builtin_amdgcn_s_barrier(); asm volatile("" ::: "memory");
        }
    }
    __device__ __forceinline__ void done(const Unit2& u, int lane) const {
        if (u.kind == 0 && u.pn <= 2) { asm volatile("s_waitcnt vmcnt(0)" ::: "memory");
            if (lane == 0) { if (u.pn <= 1) __hip_atomic_fetch_add(c01 + u.pm, 1u, __ATOMIC_RELAXED, __HIP_MEMORY_SCOPE_AGENT); if (u.pn >= 1) __hip_atomic_fetch_add(c12 + u.pm, 1u, __ATOMIC_RELAXED, __HIP_MEMORY_SCOPE_AGENT); } }
    }
};

template <class SchedT, class E0T, class E1T, class E2T>
__device__ __forceinline__ void gemm_stream(LAS unsigned char* lds, const SchedT& S, const E0T& E0, const E1T& E1, const E2T& E2, const int tid) {
    const int wid = __builtin_amdgcn_readfirstlane(tid >> 6), lane = tid & 63, wr = wid >> 2, wc = wid & 3, fr = lane & 15, fq = lane >> 4;
#define PG8_GEOM() int RA[2], CA[2], RB[2]; { int tq_ = tid; asm volatile("" : "+v"(tq_)); _Pragma("unroll") for (int i = 0; i < 2; ++i) { int R, C; stage_rc(tq_ * 16 + i * 8192, R, C); RA[i] = R; CA[i] = C; RB[i] = (R & ~31) + perm32(R & 31); } }
    const size_t kstep = (size_t)(BK * 2);
    const unsigned ldsw = (unsigned)wid * 1024u;
    const int aoff = lds_byte(wr * 64 + fr, fq * 8), boff = lds_byte(wc * 32 + fr, fq * 8);
#define PG8_SA(b, h) (((b) * 2 + (h)) * HTB)
#define PG8_SB(b, h) ((4 + (b) * 2 + (h)) * HTB)
#define PG8_STAGE2(bufoff, gbase, v0, v1) do { \
        __builtin_amdgcn_global_load_lds((const unsigned*)((const char*)(gbase) + (v0)), (LAS unsigned*)(lds + (bufoff) + ldsw), 16, 0, 0); \
        __builtin_amdgcn_global_load_lds((const unsigned*)((const char*)(gbase) + (v1)), (LAS unsigned*)(lds + (bufoff) + ldsw + 8192), 16, 0, 0); } while (0)
#define PG8_LDA(dst, b, h) do { _Pragma("unroll") for (int m = 0; m < 4; ++m) _Pragma("unroll") for (int k = 0; k < 2; ++k) dst[m][k] = *(const LAS bf16x8*)(lds + PG8_SA(b, h) + aoff + m * 2048 + k * 1024); } while (0)
#define PG8_LDB(dst, b, h) do { _Pragma("unroll") for (int n = 0; n < 2; ++n) _Pragma("unroll") for (int k = 0; k < 2; ++k) dst[n][k] = *(const LAS bf16x8*)(lds + PG8_SB(b, h) + boff + n * 2048 + k * 1024); } while (0)
#define PG8_MMA(ai, bj, At, Bt) do { __builtin_amdgcn_s_setprio(1); _Pragma("unroll") for (int m = 0; m < 4; ++m) _Pragma("unroll") for (int n = 0; n < 2; ++n) _Pragma("unroll") for (int k = 0; k < 2; ++k) \
        acc[ai][bj][m][n] = __builtin_amdgcn_mfma_f32_16x16x32_bf16(Bt[n][k], At[m][k], acc[ai][bj][m][n], 0, 0, 0); __builtin_amdgcn_s_setprio(0); } while (0)
#define PG8_WAIT_V(n) asm volatile("s_waitcnt vmcnt(" #n ")" ::: "memory")
#define PG8_WAIT_L(n) asm volatile("s_waitcnt lgkmcnt(" #n ")" ::: "memory")
#define PG8_BAR __builtin_amdgcn_s_barrier()
#define PG8_SCHED __builtin_amdgcn_sched_barrier(0)
    Unit2 cur, nxt; int ui = 0;
    if (!S.next(0, cur)) return;
    f32x4 acc[2][2][4][2];
#pragma unroll
    for (int a = 0; a < 2; ++a)
#pragma unroll
        for (int b = 0; b < 2; ++b)
#pragma unroll
            for (int m = 0; m < 4; ++m)
#pragma unroll
                for (int n = 0; n < 2; ++n) acc[a][b][m][n] = (f32x4){0.f, 0.f, 0.f, 0.f};
    bf16x8 At[4][2], B0[2][2], B1[2][2];
    const char* cA = S.a_base(cur); const char* cB = S.b_base(cur);
    int Kc = S.kdim(cur); int ntc = Kc / BK; size_t hbc = (size_t)HALF * Kc * 2;
    unsigned bc0, bc1, bn0, bn1, vc00, vc01, vc10, vc11, vn00, vn01, vn10, vn11;
    { PG8_GEOM();
      bc0 = (unsigned)((S.perm(cur) ? RB[0] : RA[0]) * Kc + CA[0]) * 2u; bc1 = (unsigned)((S.perm(cur) ? RB[1] : RA[1]) * Kc + CA[1]) * 2u;
      vc00 = S.a_off(cur, RA[0]) + CA[0] * 2; vc01 = S.a_off(cur, RA[1]) + CA[1] * 2; vc10 = S.a_off(cur, HALF + RA[0]) + CA[0] * 2; vc11 = S.a_off(cur, HALF + RA[1]) + CA[1] * 2; }
    S.a_ready(cur, tid);
    PG8_STAGE2(PG8_SB(0, 0), cB, bc0, bc1); PG8_STAGE2(PG8_SB(0, 1), cB + hbc, bc0, bc1); PG8_STAGE2(PG8_SA(0, 0), cA, vc00, vc01); PG8_STAGE2(PG8_SA(0, 1), cA, vc10, vc11);
    if (wr == 1) PG8_BAR;
    PG8_WAIT_V(2); PG8_BAR;
    PG8_STAGE2(PG8_SB(1, 0), cB + kstep, bc0, bc1); PG8_STAGE2(PG8_SA(1, 0), cA + kstep, vc00, vc01); PG8_STAGE2(PG8_SB(1, 1), cB + hbc + kstep, bc0, bc1);
    PG8_WAIT_V(6); PG8_BAR;
    for (;;) {
        const bool has_next = S.next(ui + 1, nxt);
        const char* nA = cA; const char* nB = cB; int Kn = Kc; size_t hbn = hbc;
        bn0 = bc0; bn1 = bc1; vn00 = vc00; vn01 = vc01; vn10 = vc10; vn11 = vc11;
        if (has_next) { nA = S.a_base(nxt); nB = S.b_base(nxt); Kn = S.kdim(nxt); hbn = (size_t)HALF * Kn * 2; PG8_GEOM();
            bn0 = (unsigned)((S.perm(nxt) ? RB[0] : RA[0]) * Kn + CA[0]) * 2u; bn1 = (unsigned)((S.perm(nxt) ? RB[1] : RA[1]) * Kn + CA[1]) * 2u;
            vn00 = S.a_off(nxt, RA[0]) + CA[0] * 2; vn01 = S.a_off(nxt, RA[1]) + CA[1] * 2; vn10 = S.a_off(nxt, HALF + RA[0]) + CA[0] * 2; vn11 = S.a_off(nxt, HALF + RA[1]) + CA[1] * 2; }
        for (int t = 0; t < ntc; t += 2) {
            const bool last = (t == ntc - 2);
            if (last && has_next) S.a_ready(nxt, tid);
            const char* a1 = cA + (size_t)(t + 1) * kstep;
            const char* a2 = last ? nA : cA + (size_t)(t + 2) * kstep; const char* b2 = last ? nB : cB + (size_t)(t + 2) * kstep;
            const char* a3 = a2 + kstep; const char* b3 = b2 + kstep;
            unsigned w00 = vc00, w01 = vc01, w10 = vc10, w11 = vc11, x0 = bc0, x1 = bc1; size_t hb = hbc;
            if (last) { w00 = vn00; w01 = vn01; w10 = vn10; w11 = vn11; x0 = bn0; x1 = bn1; hb = hbn; }
            PG8_LDB(B0, 0, 0); PG8_LDB(B1, 0, 1); PG8_SCHED; PG8_LDA(At, 0, 0); PG8_STAGE2(PG8_SA(1, 1), a1, vc10, vc11);
            PG8_WAIT_V(8); PG8_WAIT_L(0); PG8_BAR; PG8_MMA(0, 0, At, B0); PG8_MMA(0, 1, At, B1); PG8_BAR; PG8_SCHED;
            PG8_LDA(At, 0, 1); PG8_STAGE2(PG8_SB(0, 0), b2, x0, x1); PG8_STAGE2(PG8_SB(0, 1), b2 + hb, x0, x1); PG8_STAGE2(PG8_SA(0, 0), a2, w00, w01);
            PG8_WAIT_V(8); PG8_WAIT_L(0); PG8_BAR; PG8_MMA(1, 0, At, B0); PG8_MMA(1, 1, At, B1); PG8_BAR; PG8_SCHED;
            PG8_LDB(B0, 1, 0); PG8_LDB(B1, 1, 1); PG8_SCHED; PG8_LDA(At, 1, 0); PG8_STAGE2(PG8_SA(0, 1), a2, w10, w11);
            PG8_WAIT_V(8); PG8_WAIT_L(0); PG8_BAR; PG8_MMA(0, 0, At, B0); PG8_MMA(0, 1, At, B1); PG8_BAR; PG8_SCHED;
            PG8_LDA(At, 1, 1); PG8_STAGE2(PG8_SB(1, 0), b3, x0, x1); PG8_STAGE2(PG8_SB(1, 1), b3 + hb, x0, x1); PG8_STAGE2(PG8_SA(1, 0), a3, w00, w01);
            PG8_WAIT_V(8); PG8_WAIT_L(0); PG8_BAR; PG8_MMA(1, 0, At, B0); PG8_MMA(1, 1, At, B1); PG8_BAR; PG8_SCHED;
        }
        if (wr == 0) PG8_BAR;
        { int ln_; asm volatile("v_mbcnt_lo_u32_b32 %0, -1, 0\n\tv_mbcnt_hi_u32_b32 %0, -1, %0" : "=v"(ln_));
          const int ek = S.epi(cur);
          if (ek == 0) E0(acc, cur, S, wr, wc, ln_ & 15, ln_ >> 4); else if (ek == 1) E1(acc, cur, S, wr, wc, ln_ & 15, ln_ >> 4); else E2(acc, cur, S, wr, wc, ln_ & 15, ln_ >> 4);
          S.done(cur, ln_); }
        if (!has_next) break;
#pragma unroll
        for (int a = 0; a < 2; ++a)
#pragma unroll
            for (int b = 0; b < 2; ++b)
#pragma unroll
                for (int m = 0; m < 4; ++m)
#pragma unroll
                    for (int n = 0; n < 2; ++n) acc[a][b][m][n] = (f32x4){0.f, 0.f, 0.f, 0.f};
        cur = nxt; cA = nA; cB = nB; ++ui; vc00 = vn00; vc01 = vn01; vc10 = vn10; vc11 = vn11; bc0 = bn0; bc1 = bn1; Kc = Kn; ntc = Kc / BK; hbc = hbn;
        if (wr == 1) PG8_BAR;
    }
    PG8_WAIT_V(0);
    PG8_BAR;
#undef PG8_GEOM
#undef PG8_SA
#undef PG8_SB
#undef PG8_STAGE2
#undef PG8_LDA
#undef PG8_LDB
#undef PG8_MMA
#undef PG8_WAIT_V
#undef PG8_WAIT_L
#undef PG8_BAR
#undef PG8_SCHED
}
}


struct Args {
    const float* x; const float* w_in; const float* q_norm_g; const float* w_q_up; const float* kv_norm_g; const float* w_uk; const float* w_uv; const float* w_o;
    const float* ln1_g; const float* ln1_b; const float* router_w; const float* router_bias; const float* w_gate; const float* w_up; const float* w_down;
    const float* ln2_g; const float* ln2_b;
    float* out; unsigned char* ws; int ph_lo, ph_hi, dup_mask, pad;
};

__device__ __forceinline__ void conv_item(const float* srcp, int ldw, float cs, const float* kscale, bf16_t* dst, int Kdst, LAS float* scr, int lane) {
    const int kr = lane >> 4, j = lane & 15;
    f32x4 v[8];
#pragma unroll
    for (int i = 0; i < 8; ++i) v[i] = srcp ? *(const f32x4*)(srcp + (size_t)(kr + 4 * i) * ldw) : (f32x4){0.f, 0.f, 0.f, 0.f};
#pragma unroll
    for (int i = 0; i < 8; ++i) { const int k = kr + 4 * i; const float ks = kscale ? kscale[k] * cs : cs; LAS float* p = scr + k * 65 + 4 * j;
        p[0] = v[i][0] * ks; p[1] = v[i][1] * ks; p[2] = v[i][2] * ks; p[3] = v[i][3] * ks; }
    asm volatile("s_waitcnt lgkmcnt(0)" ::: "memory");
    const int kc = lane & 3;
#pragma unroll
    for (int q = 0; q < 4; ++q) { const int n = (lane >> 2) + 16 * q; const LAS float* sp = scr + (8 * kc) * 65 + n;
        u32x4 o; o.x = pk2(sp[0 * 65], sp[1 * 65]); o.y = pk2(sp[2 * 65], sp[3 * 65]); o.z = pk2(sp[4 * 65], sp[5 * 65]); o.w = pk2(sp[6 * 65], sp[7 * 65]);
        *(u32x4*)(dst + (size_t)n * Kdst + 8 * kc) = o; }
    asm volatile("s_waitcnt lgkmcnt(0)" ::: "memory");
}

__device__ __forceinline__ void p0_small_weights(const Args& a, LAS float* scr, int gw, int NGW, int lane) {
    unsigned char* ws = a.ws;
    constexpr int I_IN = 28 * 32, I_QUP = 12 * 12, I_KV = 16 * 8, I_O = 16 * 32, I_L = I_IN + I_QUP + I_KV + I_O;
    const int j4 = (lane & 15) * 4;
    for (int it = gw; it < DEPTH * I_L; it += NGW) {
        const int l = it / I_L; int r = it % I_L;
        if (r < I_IN) { const int kb = r / 28, nb = r % 28, n = nb * 64 + j4, k0 = kb * 32;
            const float* sp = n < IN_COLS ? a.w_in + (size_t)l * DM * IN_COLS + (size_t)k0 * IN_COLS + n : nullptr;
            const float cs = (n >= C_DQ && n < C_DK) ? DSA_QSCALE : 1.f;
            conv_item(sp, IN_COLS, cs, nullptr, (bf16_t*)(ws + WS_WIN) + (size_t)l * NPROJ * DM + (size_t)(nb * 64) * DM + k0, DM, scr, lane); continue; }
        r -= I_IN;
        if (r < I_QUP) { const int kb = r / 12, nb = r % 12, n = nb * 64 + j4, k0 = kb * 32;
            conv_item(a.w_q_up + (size_t)l * 384 * 768 + (size_t)k0 * 768 + n, 768, MLA_QSCALE, a.q_norm_g + l * 384 + k0, (bf16_t*)(ws + WS_WQUP) + (size_t)l * 768 * 384 + (size_t)(nb * 64) * 384 + k0, 384, scr, lane); continue; }
        r -= I_QUP;
        if (r < I_KV) { const int kb = r / 16, nb = r % 16, n = nb * 64 + j4, k0 = kb * 32;
            const float* sp = n < 512 ? a.w_uk + (size_t)l * 256 * 512 + (size_t)k0 * 512 + n : a.w_uv + (size_t)l * 256 * 512 + (size_t)k0 * 512 + (n - 512);
            conv_item(sp, 512, 1.f, a.kv_norm_g + l * 256 + k0, (bf16_t*)(ws + WS_WKV) + (size_t)l * 1024 * 256 + (size_t)(nb * 64) * 256 + k0, 256, scr, lane); continue; }
        r -= I_KV;
        { const int kb = r / 16, nb = r % 16, n = nb * 64 + j4, k0 = kb * 32;
            conv_item(a.w_o + (size_t)l * DM * DM + (size_t)k0 * DM + n, DM, 1.f, nullptr, (bf16_t*)(ws + WS_WO) + (size_t)l * DM * DM + (size_t)(nb * 64) * DM + k0, DM, scr, lane); }
    }
}
__device__ __forceinline__ void p0_expert_weights(const Args& a, int l, LAS float* scr, int gw, int NGW, int lane) {
    unsigned char* ws = a.ws;
    constexpr int I_GU = 16 * 32 * 16, I_D = 16 * 16 * 16;
    const int j4 = (lane & 15) * 4;
    for (int it = gw; it < I_GU + I_D; it += NGW) {
        int r = it;
        if (r < I_GU) { const int e = r / 512, rr = r % 512, kb = rr / 16, nb = rr % 16, c0 = nb * 64 + j4, k0 = kb * 32;
            const int f = 4 * (c0 >> 3); const float* W = (c0 & 4) ? a.w_up : a.w_gate;
            conv_item(W + ((size_t)(l * NEXP + e) * DM + k0) * DFF + f, DFF, 1.f, nullptr, (bf16_t*)(ws + WS_WGU) + (size_t)e * DM * DM + (size_t)(nb * 64) * DM + k0, DM, scr, lane); continue; }
        r -= I_GU;
        { const int e = r / 256, rr = r % 256, kb = rr / 16, nb = rr % 16, n = nb * 64 + j4, k0 = kb * 32;
            conv_item(a.w_down + ((size_t)(l * NEXP + e) * DFF + k0) * DM + n, DM, 1.f, nullptr, (bf16_t*)(ws + WS_WD) + (size_t)e * DM * DFF + (size_t)(nb * 64) * DFF + k0, DFF, scr, lane); }
    }
}
__device__ __forceinline__ void p0_misc(const Args& a, int gw, int NGW, int lane) {
    unsigned char* ws = a.ws;
    for (int m = gw; m < M; m += NGW) { const f32x4* xr = (const f32x4*)(a.x + (size_t)m * DM) + lane; u32x2* o = (u32x2*)((bf16_t*)(ws + WS_XB) + (size_t)m * DM) + lane;
#pragma unroll
        for (int j = 0; j < 4; ++j) { const f32x4 v = xr[64 * j]; u32x2 w; w.x = pk2(v[0], v[1]); w.y = pk2(v[2], v[3]); o[64 * j] = w; } }
    float* cs = (float*)(ws + WS_ROPE); float* sn = cs + SEQ * 16;
    for (int i = gw * 64 + lane; i < SEQ * 16; i += NGW * 64) { const int pos = i >> 4, k = i & 15; const float inv = powf(10000.0f, -(float)k / 16.0f); const float ang = (float)pos * inv; cs[i] = cosf(ang); sn[i] = sinf(ang); }
    if (gw == 0) for (int i = lane; i < 1024; i += 64) ((int*)(ws + WS_CTL))[i] = 0;
}

__device__ __forceinline__ void p1b_token_stats(const Args& a, int gw, int NGW, int lane) {
    unsigned char* ws = a.ws; const bf16_t* PROJ = (const bf16_t*)(ws + WS_PROJ); float* RS = (float*)(ws + WS_RS); bf16_t* KR = (bf16_t*)(ws + WS_KR);
    const float* cs = (const float*)(ws + WS_ROPE); const float* sn = cs + SEQ * 16;
    for (int m = gw; m < M; m += NGW) {
        const bf16_t* row = PROJ + (size_t)m * NPROJ;
        float sq = 0.f, sk = 0.f;
        if (lane < 48) { const u32x4 w = *(const u32x4*)(row + C_QA + lane * 8);
#pragma unroll
            for (int j = 0; j < 4; ++j) { const float lo = bf_lo(w[j]), hi = bf_hi(w[j]); sq += lo * lo + hi * hi; } }
        if (lane < 32) { const u32x4 w = *(const u32x4*)(row + C_KVA + lane * 8);
#pragma unroll
            for (int j = 0; j < 4; ++j) { const float lo = bf_lo(w[j]), hi = bf_hi(w[j]); sk += lo * lo + hi * hi; } }
        sq = wave_sum(sq); sk = wave_sum(sk);
        if (lane == 0) { RS[(size_t)m * 2] = 1.0f / sqrtf(sq * (1.f / 384.f) + RMS_EPS); RS[(size_t)m * 2 + 1] = 1.0f / sqrtf(sk * (1.f / 256.f) + RMS_EPS); }
        if (lane < 16) { const int pos = m & (SEQ - 1); const float x1 = bf2f(row[C_KR + lane]), x2 = bf2f(row[C_KR + 16 + lane]); const float c = cs[pos * 16 + lane], s = sn[pos * 16 + lane];
            const unsigned y1 = pk2(x1 * c - x2 * s, 0.f) & 0xffffu, y2 = pk2(x1 * s + x2 * c, 0.f) & 0xffffu;
            KR[(size_t)m * 32 + lane] = (bf16_t)y1; KR[(size_t)m * 32 + 16 + lane] = (bf16_t)y2; }
    }
}

__device__ __forceinline__ float max3f(float a, float b, float c) { float r; asm("v_max3_f32 %0, %1, %2, %3" : "=v"(r) : "v"(a), "v"(b), "v"(c)); return r; }
__device__ __forceinline__ int crow(int r, int hi) { return (r & 3) + 8 * (r >> 2) + 4 * hi; }
__device__ __forceinline__ s16x4 vtr(const LAS unsigned char* p) { typedef short v4i16_t __attribute__((ext_vector_type(4))); return __builtin_bit_cast(s16x4, __builtin_amdgcn_ds_read_tr16_b64_v4i16((LAS v4i16_t*)p)); }

template <bool DSA>
__device__ __forceinline__ void attn_qk(LAS unsigned char* lds, const int bo, const int t, const bf16x8 (&qf)[DSA ? 4 : 6], f32x16& p0, f32x16& p1,
                                        const int q0, const int lane, const float sl2, const float (&slc)[16], const LAS unsigned char* mrow) {
    constexpr int DQK = DSA ? 64 : 96;
    const int r32 = lane & 31, hi = lane >> 5;
    if (DSA) { const float b0 = -sl2 * (float)(q0 + r32 - 64 * t - 4 * hi);
#pragma unroll
        for (int r = 0; r < 16; ++r) { p0[r] = b0 + slc[r]; p1[r] = p0[r] + 32.f * sl2; } }
    else { p0 = f32x16{}; p1 = f32x16{}; }
    constexpr int KP = DQK * 2 + 16;
    const LAS unsigned char* kb = lds + bo + r32 * KP + hi * 16;
    bf16x8 kf0[DQK / 16], kf1[DQK / 16];
#pragma unroll
    for (int d0 = 0; d0 < DQK / 16; ++d0) { kf0[d0] = *(const LAS bf16x8*)(kb + d0 * 32); kf1[d0] = *(const LAS bf16x8*)(kb + d0 * 32 + 32 * KP); }
    __builtin_amdgcn_s_setprio(1);
#pragma unroll
    for (int d0 = 0; d0 < DQK / 16; ++d0) { p0 = __builtin_amdgcn_mfma_f32_32x32x16_bf16(kf0[d0], qf[d0], p0, 0, 0, 0); p1 = __builtin_amdgcn_mfma_f32_32x32x16_bf16(kf1[d0], qf[d0], p1, 0, 0, 0); }
    __builtin_amdgcn_s_setprio(0);
    if (DSA) { const u32x2 mw = *(const LAS u32x2*)(mrow + 8 * t); const unsigned w0 = mw.x >> (4 * hi), w1 = mw.y >> (4 * hi);
#pragma unroll
        for (int r = 0; r < 16; ++r) { const unsigned bit = 1u << ((r & 3) + 8 * (r >> 2)); if (!(w0 & bit)) p0[r] = -INFINITY; if (!(w1 & bit)) p1[r] = -INFINITY; } }
    else if (64 * t + 63 > q0) { const int qa = q0 + r32, kbase = 64 * t + 4 * hi;
#pragma unroll
        for (int r = 0; r < 16; ++r) { const int kv = kbase + (r & 3) + 8 * (r >> 2); if (kv > qa) p0[r] = -INFINITY; if (kv + 32 > qa) p1[r] = -INFINITY; } }
}
template <bool DSA>
__device__ __forceinline__ void attn_sm_pv(LAS unsigned char* lds, const int bo, f32x16& p0, f32x16& p1, f32x16 (&o)[2], float& mrun, float& lrun, const int lane, LAS float* wsf) {
    constexpr int DQK = DSA ? 64 : 96, KBYTES = 64 * (DQK * 2 + 16);
    const int r32 = lane & 31, hi = lane >> 5;
    float mx = max3f(p0[0], p1[0], p0[1]), mx2 = max3f(p1[1], p0[2], p1[2]);
#pragma unroll
    for (int r = 3; r < 15; r += 2) { mx = max3f(mx, p0[r], p1[r]); mx2 = max3f(mx2, p0[r + 1], p1[r + 1]); }
    mx = max3f(mx, mx2, fmaxf(p0[15], p1[15]));
    { auto rr = __builtin_amdgcn_permlane32_swap(__float_as_uint(mx), __float_as_uint(mx), false, false); mx = fmaxf(__uint_as_float(rr[0]), __uint_as_float(rr[1])); }
    const float mnew = fmaxf(mrun, mx); const float alpha = fast_exp2(mrun - mnew); mrun = mnew;
    float sum = 0.f;
#pragma unroll
    for (int r = 0; r < 16; ++r) { p0[r] = fast_exp2(p0[r] - mnew); p1[r] = fast_exp2(p1[r] - mnew); sum += p0[r] + p1[r]; }
    lrun = lrun * alpha + sum;
    if (__any(alpha != 1.f)) {
        if (hi == 0) wsf[r32] = alpha;
        asm volatile("s_waitcnt lgkmcnt(0)" ::: "memory");
#pragma unroll
        for (int g = 0; g < 4; ++g) { const f32x4 av = *(const LAS f32x4*)(wsf + 8 * g + 4 * hi);
#pragma unroll
            for (int j = 0; j < 4; ++j) { o[0][4 * g + j] *= av[j]; o[1][4 * g + j] *= av[j]; } }
        asm volatile("s_waitcnt lgkmcnt(0)" ::: "memory");
    }
    bf16x8 pf[4];
#pragma unroll
    for (int s = 0; s < 4; ++s) { u32x4 w;
        if (s < 2) { w.x = pk2(p0[8 * s + 0], p0[8 * s + 1]); w.y = pk2(p0[8 * s + 2], p0[8 * s + 3]); w.z = pk2(p0[8 * s + 4], p0[8 * s + 5]); w.w = pk2(p0[8 * s + 6], p0[8 * s + 7]); }
        else { const int s2 = s - 2; w.x = pk2(p1[8 * s2 + 0], p1[8 * s2 + 1]); w.y = pk2(p1[8 * s2 + 2], p1[8 * s2 + 3]); w.z = pk2(p1[8 * s2 + 4], p1[8 * s2 + 5]); w.w = pk2(p1[8 * s2 + 6], p1[8 * s2 + 7]); }
        pf[s] = __builtin_bit_cast(bf16x8, w); }
    const LAS unsigned char* vb = lds + bo + KBYTES + ((lane >> 4) & 1) * 32 + (lane & 3) * 8 + (4 * hi + ((lane & 15) >> 2)) * 64;
    __builtin_amdgcn_s_setprio(1);
#pragma unroll
    for (int d0 = 0; d0 < 2; ++d0)
#pragma unroll
        for (int ks = 0; ks < 4; ++ks) { const s16x4 lo = vtr(vb + d0 * 4096 + ks * 1024), hh = vtr(vb + d0 * 4096 + ks * 1024 + 512);
            const bf16x8 vf = (bf16x8){lo[0], lo[1], lo[2], lo[3], hh[0], hh[1], hh[2], hh[3]};
            o[d0] = __builtin_amdgcn_mfma_f32_32x32x16_bf16(pf[ks], vf, o[d0], 0, 0, 0); }
    __builtin_amdgcn_s_setprio(0);
}

template <bool DSA>
__device__ __forceinline__ void attn_unit(LAS unsigned char* lds, const Args& a, int b, int hq  , int qblk  , int tid) {
    asm volatile("" : "+v"(tid));
    constexpr int DQK = DSA ? 64 : 96, KP = DQK * 2 + 16, KBYTES = 64 * KP, BUFB = KBYTES + 8192;
    constexpr int WS_OFF = 3 * BUFB;
    unsigned char* ws = a.ws;
    const int lane = tid & 63, r32 = lane & 31, hi = lane >> 5; const int wid = __builtin_amdgcn_readfirstlane(tid >> 6);
    const size_t rowbase = (size_t)b * SEQ;
    const int q0 = DSA ? qblk * 32 : qblk * 256 + wid * 32;
    const int qlast_unit = DSA ? qblk * 32 + 31 : qblk * 256 + 255;
    const int NT = qlast_unit / 64 + 1;
    const int h = DSA ? wid : hq;
    const bf16_t* PROJ = (const bf16_t*)(ws + WS_PROJ); const bf16_t* KVU = (const bf16_t*)(ws + WS_KVU); const bf16_t* KR = (const bf16_t*)(ws + WS_KR); const bf16_t* Qb = (const bf16_t*)(ws + WS_Q);
    const int krow = tid >> 3, kch = tid & 7, krowB = (tid >> 2) & 63, kchB = tid & 3;
    const bf16_t* ksrcA; const bf16_t* ksrcB; const bf16_t* vsrc; size_t kstrideA, kstrideB, vstride;
    if (DSA) { ksrcA = PROJ + (rowbase + krow) * NPROJ + C_DK + kch * 8; kstrideA = (size_t)64 * NPROJ; ksrcB = ksrcA; kstrideB = 0;
               vsrc = PROJ + (rowbase + 16 * (wid & 3) + (lane >> 2)) * NPROJ + C_DV + (wid >> 2) * 32 + (lane & 3) * 8; vstride = (size_t)64 * NPROJ; }
    else { ksrcA = KVU + (rowbase + krow) * 1024 + h * 64 + kch * 8; kstrideA = (size_t)64 * 1024;
           ksrcB = KR + (rowbase + krowB) * 32 + kchB * 8; kstrideB = (size_t)64 * 32;
           vsrc = KVU + (rowbase + 16 * (wid & 3) + (lane >> 2)) * 1024 + 512 + h * 64 + (wid >> 2) * 32 + (lane & 3) * 8; vstride = (size_t)64 * 1024; }
    const bool hasB = (!DSA) && (tid < 256);
    const int kdstA = krow * KP + kch * 16, kdstB = krowB * KP + 128 + kchB * 16, vdst = KBYTES + wid * 1024 + lane * 16;
    bf16x8 qf[DQK / 16];
    { const bf16_t* qp = DSA ? PROJ + (rowbase + q0 + r32) * NPROJ + C_DQ + h * 64 + 8 * hi : Qb + (rowbase + q0 + r32) * 768 + h * 96 + 8 * hi;
#pragma unroll
      for (int d0 = 0; d0 < DQK / 16; ++d0) qf[d0] = *(const bf16x8*)(qp + d0 * 16); }
    constexpr int MOFF = WS_OFF + 2048, MPITCH = 264;
    if (DSA) { const u32x4 mv = *(const u32x4*)((const unsigned*)(ws + WS_MASK) + (rowbase + q0 + (tid >> 4)) * 64 + (tid & 15) * 4);
        LAS unsigned char* md = lds + MOFF + (tid >> 4) * MPITCH + (tid & 15) * 16; *(LAS u32x2*)md = (u32x2){mv.x, mv.y}; *(LAS u32x2*)(md + 8) = (u32x2){mv.z, mv.w}; }
    const LAS unsigned char* mrow = lds + MOFF + r32 * MPITCH;
    const float sl2 = DSA ? exp2f(-(float)(h + 1)) * LOG2E : 0.f;
    float slc[16];
#pragma unroll
    for (int r = 0; r < 16; ++r) slc[r] = sl2 * (float)((r & 3) + 8 * (r >> 2));
    LAS float* wsf = (LAS float*)(lds + WS_OFF) + wid * 64;
    float mrun = -1e30f, lrun = 0.f; f32x16 o[2]; o[0] = f32x16{}; o[1] = f32x16{};
#define AT_LOAD(KA, KB, VV, tt) do { const int tc_ = (tt) < NT ? (tt) : NT - 1; KA = *(const u32x4*)(ksrcA + (size_t)tc_ * kstrideA); if (!DSA) KB = *(const u32x4*)(ksrcB + (size_t)tc_ * kstrideB); \
        VV = *(const u32x4*)(vsrc + (size_t)tc_ * vstride); } while (0)
#define AT_WRITE(KA, KB, VV, bn) do { *(LAS u32x4*)(lds + (bn) + kdstA) = KA; if (hasB) *(LAS u32x4*)(lds + (bn) + kdstB) = KB; *(LAS u32x4*)(lds + (bn) + vdst) = VV; } while (0)
#define AT_ACTIVE(tt) (64 * (tt) <= q0 + 31)
#define AT_ROT() do { const int t_ = bc; bc = bn; bn = bw; bw = t_; } while (0)
    u32x4 kA0, kB0 = (u32x4){0, 0, 0, 0}, vv0, kA1, kB1 = (u32x4){0, 0, 0, 0}, vv1;
    AT_LOAD(kA0, kB0, vv0, 0); AT_LOAD(kA1, kB1, vv1, 1);
    AT_WRITE(kA0, kB0, vv0, 0); AT_WRITE(kA1, kB1, vv1, BUFB);
    AT_LOAD(kA0, kB0, vv0, 2); AT_LOAD(kA1, kB1, vv1, 3);
    __syncthreads();
    int bc = 0, bn = BUFB, bw = 2 * BUFB;
    f32x16 pA0, pA1, pB0, pB1;
    attn_qk<DSA>(lds, 0, 0, qf, pA0, pA1, q0, lane, sl2, slc, mrow);
    for (int t = 0; t < NT; t += 2) {
        if (t + 1 < NT && AT_ACTIVE(t + 1)) attn_qk<DSA>(lds, bn, t + 1, qf, pB0, pB1, q0, lane, sl2, slc, mrow);
        if (AT_ACTIVE(t)) attn_sm_pv<DSA>(lds, bc, pA0, pA1, o, mrun, lrun, lane, wsf);
        if (t + 2 < NT) AT_WRITE(kA0, kB0, vv0, bw);
        AT_LOAD(kA0, kB0, vv0, t + 4);
        __syncthreads(); AT_ROT();
        if (t + 1 >= NT) break;
        if (t + 2 < NT && AT_ACTIVE(t + 2)) attn_qk<DSA>(lds, bn, t + 2, qf, pA0, pA1, q0, lane, sl2, slc, mrow);
        if (AT_ACTIVE(t + 1)) attn_sm_pv<DSA>(lds, bc, pB0, pB1, o, mrun, lrun, lane, wsf);
        if (t + 3 < NT) AT_WRITE(kA1, kB1, vv1, bw);
        AT_LOAD(kA1, kB1, vv1, t + 5);
        __syncthreads(); AT_ROT();
    }
#undef AT_ROT
#undef AT_LOAD
#undef AT_WRITE
#undef AT_ACTIVE
    { auto rr = __builtin_amdgcn_permlane32_swap(__float_as_uint(lrun), __float_as_uint(lrun), false, false); lrun = __uint_as_float(rr[0]) + __uint_as_float(rr[1]); }
    if (hi == 0) wsf[r32] = 1.0f / lrun;
    asm volatile("s_waitcnt lgkmcnt(0)" ::: "memory");
    bf16_t* Ob = (bf16_t*)(ws + WS_CONCAT) + (rowbase + q0) * DM + (DSA ? 512 : 0) + h * 64 + r32;
#pragma unroll
    for (int g = 0; g < 4; ++g) { const f32x4 li = *(const LAS f32x4*)(wsf + 8 * g + 4 * hi);
#pragma unroll
        for (int j = 0; j < 4; ++j) { const int r = 4 * g + j; const int orow = crow(r, hi);
            Ob[(size_t)orow * DM] = (bf16_t)(pk2(o[0][r] * li[j], 0.f) & 0xffffu); Ob[(size_t)orow * DM + 32] = (bf16_t)(pk2(o[1][r] * li[j], 0.f) & 0xffffu); } }
    asm volatile("s_waitcnt lgkmcnt(0)" ::: "memory");
    __syncthreads();
}

__device__ __forceinline__ unsigned f2key(float s) { s = s + 0.0f; const unsigned u = __float_as_uint(s); return (u & 0x80000000u) ? ~u : (u | 0x80000000u); }
#define SBAR0() __builtin_amdgcn_sched_barrier(0)
#ifndef IDX_ITCAP
#define IDX_ITCAP 16
#endif
__device__ __forceinline__ void cnt_ge4(int& cnt, unsigned k0, unsigned k1, unsigned k2, unsigned k3, unsigned t) {
    unsigned long long m0, m1, m2, m3;
    asm("v_cmp_ge_u32_e64 %1, %5, %9\n\tv_cmp_ge_u32_e64 %2, %6, %9\n\tv_cmp_ge_u32_e64 %3, %7, %9\n\tv_cmp_ge_u32_e64 %4, %8, %9\n\t"
        "v_addc_co_u32_e64 %0, %1, %0, 0, %1\n\tv_addc_co_u32_e64 %0, %2, %0, 0, %2\n\tv_addc_co_u32_e64 %0, %3, %0, 0, %3\n\tv_addc_co_u32_e64 %0, %4, %0, 0, %4"
        : "+v"(cnt), "=&s"(m0), "=&s"(m1), "=&s"(m2), "=&s"(m3) : "v"(k0), "v"(k1), "v"(k2), "v"(k3), "v"(t));
}
__device__ __forceinline__ float relu1(float x) { return __builtin_amdgcn_fmed3f(x, 0.f, __builtin_inff()); }
__device__ __forceinline__ float key2f(unsigned k) { const unsigned u = (k & 0x80000000u) ? (k ^ 0x80000000u) : ~k; return __uint_as_float(u); }

__device__ __forceinline__ void idx_unit(LAS unsigned char* lds, const Args& a, int b, int qg, int tid) {
    asm volatile("" : "+v"(tid));
    unsigned char* ws = a.ws; const bf16_t* PROJ = (const bf16_t*)(ws + WS_PROJ); unsigned* MASK = (unsigned*)(ws + WS_MASK);
    const int lane = tid & 63; const int wid = __builtin_amdgcn_readfirstlane(tid >> 6);
    const size_t rowbase = (size_t)b * SEQ; const int hl = lane >> 5, c = lane & 31;
    const int nkeys = 32 * qg + 32;
    const int nstage = (nkeys + 511) & ~511;
    for (int i0 = tid; i0 < nstage * 4; i0 += 4 * NTHREADS) {
        u32x4 v[4];
#pragma unroll
        for (int q = 0; q < 4; ++q) { const int i = i0 + q * NTHREADS; v[q] = *(const u32x4*)(PROJ + (rowbase + (i >> 2)) * NPROJ + C_IK + (i & 3) * 8); }
#pragma unroll
        for (int q = 0; q < 4; ++q) { const int i = i0 + q * NTHREADS; const int r = i >> 2, ch = i & 3; *(LAS u32x4*)(lds + r * 64 + ((ch ^ ((r >> 2) & 3)) * 16)) = v[q]; }
    }
    __syncthreads();
    const int t0 = 32 * qg + 4 * wid;
    const int tqa = t0 + 2 * hl, tqb = tqa + 1; const int ntile = (t0 + 3) / 32 + 1;
    const int aq = 2 * ((c >> 2) & 1) + (c >> 4), ah = (c & 3) + 4 * ((c >> 3) & 1);
    const bf16_t* ap = PROJ + (rowbase + t0 + aq) * NPROJ + C_IQ + ah * 32 + 8 * hl;
    const bf16x8 a0 = *(const bf16x8*)ap, a1 = *(const bf16x8*)(ap + 16);
    float wa[8], wb[8];
    { const u32x4 wv = *(const u32x4*)(PROJ + (rowbase + tqa) * NPROJ + C_IW), wv2 = *(const u32x4*)(PROJ + (rowbase + tqb) * NPROJ + C_IW);
#pragma unroll
      for (int j = 0; j < 4; ++j) { wa[2 * j] = bf_lo(wv[j]); wa[2 * j + 1] = bf_hi(wv[j]); wb[2 * j] = bf_lo(wv2[j]); wb[2 * j + 1] = bf_hi(wv2[j]); } }
    unsigned keyA[64], keyB[64];
    const int sw = (c >> 2) & 3;
    const LAS unsigned char* kb0 = lds + c * 64 + ((hl ^ sw) * 16); const LAS unsigned char* kb1 = lds + c * 64 + (((2 + hl) ^ sw) * 16);
#pragma unroll
    for (int blk = 0; blk < 16; ++blk) {
        if (blk * 4 < ntile) {
#pragma unroll
            for (int j4 = 0; j4 < 4; ++j4) { const int i = blk * 4 + j4;
                if (i < ntile) {
                    const bf16x8 b0 = *(const LAS bf16x8*)(kb0 + i * 2048), b1 = *(const LAS bf16x8*)(kb1 + i * 2048);
                    f32x16 z = f32x16{};
                    z = __builtin_amdgcn_mfma_f32_32x32x16_bf16(a0, b0, z, 0, 0, 0); z = __builtin_amdgcn_mfma_f32_32x32x16_bf16(a1, b1, z, 0, 0, 0);
                    float sa = 0.f, sb = 0.f;
#pragma unroll
                    for (int r = 0; r < 8; ++r) { sa += wa[r] * relu1(z[r]); sb += wb[r] * relu1(z[8 + r]); }
                    const int kidx = 32 * i + c;
                    keyA[i] = (kidx <= tqa) ? f2key(sa) : 0u; keyB[i] = (kidx <= tqb) ? f2key(sb) : 0u;
                } else { keyA[i] = 0u; keyB[i] = 0u; } }
        } else {
#pragma unroll
            for (int j4 = 0; j4 < 4; ++j4) { keyA[blk * 4 + j4] = 0u; keyB[blk * 4 + j4] = 0u; }
        }
        SBAR0();
    }
    const int KqA = tqa + 1 < 256 ? tqa + 1 : 256, KqB = tqb + 1 < 256 ? tqb + 1 : 256;
    unsigned TA = 1u, TB = 1u; int cgeA = KqA, cgeB = KqB;
#define COUNT_GE(ta, tb, ca, cb) do { ca = 0; cb = 0; const unsigned ta_ = (ta), tb_ = (tb); _Pragma("unroll") for (int blk = 0; blk < 8; ++blk) { if (blk * 8 < ntile) { \
        cnt_ge4(ca, keyA[blk * 8 + 0], keyA[blk * 8 + 1], keyA[blk * 8 + 2], keyA[blk * 8 + 3], ta_); cnt_ge4(cb, keyB[blk * 8 + 0], keyB[blk * 8 + 1], keyB[blk * 8 + 2], keyB[blk * 8 + 3], tb_); \
        cnt_ge4(ca, keyA[blk * 8 + 4], keyA[blk * 8 + 5], keyA[blk * 8 + 6], keyA[blk * 8 + 7], ta_); cnt_ge4(cb, keyB[blk * 8 + 4], keyB[blk * 8 + 5], keyB[blk * 8 + 6], keyB[blk * 8 + 7], tb_); } SBAR0(); } \
        ca = half32_sum(ca); cb = half32_sum(cb); } while (0)
    if (t0 + 3 >= 256) {
        unsigned mxA = 0u, mxB = 0u, mnA = 0xffffffffu, mnB = 0xffffffffu;
#pragma unroll
        for (int i = 0; i < 64; ++i) { mxA = max(mxA, keyA[i]); mxB = max(mxB, keyB[i]); mnA = min(mnA, keyA[i] ? keyA[i] : 0xffffffffu); mnB = min(mnB, keyB[i] ? keyB[i] : 0xffffffffu); }
        unsigned loA = ~half32_max(~mnA), hiA = half32_max(mxA), loB = ~half32_max(~mnB), hiB = half32_max(mxB);
        int cloA = tqa + 1, cloB = tqb + 1;
        if (cloA == KqA) hiA = loA;
        if (cloB == KqB) hiB = loB;
        for (int it = 0; it < IDX_ITCAP; ++it) {
            if (__all(loA == hiA && loB == hiB)) break;
            unsigned gA = f2key(0.5f * key2f(loA) + 0.5f * key2f(hiA)), gB = f2key(0.5f * key2f(loB) + 0.5f * key2f(hiB));
            gA = gA <= loA ? loA + 1u : gA; gA = gA > hiA ? hiA : gA; gB = gB <= loB ? loB + 1u : gB; gB = gB > hiB ? hiB : gB;
            const unsigned midA = gA, midB = gB;
            int ca, cb; COUNT_GE(midA, midB, ca, cb);
            if (loA != hiA) { if (ca >= KqA) { loA = midA; cloA = ca; } else hiA = midA - 1u; if (ca == KqA) hiA = midA; }
            if (loB != hiB) { if (cb >= KqB) { loB = midB; cloB = cb; } else hiB = midB - 1u; if (cb == KqB) hiB = midB; }
        }
        for (int ms = 0; ms < 4096; ++ms) {
            if (__all(loA == hiA && loB == hiB)) break;
            unsigned mA = 0u, mB = 0u;
#pragma unroll
            for (int blk = 0; blk < 8; ++blk) { if (blk * 8 < ntile) {
#pragma unroll
                for (int j8 = 0; j8 < 8; ++j8) { const unsigned ka = keyA[blk * 8 + j8], kb = keyB[blk * 8 + j8]; mA = max(mA, ka <= hiA ? ka : 0u); mB = max(mB, kb <= hiB ? kb : 0u); } } SBAR0(); }
            mA = half32_max(mA); mB = half32_max(mB);
            int ca, cb; COUNT_GE(mA, mB, ca, cb);
            if (loA != hiA) { if (ca >= KqA) { loA = mA; hiA = mA; cloA = ca; } else hiA = mA - 1u; }
            if (loB != hiB) { if (cb >= KqB) { loB = mB; hiB = mB; cloB = cb; } else hiB = mB - 1u; }
        }
        TA = loA; TB = loB; cgeA = cloA; cgeB = cloB;
    }
    const bool ties = __any(cgeA != KqA || cgeB != KqB);
    int needA = 0, needB = 0, runA = 0, runB = 0;
    if (ties) { int ca, cb; COUNT_GE(TA + 1u, TB + 1u, ca, cb); needA = KqA - ca; needB = KqB - cb; }
    unsigned mw0 = 0u, mw1 = 0u, mw2 = 0u, mw3 = 0u;
#pragma unroll
    for (int blk = 0; blk < 16; ++blk) {
        if (blk * 4 < ntile) {
#pragma unroll
            for (int j4 = 0; j4 < 4; ++j4) { const int i = blk * 4 + j4;
                bool selA = keyA[i] >= TA && keyA[i] != 0u, selB = keyB[i] >= TB && keyB[i] != 0u;
                if (ties) {
                    const bool eqA = keyA[i] == TA && keyA[i] != 0u, eqB = keyB[i] == TB && keyB[i] != 0u;
                    const unsigned long long balA = __ballot(eqA), balB = __ballot(eqB);
                    const unsigned eA = hl ? (unsigned)(balA >> 32) : (unsigned)balA, eB = hl ? (unsigned)(balB >> 32) : (unsigned)balB;
                    const unsigned below = (1u << c) - 1u;
                    selA = (keyA[i] > TA) || (eqA && (runA + __popc(eA & below) < needA)); selB = (keyB[i] > TB) || (eqB && (runB + __popc(eB & below) < needB));
                    runA += __popc(eA); runB += __popc(eB);
                }
                const unsigned long long sA = __ballot(selA), sB = __ballot(selB);
                if (lane == i) { mw0 = (unsigned)sA; mw2 = (unsigned)(sA >> 32); mw1 = (unsigned)sB; mw3 = (unsigned)(sB >> 32); } }
        }
        SBAR0();
    }
#undef COUNT_GE
    unsigned* mrow = MASK + (rowbase + t0) * 64 + lane;
    mrow[0] = mw0; mrow[64] = mw1; mrow[128] = mw2; mrow[192] = mw3;
    __syncthreads();
}

__device__ __forceinline__ void ln_row(f32x4 (&v)[4], const float* gam, const float* bet, int lane) {
    float s = 0.f;
#pragma unroll
    for (int j = 0; j < 4; ++j) s += (v[j][0] + v[j][1]) + (v[j][2] + v[j][3]);
    const float mean = wave_sum(s) * (1.f / DM); float s2 = 0.f;
#pragma unroll
    for (int j = 0; j < 4; ++j) { v[j] = v[j] - mean; s2 += (v[j][0] * v[j][0] + v[j][1] * v[j][1]) + (v[j][2] * v[j][2] + v[j][3] * v[j][3]); }
    const float rstd = 1.0f / sqrtf(wave_sum(s2) * (1.f / DM) + LN_EPS);
#pragma unroll
    for (int j = 0; j < 4; ++j) { const f32x4 gg = *((const f32x4*)gam + lane + 64 * j), bb = *((const f32x4*)bet + lane + 64 * j); v[j] = v[j] * rstd * gg + bb; }
}

__device__ __forceinline__ void p6_ln1_router(LAS unsigned char* lds, const Args& a, int l, const int tid, const int nrep) {
    const int lane = tid & 63; const int wave = __builtin_amdgcn_readfirstlane(tid >> 6);
    unsigned char* ws = a.ws;
    LAS float* rwt = (LAS float*)lds;
    LAS int* ent_e = (LAS int*)(lds + 65536);
    LAS int* ent_p = ent_e + 128;
    LAS float* bias_l = (LAS float*)(ent_p + 128);
    { f32x4 rv[8];
#pragma unroll
      for (int q = 0; q < 8; ++q) rv[q] = *((const f32x4*)a.router_w + tid + q * NTHREADS);
#pragma unroll
      for (int q = 0; q < 8; ++q) { const int i4 = tid + q * NTHREADS, k = i4 >> 2, e0 = (i4 & 3) * 4;
#pragma unroll
          for (int c = 0; c < 4; ++c) rwt[(e0 + c) * DM + k] = rv[q][c]; } }
    if (tid < 16) bias_l[tid] = a.router_bias[tid];
    if (tid < 128) { ent_e[tid] = -1; ent_p[tid] = 0; }
    __syncthreads();
    const bf16_t* MIX = (const bf16_t*)(ws + WS_MIX); const bf16_t* XBr = (const bf16_t*)(ws + WS_XB); bf16_t* X1B = (bf16_t*)(ws + WS_X1B); float* GATE = (float*)(ws + WS_GATE);
    const float* gam = a.ln1_g + l * DM; const float* bet = a.ln1_b + l * DM;
    const int G = gridDim.x;
    const int ntok = (M / (256 * 8)) * nrep;
    u32x2 xw[4], mw[4];
    { const int m0 = blockIdx.x * 8 + wave;
#pragma unroll
      for (int j = 0; j < 4; ++j) { xw[j] = *((const u32x2*)(XBr + (size_t)m0 * DM) + lane + 64 * j); mw[j] = *((const u32x2*)(MIX + (size_t)m0 * DM) + lane + 64 * j); } }
    for (int it2 = 0; it2 < ntok; ++it2) {
        const int it = it2 & 7;
        const int m = (it * G + blockIdx.x) * 8 + wave;
        u32x2 nxw[4], nmw[4];
        { const int itn = (it2 + 1 < ntok ? it2 + 1 : it2) & 7; const int mn = (itn * G + blockIdx.x) * 8 + wave;
#pragma unroll
          for (int j = 0; j < 4; ++j) { nxw[j] = *((const u32x2*)(XBr + (size_t)mn * DM) + lane + 64 * j); nmw[j] = *((const u32x2*)(MIX + (size_t)mn * DM) + lane + 64 * j); } }
        f32x4 v[4];
#pragma unroll
        for (int j = 0; j < 4; ++j) { v[j][0] = ALPHA * bf_lo(xw[j].x) + bf_lo(mw[j].x); v[j][1] = ALPHA * bf_hi(xw[j].x) + bf_hi(mw[j].x); v[j][2] = ALPHA * bf_lo(xw[j].y) + bf_lo(mw[j].y); v[j][3] = ALPHA * bf_hi(xw[j].y) + bf_hi(mw[j].y); }
        ln_row(v, gam, bet, lane);
#pragma unroll
        for (int j = 0; j < 4; ++j) { u32x2 w; w.x = pk2(v[j][0], v[j][1]); w.y = pk2(v[j][2], v[j][3]); *((u32x2*)(X1B + (size_t)m * DM) + lane + 64 * j) = w; }
        float ps[16];
#pragma unroll
        for (int e = 0; e < 16; ++e) { float s = 0.f;
#pragma unroll
            for (int j = 0; j < 4; ++j) { const f32x4 r = *((const LAS f32x4*)(rwt + e * DM) + lane + 64 * j); s += v[j][0] * r[0] + v[j][1] * r[1] + v[j][2] * r[2] + v[j][3] * r[3]; }
            ps[e] = s; }
        float t8[8], u4[4];
#pragma unroll
        for (int e = 0; e < 8; ++e) { auto rr = __builtin_amdgcn_permlane32_swap(__float_as_uint(ps[e]), __float_as_uint(ps[e + 8]), false, false); t8[e] = __uint_as_float(rr[0]) + __uint_as_float(rr[1]); }
#pragma unroll
        for (int e = 0; e < 4; ++e) { auto rr = __builtin_amdgcn_permlane16_swap(__float_as_uint(t8[e]), __float_as_uint(t8[e + 4]), false, false); u4[e] = __uint_as_float(rr[0]) + __uint_as_float(rr[1]); }
#pragma unroll
        for (int e = 0; e < 4; ++e) { float x = u4[e]; x += dpp_f<0xB1>(x); x += dpp_f<0x4E>(x); x += dpp_f<0x141>(x); x += dpp_f<0x140>(x); u4[e] = x; }
        float lg[16];
#pragma unroll
        for (int e = 0; e < 4; ++e) { const int ub = (int)__float_as_uint(u4[e]);
            lg[e] = __uint_as_float((unsigned)__builtin_amdgcn_readlane(ub, 0)); lg[e + 4] = __uint_as_float((unsigned)__builtin_amdgcn_readlane(ub, 16));
            lg[e + 8] = __uint_as_float((unsigned)__builtin_amdgcn_readlane(ub, 32)); lg[e + 12] = __uint_as_float((unsigned)__builtin_amdgcn_readlane(ub, 48)); }
#pragma unroll
        for (int j = 0; j < 4; ++j) { xw[j] = nxw[j]; mw[j] = nmw[j]; }
        float best_gs = -INFINITY, be_a1 = 0.f, be_a2 = 0.f; int be1 = 0, be2 = 0;
#pragma unroll
        for (int gi = 0; gi < 4; ++gi) {
            float af[4], bs[4];
#pragma unroll
            for (int j = 0; j < 4; ++j) { af[j] = 1.0f / (1.0f + expf(-lg[gi * 4 + j])); bs[j] = af[j] + bias_l[gi * 4 + j]; }
            int i1 = 0; float m1 = bs[0], a1 = af[0];
#pragma unroll
            for (int j = 1; j < 4; ++j) if (bs[j] > m1) { m1 = bs[j]; a1 = af[j]; i1 = j; }
            int i2 = -1; float m2 = -INFINITY, a2 = 0.f;
#pragma unroll
            for (int j = 0; j < 4; ++j) if (j != i1 && bs[j] > m2) { m2 = bs[j]; a2 = af[j]; i2 = j; }
            const float gs = m1 + m2;
            if (gs > best_gs) { best_gs = gs; be1 = gi * 4 + i1; be2 = gi * 4 + i2; be_a1 = a1; be_a2 = a2; }
        }
        if (lane == 0) { const float inv = 1.0f / (be_a1 + be_a2); GATE[(size_t)m * 2] = be_a1 * inv; GATE[(size_t)m * 2 + 1] = be_a2 * inv;
            const int slot = (it * 8 + wave) * 2; ent_e[slot] = be1; ent_p[slot] = m * 2; ent_e[slot + 1] = be2; ent_p[slot + 1] = m * 2 + 1; }
    }
    __syncthreads();
    if (tid < 16) { const int e = tid; int cnt = 0;
        for (int i = 0; i < 128; ++i) cnt += (ent_e[i] == e) ? 1 : 0;
        if (cnt > 0) { int* ctr = (int*)(ws + WS_CTL) + l * 16 + e; int base = atomicAdd(ctr, cnt); int* el = (int*)(ws + WS_ELIST) + ((size_t)l * 16 + e) * 16384;
            for (int i = 0; i < 128; ++i) if (ent_e[i] == e) el[base++] = ent_p[i]; } }
    __syncthreads();
}

__device__ __forceinline__ void p9_ln2(const Args& a, int l, int gw, int NGW, int lane) {
    unsigned char* ws = a.ws; const bf16_t* X1B = (const bf16_t*)(ws + WS_X1B); const bf16_t* Y = (const bf16_t*)(ws + WS_Y); bf16_t* XB = (bf16_t*)(ws + WS_XB);
    const float* gam = a.ln2_g + l * DM; const float* bet = a.ln2_b + l * DM;
    u32x2 xw[4], y0[4], y1[4];
#pragma unroll
    for (int j = 0; j < 4; ++j) { xw[j] = *((const u32x2*)(X1B + (size_t)gw * DM) + lane + 64 * j); y0[j] = *((const u32x2*)(Y + (size_t)(2 * gw) * DM) + lane + 64 * j); y1[j] = *((const u32x2*)(Y + (size_t)(2 * gw + 1) * DM) + lane + 64 * j); }
    for (int m = gw; m < M; m += NGW) {
        u32x2 nxw[4], ny0[4], ny1[4];
        { const int mn = m + NGW < M ? m + NGW : m;
#pragma unroll
          for (int j = 0; j < 4; ++j) { nxw[j] = *((const u32x2*)(X1B + (size_t)mn * DM) + lane + 64 * j); ny0[j] = *((const u32x2*)(Y + (size_t)(2 * mn) * DM) + lane + 64 * j); ny1[j] = *((const u32x2*)(Y + (size_t)(2 * mn + 1) * DM) + lane + 64 * j); } }
        f32x4 v[4];
#pragma unroll
        for (int j = 0; j < 4; ++j) {
            v[j][0] = ALPHA * bf_lo(xw[j].x) + (bf_lo(y0[j].x) + bf_lo(y1[j].x)); v[j][1] = ALPHA * bf_hi(xw[j].x) + (bf_hi(y0[j].x) + bf_hi(y1[j].x));
            v[j][2] = ALPHA * bf_lo(xw[j].y) + (bf_lo(y0[j].y) + bf_lo(y1[j].y)); v[j][3] = ALPHA * bf_hi(xw[j].y) + (bf_hi(y0[j].y) + bf_hi(y1[j].y)); }
#pragma unroll
        for (int j = 0; j < 4; ++j) { xw[j] = nxw[j]; y0[j] = ny0[j]; y1[j] = ny1[j]; }
        ln_row(v, gam, bet, lane);
#pragma unroll
        for (int j = 0; j < 4; ++j) {
            if (l + 1 < DEPTH) { u32x2 w; w.x = pk2(v[j][0], v[j][1]); w.y = pk2(v[j][2], v[j][3]); *((u32x2*)(XB + (size_t)m * DM) + lane + 64 * j) = w; }
            else *((f32x4*)(a.out + (size_t)m * DM) + lane + 64 * j) = v[j]; }
    }
}


#define XB_TMO      128
#define XB_XCNT(j)  (256  + 64 * (j))
#define XB_XSUB(j)  (1280 + 64 * (j))
#define XB_XGEN(j)  (2304 + 64 * (j))
#define XB_TOP      3328
#define XB_TOPGEN   3392
#define XCD_BAR_WORDS 3456
#define XB_SPIN_CAP (1u << 18)
__device__ __forceinline__ unsigned xb_ld(unsigned* p)              { return __hip_atomic_load(p, __ATOMIC_RELAXED, __HIP_MEMORY_SCOPE_AGENT); }
__device__ __forceinline__ unsigned xb_add(unsigned* p, unsigned v) { return __hip_atomic_fetch_add(p, v, __ATOMIC_RELAXED, __HIP_MEMORY_SCOPE_AGENT); }
__device__ __forceinline__ unsigned xb_xcc_id() { return (unsigned)__builtin_amdgcn_s_getreg((3 << 11) | 20) & 0xFu; }
#define XB_SPIN(cond, bar) do { unsigned _sp = 0; while (cond) { __builtin_amdgcn_s_sleep(1); \
    if ((++_sp & 255u) == 0u) { if (xb_ld(&(bar)[XB_TMO])) break; if (_sp > XB_SPIN_CAP) { atomicAdd(&(bar)[XB_TMO], 1u); break; } } } } while (0)
struct XcdBarrier { unsigned* bar; unsigned x; volatile LAS unsigned* st; };
__device__ __forceinline__ XcdBarrier xcd_barrier_post(unsigned* bar, volatile LAS unsigned* st) {
    XcdBarrier b; b.bar = bar; b.x = xb_xcc_id(); b.st = st;
    if (threadIdx.x == 0) (void)xb_add(&bar[XB_XCNT(b.x)], 1u);
    return b;
}
__device__ __forceinline__ void xcd_barrier_complete(unsigned* bar, unsigned x, unsigned& nloc, unsigned& nx) {
    const unsigned G = gridDim.x * gridDim.y * gridDim.z;
    unsigned sum, cnt, mine, sp = 0u;
    for (;;) {
        sum = 0u; cnt = 0u; mine = 0u;
#pragma unroll
        for (unsigned j = 0; j < 16; ++j) { const unsigned c = xb_ld(&bar[XB_XCNT(j)]); sum += c; cnt += (c > 0u) ? 1u : 0u; mine = (j == x) ? c : mine; }
        if (sum == G) break;
        __builtin_amdgcn_s_sleep(1);
        if ((++sp & 255u) == 0u) { if (xb_ld(&bar[XB_TMO])) break; if (sp > XB_SPIN_CAP) { atomicAdd(&bar[XB_TMO], 1u); break; } }
    }
    nloc = mine > 0u ? mine : 1u; nx = cnt > 0u ? cnt : 1u;
}
__device__ __forceinline__ void xcd_barrier(const XcdBarrier& b) {
    asm volatile("s_waitcnt vmcnt(0)" ::: "memory");
    __syncthreads();
    if (threadIdx.x == 0) {
        unsigned* bar = b.bar;
        __builtin_amdgcn_s_waitcnt(0);
        unsigned nloc = b.st[0], nx = b.st[1];
        if (nloc == 0u) { xcd_barrier_complete(bar, b.x, nloc, nx); b.st[0] = nloc; b.st[1] = nx; }
        const unsigned old = xb_add(&bar[XB_XSUB(b.x)], 1u);
        const unsigned gen = old / nloc;
        if (old + 1u == (gen + 1u) * nloc) {
            __builtin_amdgcn_fence(__ATOMIC_RELEASE, "agent");
            asm volatile("s_waitcnt vmcnt(0)" ::: "memory");
            const unsigned og = xb_add(&bar[XB_TOP], 1u);
            const unsigned tg = og / nx;
            if (og + 1u == (tg + 1u) * nx) xb_add(&bar[XB_TOPGEN], 1u);
            else XB_SPIN(xb_ld(&bar[XB_TOPGEN]) == tg, bar);
            __builtin_amdgcn_fence(__ATOMIC_ACQUIRE, "agent");
            xb_add(&bar[XB_XGEN(b.x)], 1u);
            asm volatile("s_waitcnt vmcnt(0)" ::: "memory");
        } else {
            XB_SPIN(xb_ld(&bar[XB_XGEN(b.x)]) == gen, bar);
            __builtin_amdgcn_fence(__ATOMIC_ACQUIRE, "agent");
            asm volatile("s_waitcnt vmcnt(0)" ::: "memory");
        }
    }
    __syncthreads();
}

#ifndef PROJ_MERGED
#define PROJ_MERGED 0
#endif
#ifndef MOE_MERGED
#define MOE_MERGED 1
#endif
constexpr int N_PHASES = 1 + 10 * DEPTH;
#ifndef DUP_MASK
#define DUP_MASK 0
#endif
#define NREP(k) ((((DUP_MASK) >> (k)) & 1) ? (((a.dup_mask >> (k)) & 1) + 1) : 1)

__global__ void __launch_bounds__(NTHREADS, 2) mega_fwd(Args a_param) {
    extern __shared__ __attribute__((aligned(16))) unsigned char lds_raw[];
    LAS unsigned char* const lds0 = (LAS unsigned char*)lds_raw;
    cg::grid_group grid = cg::this_grid();
    const int wave0 = __builtin_amdgcn_readfirstlane((int)threadIdx.x >> 6);
    const int G0 = gridDim.x, bx0 = blockIdx.x;
    volatile LAS unsigned* bar_st = (volatile LAS unsigned*)(lds0 + MISC_OFF + 1024);
    if (threadIdx.x < 4) bar_st[threadIdx.x] = 0u;
    __syncthreads();
    (void)xcd_barrier_post((unsigned*)(a_param.ws + WS_BAR), bar_st);
    typedef const __attribute__((address_space(4))) Args* kargs_t;
#define PHASE_IDS() int G = G0, bx = bx0; unsigned ldsu_ = (unsigned)(uintptr_t)lds0; asm volatile("" : "+s"(G), "+s"(bx), "+s"(ldsu_)); LAS unsigned char* lds = (LAS unsigned char*)(uintptr_t)ldsu_; const int vcu = (G % 8 == 0) ? (bx % 8) * (G / 8) + bx / 8 : bx; const int NGW = G * NWAVES; (void)NGW; (void)vcu; \
        kargs_t ap_ = (kargs_t)__builtin_amdgcn_kernarg_segment_ptr(); asm volatile("" : "+s"(ap_)); Args a; __builtin_memcpy(&a, ap_, sizeof(Args)); unsigned char* ws = a.ws; (void)ws; int tid; asm volatile("v_mbcnt_lo_u32_b32 %0, -1, 0\n\tv_mbcnt_hi_u32_b32 %0, -1, %0" : "=v"(tid)); tid += wave0 * 64; const int lane = tid & 63; const int wave = __builtin_amdgcn_readfirstlane(tid >> 6); const int gw = vcu * NWAVES + wave; (void)lane; (void)gw; \
        LAS float* scr = (LAS float*)(lds + wave * 16384); (void)scr
    const int lo = a_param.ph_lo, hi = a_param.ph_hi;
    if (lo < 0) grid.sync();
#ifdef DBG_ONLY
#define IN(k) ((((k) - 1) % 10 + 1 == DBG_ONLY || ((k) == 0 && DBG_ONLY == 0)) && lo <= (k) && (k) < hi)
#else
#define IN(k) (lo <= (k) && (k) < hi)
#endif
#define SEAM_BAR() do { kargs_t bp_ = (kargs_t)__builtin_amdgcn_kernarg_segment_ptr(); asm volatile("" : "+s"(bp_)); \
        XcdBarrier xb_; xb_.bar = (unsigned*)(bp_->ws + WS_BAR); xb_.x = xb_xcc_id(); xb_.st = (volatile LAS unsigned*)(lds0 + MISC_OFF + 1024); xcd_barrier(xb_); } while (0)
#define SEAM(k) do { if (IN(k) && IN((k) + 1)) { { kargs_t bp_ = (kargs_t)__builtin_amdgcn_kernarg_segment_ptr(); asm volatile("" : "+s"(bp_)); \
        XcdBarrier xb_; xb_.bar = (unsigned*)(bp_->ws + WS_BAR); xb_.x = xb_xcc_id(); xb_.st = (volatile LAS unsigned*)(lds0 + MISC_OFF + 1024); xcd_barrier(xb_); if ((DUP_MASK) & 0x2000) xcd_barrier(xb_); } } } while (0)

    if (IN(0)) { PHASE_IDS(); for (int rep = 0; rep < NREP(10); ++rep) { p0_small_weights(a, scr, gw, NGW, lane); p0_expert_weights(a, 0, scr, gw, NGW, lane); p0_misc(a, gw, NGW, lane); } }
    SEAM(0);
    for (int l = 0; l < DEPTH; ++l) {
        const int P = 1 + 10 * l;
#if PROJ_MERGED
        if (IN(P + 0)) { PHASE_IDS();
            pg8::ProjSched S; S.XB = (const bf16_t*)(ws + WS_XB); S.PROJ = (const bf16_t*)(ws + WS_PROJ); S.WIN = (const bf16_t*)(ws + WS_WIN) + (size_t)l * NPROJ * DM;
            S.WQUP = (const bf16_t*)(ws + WS_WQUP) + (size_t)l * 768 * 384; S.WKV = (const bf16_t*)(ws + WS_WKV) + (size_t)l * 1024 * 256;
            S.c01 = (unsigned*)(ws + WS_CTL) + 768 + l * 128; S.c12 = S.c01 + 64; S.G = G; S.v = bx;
            pg8::EpiProj E0{(bf16_t*)(ws + WS_PROJ), NPROJ, (float*)(ws + WS_RS), (bf16_t*)(ws + WS_KR), (const float*)(ws + WS_ROPE), (const float*)(ws + WS_ROPE) + SEQ * 16, true};
            pg8::EpiQRope E1{(bf16_t*)(ws + WS_Q), 768, (const float*)(ws + WS_RS), (const float*)(ws + WS_ROPE), (const float*)(ws + WS_ROPE) + SEQ * 16};
            pg8::EpiBf16 E2{(bf16_t*)(ws + WS_KVU), 1024, (const float*)(ws + WS_RS), 12, 2, 1.f / 256.f};
            pg8::gemm_stream(lds, S, E0, E1, E2, tid);
        }
        if (IN(P + 0) && IN(P + 3)) SEAM_BAR();
#else
        if (IN(P + 0)) { PHASE_IDS();
            pg8::DenseSched S; S.A = (const bf16_t*)(ws + WS_XB); S.Bt = (const bf16_t*)(ws + WS_WIN) + (size_t)l * NPROJ * DM; S.lda = DM; S.K = DM; S.so.init(M, NPROJ, G, bx, NREP(0));
            pg8::EpiProj E{(bf16_t*)(ws + WS_PROJ), NPROJ, (float*)(ws + WS_RS), (bf16_t*)(ws + WS_KR), (const float*)(ws + WS_ROPE), (const float*)(ws + WS_ROPE) + SEQ * 16, false};
            pg8::gemm_phase(lds, S, E, tid);
        }
        if (IN(P + 0) && IN(P + 2)) SEAM_BAR();
        if (IN(P + 2)) { PHASE_IDS();
            { pg8::DenseSched S; S.A = (const bf16_t*)(ws + WS_PROJ) + C_QA; S.Bt = (const bf16_t*)(ws + WS_WQUP) + (size_t)l * 768 * 384; S.lda = NPROJ; S.K = 384; S.so.init(M, 768, G, bx - 64, NREP(2));
              pg8::EpiQRope E{(bf16_t*)(ws + WS_Q), 768, (const float*)(ws + WS_RS), (const float*)(ws + WS_ROPE), (const float*)(ws + WS_ROPE) + SEQ * 16};
              pg8::gemm_phase(lds, S, E, tid); }
            { pg8::DenseSched S; S.A = (const bf16_t*)(ws + WS_PROJ) + C_KVA; S.Bt = (const bf16_t*)(ws + WS_WKV) + (size_t)l * 1024 * 256; S.lda = NPROJ; S.K = 256; S.so.init(M, 1024, G, bx, NREP(2));
              pg8::EpiBf16 E{(bf16_t*)(ws + WS_KVU), 1024, (const float*)(ws + WS_RS), 12, 2, 1.f / 256.f};
              pg8::gemm_phase(lds, S, E, tid); }
        }
        SEAM(P + 2);
#endif
        if (IN(P + 3)) { PHASE_IDS();
#ifndef DBG_NOMLA
            for (int rep = 0; rep < NREP(3); ++rep)
            for (int u = vcu; u < 256; u += G) { const int bh = u >> 2, s = u & 3;
                for (int k = 0; k < 2; ++k) attn_unit<false>(lds, a, bh >> 3, bh & 7, k ? s : 7 - s, tid); }
#endif
#ifndef DBG_NOIDX
            for (int uu = vcu; uu < 256 * NREP(11); uu += G) { const int u = uu & 255; const int b = u >> 5, s = u & 31;
                for (int k = 0; k < 2; ++k) idx_unit(lds, a, b, k ? s : 63 - s, tid); }
#endif
        }
        SEAM(P + 3);
        if (IN(P + 4)) { PHASE_IDS();
            for (int uu = vcu; uu < 256 * NREP(4); uu += G) { const int u = uu & 255; const int b = u >> 5, s = u & 31;
                for (int k = 0; k < 2; ++k) attn_unit<true>(lds, a, b, 0, k ? s : 63 - s, tid); }
        }
        SEAM(P + 4);
        if (IN(P + 5)) { PHASE_IDS();
            pg8::DenseSched S; S.A = (const bf16_t*)(ws + WS_CONCAT); S.Bt = (const bf16_t*)(ws + WS_WO) + (size_t)l * DM * DM; S.lda = DM; S.K = DM; S.so.init(M, DM, G, bx, NREP(5));
            pg8::EpiBf16 E{(bf16_t*)(ws + WS_MIX), DM, nullptr, 0, 0, 0.f};
            pg8::gemm_phase(lds, S, E, tid);
        }
        SEAM(P + 5);
        if (IN(P + 6)) { PHASE_IDS(); p6_ln1_router(lds, a, l, tid, NREP(6)); }
        SEAM(P + 6);
        if (IN(P + 7) || IN(P + 8)) { PHASE_IDS();
            LAS int* tstart = (LAS int*)(lds + MISC_OFF); LAS int* ecnt = tstart + 32;
            if (tid < 16) ecnt[tid] = __hip_atomic_load((const int*)(ws + WS_CTL) + l * 16 + tid, __ATOMIC_RELAXED, __HIP_MEMORY_SCOPE_AGENT);
            __syncthreads();
            if (tid == 0) { int acc = 0;
                for (int e = 0; e < 16; ++e) { tstart[e] = acc; acc += (ecnt[e] + 255) >> 8; }
                tstart[16] = acc; }
            __syncthreads();
#if MOE_MERGED
            { pg8::Moe12Sched S; S.X1B = (const bf16_t*)(ws + WS_X1B); S.H = (const bf16_t*)(ws + WS_H); S.WGU = (const bf16_t*)(ws + WS_WGU); S.WD = (const bf16_t*)(ws + WS_WD);
              S.elist = (const int*)(ws + WS_ELIST) + (size_t)l * 16 * 16384; S.tstart = tstart; S.ecnt = ecnt; S.ready = (unsigned*)(ws + WS_CTL) + 256 + l * 256; S.G = G; S.v = vcu;
              pg8::EpiMoe1 E1{(bf16_t*)(ws + WS_H), (const float*)(ws + WS_GATE)}; pg8::EpiMoe2 E2{(bf16_t*)(ws + WS_Y)};
              pg8::gemm_stream(lds, S, E1, E2, E2, tid); }
#else
            if (IN(P + 7)) {
                pg8::MoeSched S; S.A = (const bf16_t*)(ws + WS_X1B); S.Bt = (const bf16_t*)(ws + WS_WGU); S.lda = DM; S.K = DM; S.b_estride = (size_t)DM * DM * 2; S.elist = (const int*)(ws + WS_ELIST) + (size_t)l * 16 * 16384; S.rsh = 1;
                S.tstart = tstart; S.ecnt = ecnt; S.G = G; S.v = vcu; S.nrep = NREP(7);
                pg8::EpiMoe1 E{(bf16_t*)(ws + WS_H), (const float*)(ws + WS_GATE)};
                pg8::gemm_phase(lds, S, E, tid);
            }
            SEAM(P + 7);
            if (IN(P + 8)) {
                pg8::MoeSched S; S.A = (const bf16_t*)(ws + WS_H); S.Bt = (const bf16_t*)(ws + WS_WD); S.lda = DFF; S.K = DFF; S.b_estride = (size_t)DM * DFF * 2; S.elist = (const int*)(ws + WS_ELIST) + (size_t)l * 16 * 16384; S.rsh = 0;
                S.tstart = tstart; S.ecnt = ecnt; S.G = G; S.v = vcu; S.nrep = NREP(8);
                pg8::EpiMoe2 E{(bf16_t*)(ws + WS_Y)};
                pg8::gemm_phase(lds, S, E, tid);
            }
#endif
        } else { SEAM(P + 7); }
        SEAM(P + 8);
        if (IN(P + 9)) { PHASE_IDS(); for (int rep = 0; rep < NREP(9); ++rep) p9_ln2(a, l, gw, NGW, lane); if (l + 1 < DEPTH) for (int rep = 0; rep < NREP(12); ++rep) p0_expert_weights(a, l + 1, scr, gw, NGW, lane); }
        SEAM(P + 9);
    }
#undef IN
#undef SEAM
}

#ifndef MK_PER_PHASE
#define MK_PER_PHASE 0
#endif
extern "C" void kernel_launch(void* const* d_in, const int* in_sizes, int n_in, void* d_out, int out_size, void* d_ws, size_t ws_size, hipStream_t stream) {
    static int grid_blocks = 0;
    if (grid_blocks == 0) {
        if (n_in != 17 || in_sizes[0] != M * DM || out_size != M * DM || ws_size < WS_END) { fprintf(stderr, "kernel_launch: unexpected shapes / workspace (n_in %d, in0 %d, out %d, ws %zu); nothing launched\n", n_in, n_in > 0 ? in_sizes[0] : -1, out_size, ws_size); grid_blocks = -1; return; }
        int dev = 0, cus = 0, per_cu = 0;
        (void)hipGetDevice(&dev);
        (void)hipDeviceGetAttribute(&cus, hipDeviceAttributeMultiprocessorCount, dev);
        (void)hipFuncSetAttribute((const void*)mega_fwd, hipFuncAttributeMaxDynamicSharedMemorySize, LDS_BYTES);
        (void)hipOccupancyMaxActiveBlocksPerMultiprocessor(&per_cu, (const void*)mega_fwd, NTHREADS, LDS_BYTES);
        fprintf(stderr, "kernel_launch: cus %d per_cu %d ws_size %zu\n", cus, per_cu, ws_size);
        if (per_cu < 1 || cus < 1) { grid_blocks = -1; return; }
        grid_blocks = cus > 256 ? 256 : cus;
    }
    if (grid_blocks < 0) return;
    (void)hipMemsetAsync((unsigned char*)d_ws + WS_BAR, 0, XCD_BAR_WORDS * 4, stream);
    Args a{};
    a.x = (const float*)d_in[0]; a.w_in = (const float*)d_in[1]; a.q_norm_g = (const float*)d_in[2]; a.w_q_up = (const float*)d_in[3]; a.kv_norm_g = (const float*)d_in[4];
    a.w_uk = (const float*)d_in[5]; a.w_uv = (const float*)d_in[6]; a.w_o = (const float*)d_in[7]; a.ln1_g = (const float*)d_in[8]; a.ln1_b = (const float*)d_in[9];
    a.router_w = (const float*)d_in[10]; a.router_bias = (const float*)d_in[11]; a.w_gate = (const float*)d_in[12]; a.w_up = (const float*)d_in[13]; a.w_down = (const float*)d_in[14];
    a.ln2_g = (const float*)d_in[15]; a.ln2_b = (const float*)d_in[16];
    a.out = (float*)d_out; a.ws = (unsigned char*)d_ws;
#if MK_PER_PHASE
    for (int p = 0; p < N_PHASES; ++p) { a.ph_lo = p; a.ph_hi = p + 1; void* args[] = {&a};
        hipError_t e = hipLaunchCooperativeKernel((const void*)mega_fwd, dim3(grid_blocks), dim3(NTHREADS), args, LDS_BYTES, stream);
        if (e != hipSuccess) { fprintf(stderr, "launch %d failed: %s\n", p, hipGetErrorString(e)); break; } }
#else
    a.ph_lo = 0; a.ph_hi = N_PHASES; a.dup_mask = DUP_MASK; void* args[] = {&a};
    hipError_t e = hipLaunchCooperativeKernel((const void*)mega_fwd, dim3(grid_blocks), dim3(NTHREADS), args, LDS_BYTES, stream);
    if (e != hipSuccess) fprintf(stderr, "cooperative launch failed: %s (grid %d)\n", hipGetErrorString(e), grid_blocks);
#endif
}
```

```cpp
#include <hip/hip_runtime.h>
#include <hip/hip_cooperative_groups.h>
#include <cstdio>
#include <cstdint>
namespace cg = cooperative_groups;

#define LAS __attribute__((address_space(3)))
typedef unsigned short bf16_t;
typedef short bf16x8 __attribute__((ext_vector_type(8)));
typedef short s16x4 __attribute__((ext_vector_type(4)));
typedef float f32x2 __attribute__((ext_vector_type(2)));
typedef float f32x4 __attribute__((ext_vector_type(4)));
typedef float f32x16 __attribute__((ext_vector_type(16)));
typedef unsigned u32x2 __attribute__((ext_vector_type(2)));
typedef unsigned u32x4 __attribute__((ext_vector_type(4)));
typedef __bf16 bf16x2_t __attribute__((ext_vector_type(2)));

constexpr int DM = 1024, NBATCH = 8, SEQ = 2048, M = NBATCH * SEQ, DEPTH = 2;
constexpr int NPROJ = 1792;
constexpr int IN_COLS = 1608;
constexpr int C_QA = 0, C_KVA = 384, C_KR = 640, C_DQ = 672, C_DK = 1184, C_DV = 1248, C_IQ = 1312, C_IK = 1568, C_IW = 1600;
constexpr int NEXP = 16, DFF = 512;
constexpr float ALPHA = 1.4142135623730951f;
constexpr float LN_EPS = 1e-5f, RMS_EPS = 1e-6f;
constexpr float LOG2E = 1.4426950408889634f;
constexpr float MLA_QSCALE = 0.10206207261596575f * LOG2E;
constexpr float DSA_QSCALE = 0.125f * LOG2E;
constexpr int NTHREADS = 512, NWAVES = 8;
constexpr int LDS_BYTES = 147456;
constexpr int RING_BYTES = 131072;
constexpr int MISC_OFF = RING_BYTES;

constexpr size_t MiB = 1u << 20;
constexpr size_t WS_CTL   = 0;
constexpr size_t WS_BAR   = 65536;
constexpr size_t WS_ELIST = 1 * MiB;
constexpr size_t WS_GATE  = 3 * MiB;
constexpr size_t WS_ROPE  = 3 * MiB + 512 * 1024;
constexpr size_t WS_MASK  = 4 * MiB;
constexpr size_t WS_WIN   = 8 * MiB;
constexpr size_t WS_WQUP  = 15 * MiB;
constexpr size_t WS_WKV   = 17 * MiB;
constexpr size_t WS_WO    = 18 * MiB;
constexpr size_t WS_WGU   = 22 * MiB;
constexpr size_t WS_WD    = 54 * MiB;
constexpr size_t WS_R1    = 70 * MiB;
constexpr size_t WS_R2    = 134 * MiB;
constexpr size_t WS_R3    = 166 * MiB;
constexpr size_t WS_R4    = 198 * MiB;
constexpr size_t WS_R5    = 230 * MiB;
constexpr size_t WS_END   = 262 * MiB;
constexpr size_t WS_PROJ = WS_R1, WS_MIX = WS_R1, WS_X1B = WS_R3, WS_Y = WS_R1;
constexpr size_t WS_XB = WS_R5, WS_Q = WS_R2, WS_KR = WS_R2 + 24 * MiB, WS_RS = WS_R2 + 25 * MiB  , WS_H = WS_R2;
constexpr size_t WS_KVU = WS_R3, WS_CONCAT = WS_R4;

__device__ __forceinline__ unsigned pk2(float lo, float hi) { f32x2 v = {lo, hi}; bf16x2_t b = __builtin_convertvector(v, bf16x2_t); return __builtin_bit_cast(unsigned, b); }
__device__ __forceinline__ float bf_lo(unsigned w) { return __uint_as_float(w << 16); }
__device__ __forceinline__ float bf_hi(unsigned w) { return __uint_as_float(w & 0xffff0000u); }
__device__ __forceinline__ float bf2f(bf16_t h) { return __uint_as_float((unsigned)h << 16); }
template <int CTRL> __device__ __forceinline__ float dpp_f(float x) { return __builtin_bit_cast(float, __builtin_amdgcn_mov_dpp(__builtin_bit_cast(int, x), CTRL, 0xf, 0xf, true)); }
template <int CTRL> __device__ __forceinline__ int dpp_i(int x) { return __builtin_amdgcn_mov_dpp(x, CTRL, 0xf, 0xf, true); }
__device__ __forceinline__ float wave_sum(float v) {
    v += dpp_f<0xB1>(v); v += dpp_f<0x4E>(v); v += dpp_f<0x141>(v); v += dpp_f<0x140>(v);
    { auto s = __builtin_amdgcn_permlane16_swap(__float_as_uint(v), __float_as_uint(v), false, false); v = __uint_as_float(s[0]) + __uint_as_float(s[1]); }
    { auto t = __builtin_amdgcn_permlane32_swap(__float_as_uint(v), __float_as_uint(v), false, false); v = __uint_as_float(t[0]) + __uint_as_float(t[1]); }
    return v;
}
__device__ __forceinline__ int half32_sum(int v) {
    v += dpp_i<0xB1>(v); v += dpp_i<0x4E>(v); v += dpp_i<0x141>(v); v += dpp_i<0x140>(v);
    auto s = __builtin_amdgcn_permlane16_swap((unsigned)v, (unsigned)v, false, false); return (int)(s[0] + s[1]);
}
__device__ __forceinline__ unsigned half32_max(unsigned v) {
    v = max(v, (unsigned)dpp_i<0xB1>((int)v)); v = max(v, (unsigned)dpp_i<0x4E>((int)v)); v = max(v, (unsigned)dpp_i<0x141>((int)v)); v = max(v, (unsigned)dpp_i<0x140>((int)v));
    auto s = __builtin_amdgcn_permlane16_swap(v, v, false, false); return max(s[0], s[1]);
}
__device__ __forceinline__ float fast_exp2(float x) { return __builtin_amdgcn_exp2f(x); }

namespace pg8 {
constexpr int BM = 256, BK = 64, HALF = 128, HTB = HALF * BK * 2, NXCD = 8, WGM = 8;
__device__ __forceinline__ int lds_byte(int r, int c) { const int st = (r >> 4) * 2 + (c >> 5), rr = r & 15, cc = c & 31, ob = rr * 64 + cc * 2; return st * 1024 + (ob ^ (((ob >> 9) & 1) << 5)); }
__device__ __forceinline__ void stage_rc(int b, int& R, int& C) { const int st = b / 1024, sb = b % 1024, swz = sb ^ (((sb >> 9) & 1) << 5); R = (st >> 1) * 16 + swz / 64; C = (st & 1) * 32 + (swz % 64) / 2; }
__device__ __forceinline__ int perm32(int rho) { const int n = rho >> 4, i = rho & 15; return 8 * (i >> 2) + 4 * n + (i & 3); }

struct Unit { int pm, pn, e, nvalid; };

struct StaticOrder {
    int nM, nN, nwg, G, c, nrep;
    __device__ void init(int Mrows, int N, int G_, int c_, int nrep_ = 1) { nM = Mrows / BM; nN = N / BM; nwg = nM * nN; G = G_; c = c_; nrep = nrep_; }
    __device__ bool next(int i, Unit& u) const {
        long L = (long)i * G + c; if (c < 0 || L >= (long)nwg * nrep) return false;
        L %= nwg;
        int wgid = (int)L; { const int q = nwg / NXCD, r = nwg % NXCD, xcd = wgid % NXCD, off = wgid / NXCD; wgid = (xcd < r ? xcd * (q + 1) : r * (q + 1) + (xcd - r) * q) + off; }
        const int nig = WGM * nN, gid = wgid / nig, fm = gid * WGM, gsz = (nM - fm) < WGM ? (nM - fm) : WGM;
        u.pm = fm + ((wgid % nig) % gsz); u.pn = (wgid % nig) / gsz; u.e = 0; u.nvalid = 256; return true;
    }
};
struct DenseSched {
    static constexpr bool GATHER = false;
    const bf16_t* A; const bf16_t* Bt; int lda, K; StaticOrder so;
    __device__ __forceinline__ bool next(int i, Unit& u) const { return so.next(i, u); }
    __device__ __forceinline__ const char* a_base(const Unit& u) const { return (const char*)A + (size_t)u.pm * BM * lda * 2; }
    __device__ __forceinline__ const char* b_base(const Unit& u) const { return (const char*)Bt + (size_t)u.pn * BM * K * 2; }
    __device__ __forceinline__ unsigned a_off(const Unit&, int r) const { return (unsigned)r * (unsigned)lda * 2u; }
};
struct MoeSched {
    static constexpr bool GATHER = true;
    const bf16_t* A; const bf16_t* Bt; int lda, K; size_t b_estride; const int* elist; int rsh;
    const LAS int* tstart; const LAS int* ecnt; int G, v, nrep;
    __device__ __forceinline__ bool next(int i, Unit& u) const {
        int L = i * G + v; const int total = tstart[16] * 4; if (L >= total * nrep) return false;
        L %= total;
        const int mt = L >> 2; u.pn = L & 3; int e = 0;
#pragma unroll
        for (int k = 1; k < 16; ++k) if (mt >= tstart[k]) e = k;
        e = __builtin_amdgcn_readfirstlane(e);
        u.e = e; u.pm = __builtin_amdgcn_readfirstlane(mt - tstart[e]);
        int nv = ecnt[e] - u.pm * 256; nv = nv > 256 ? 256 : nv; u.nvalid = __builtin_amdgcn_readfirstlane(nv); return true;
    }
    __device__ __forceinline__ const char* a_base(const Unit&) const { return (const char*)A; }
    __device__ __forceinline__ const char* b_base(const Unit& u) const { return (const char*)Bt + (size_t)u.e * b_estride + (size_t)u.pn * BM * K * 2; }
    __device__ __forceinline__ int row_id(const Unit& u, int r) const { const int rr = r < u.nvalid ? r : 0; return elist[u.e * 16384 + u.pm * 256 + rr]; }
    __device__ __forceinline__ unsigned a_off(const Unit& u, int r) const { return (unsigned)(row_id(u, r) >> rsh) * (unsigned)lda * 2u; }
};

template <class Epi, class Sched>
__device__ __forceinline__ void gemm_phase(LAS unsigned char* lds, const Sched& S, const Epi& E, const int tid) {
    const int wid = __builtin_amdgcn_readfirstlane(tid >> 6), lane = tid & 63, wr = wid >> 2, wc = wid & 3, fr = lane & 15, fq = lane >> 4;
    const int K = S.K, nt = K / BK;
    int RA[2], CA[2]; unsigned voffB[2];
#pragma unroll
    for (int i = 0; i < 2; ++i) { int R, C; stage_rc(tid * 16 + i * 8192, R, C); const int Rb = Epi::PERM ? ((R & ~31) + perm32(R & 31)) : R;
        RA[i] = R; CA[i] = C; voffB[i] = (unsigned)(Rb * K + C) * 2u; }
    const size_t kstep = (size_t)(BK * 2);
    const size_t hstepB = (size_t)HALF * K * 2;
    const unsigned ldsw = (unsigned)wid * 1024u;
    const int aoff = lds_byte(wr * 64 + fr, fq * 8), boff = lds_byte(wc * 32 + fr, fq * 8);
#define PG8_SA(b, h) (((b) * 2 + (h)) * HTB)
#define PG8_SB(b, h) ((4 + (b) * 2 + (h)) * HTB)
#define PG8_STAGE2(bufoff, gbase, v0, v1) do { \
        __builtin_amdgcn_global_load_lds((const unsigned*)((const char*)(gbase) + (v0)), (LAS unsigned*)(lds + (bufoff) + ldsw), 16, 0, 0); \
        __builtin_amdgcn_global_load_lds((const unsigned*)((const char*)(gbase) + (v1)), (LAS unsigned*)(lds + (bufoff) + ldsw + 8192), 16, 0, 0); } while (0)
#define PG8_STAGEB(bufoff, gbase) PG8_STAGE2(bufoff, gbase, voffB[0], voffB[1])
#define PG8_LDA(dst, b, h) do { _Pragma("unroll") for (int m = 0; m < 4; ++m) _Pragma("unroll") for (int k = 0; k < 2; ++k) dst[m][k] = *(const LAS bf16x8*)(lds + PG8_SA(b, h) + aoff + m * 2048 + k * 1024); } while (0)
#define PG8_LDB(dst, b, h) do { _Pragma("unroll") for (int n = 0; n < 2; ++n) _Pragma("unroll") for (int k = 0; k < 2; ++k) dst[n][k] = *(const LAS bf16x8*)(lds + PG8_SB(b, h) + boff + n * 2048 + k * 1024); } while (0)
#define PG8_MMA(ai, bj, At, Bt) do { __builtin_amdgcn_s_setprio(1); _Pragma("unroll") for (int m = 0; m < 4; ++m) _Pragma("unroll") for (int n = 0; n < 2; ++n) _Pragma("unroll") for (int k = 0; k < 2; ++k) \
        acc[ai][bj][m][n] = __builtin_amdgcn_mfma_f32_16x16x32_bf16(Bt[n][k], At[m][k], acc[ai][bj][m][n], 0, 0, 0); __builtin_amdgcn_s_setprio(0); } while (0)
#define PG8_WAIT_V(n) asm volatile("s_waitcnt vmcnt(" #n ")" ::: "memory")
#define PG8_WAIT_L(n) asm volatile("s_waitcnt lgkmcnt(" #n ")" ::: "memory")
#define PG8_BAR __builtin_amdgcn_s_barrier()
#define PG8_SCHED __builtin_amdgcn_sched_barrier(0)
    Unit cur, nxt; int ui = 0;
    if (!S.next(0, cur)) return;
    f32x4 acc[2][2][4][2];
#pragma unroll
    for (int a = 0; a < 2; ++a)
#pragma unroll
        for (int b = 0; b < 2; ++b)
#pragma unroll
            for (int m = 0; m < 4; ++m)
#pragma unroll
                for (int n = 0; n < 2; ++n) acc[a][b][m][n] = (f32x4){0.f, 0.f, 0.f, 0.f};
    bf16x8 At[4][2], B0[2][2], B1[2][2];
    const char* cA = S.a_base(cur); const char* cB = S.b_base(cur);
    unsigned vc00, vc01, vc10, vc11, vn00, vn01, vn10, vn11;
    vc00 = S.a_off(cur, RA[0]) + CA[0] * 2; vc01 = S.a_off(cur, RA[1]) + CA[1] * 2; vc10 = S.a_off(cur, HALF + RA[0]) + CA[0] * 2; vc11 = S.a_off(cur, HALF + RA[1]) + CA[1] * 2;
    PG8_STAGEB(PG8_SB(0, 0), cB); PG8_STAGEB(PG8_SB(0, 1), cB + hstepB); PG8_STAGE2(PG8_SA(0, 0), cA, vc00, vc01); PG8_STAGE2(PG8_SA(0, 1), cA, vc10, vc11);
    if (wr == 1) PG8_BAR;
    PG8_WAIT_V(2); PG8_BAR;
    PG8_STAGEB(PG8_SB(1, 0), cB + kstep); PG8_STAGE2(PG8_SA(1, 0), cA + kstep, vc00, vc01); PG8_STAGEB(PG8_SB(1, 1), cB + hstepB + kstep);
    PG8_WAIT_V(6); PG8_BAR;
    for (;;) {
        const bool has_next = S.next(ui + 1, nxt);
        const char* nA = has_next ? S.a_base(nxt) : cA; const char* nB = has_next ? S.b_base(nxt) : cB;
        if (Sched::GATHER) {
            if (has_next) { vn00 = S.a_off(nxt, RA[0]) + CA[0] * 2; vn01 = S.a_off(nxt, RA[1]) + CA[1] * 2; vn10 = S.a_off(nxt, HALF + RA[0]) + CA[0] * 2; vn11 = S.a_off(nxt, HALF + RA[1]) + CA[1] * 2; }
            else { vn00 = vc00; vn01 = vc01; vn10 = vc10; vn11 = vc11; }
        } else { vn00 = vc00; vn01 = vc01; vn10 = vc10; vn11 = vc11; }
        for (int t = 0; t < nt; t += 2) {
            const bool last = (t == nt - 2);
            const char* a1 = cA + (size_t)(t + 1) * kstep;
            const char* a2 = last ? nA : cA + (size_t)(t + 2) * kstep; const char* b2 = last ? nB : cB + (size_t)(t + 2) * kstep;
            const char* a3 = a2 + kstep; const char* b3 = b2 + kstep;
            unsigned w00 = vc00, w01 = vc01, w10 = vc10, w11 = vc11;
            if (Sched::GATHER) { if (last) { w00 = vn00; w01 = vn01; w10 = vn10; w11 = vn11; } }
            PG8_LDB(B0, 0, 0); PG8_LDB(B1, 0, 1); PG8_SCHED; PG8_LDA(At, 0, 0); PG8_STAGE2(PG8_SA(1, 1), a1, vc10, vc11);
            PG8_WAIT_V(8); PG8_WAIT_L(0); PG8_BAR; PG8_MMA(0, 0, At, B0); PG8_MMA(0, 1, At, B1); PG8_BAR; PG8_SCHED;
            PG8_LDA(At, 0, 1); PG8_STAGEB(PG8_SB(0, 0), b2); PG8_STAGEB(PG8_SB(0, 1), b2 + hstepB); PG8_STAGE2(PG8_SA(0, 0), a2, w00, w01);
            PG8_WAIT_V(8); PG8_WAIT_L(0); PG8_BAR; PG8_MMA(1, 0, At, B0); PG8_MMA(1, 1, At, B1); PG8_BAR; PG8_SCHED;
            PG8_LDB(B0, 1, 0); PG8_LDB(B1, 1, 1); PG8_SCHED; PG8_LDA(At, 1, 0); PG8_STAGE2(PG8_SA(0, 1), a2, w10, w11);
            PG8_WAIT_V(8); PG8_WAIT_L(0); PG8_BAR; PG8_MMA(0, 0, At, B0); PG8_MMA(0, 1, At, B1); PG8_BAR; PG8_SCHED;
            PG8_LDA(At, 1, 1); PG8_STAGEB(PG8_SB(1, 0), b3); PG8_STAGEB(PG8_SB(1, 1), b3 + hstepB); PG8_STAGE2(PG8_SA(1, 0), a3, w00, w01);
            PG8_WAIT_V(8); PG8_WAIT_L(0); PG8_BAR; PG8_MMA(1, 0, At, B0); PG8_MMA(1, 1, At, B1); PG8_BAR; PG8_SCHED;
        }
        if (wr == 0) PG8_BAR;
        { int ln_; asm volatile("v_mbcnt_lo_u32_b32 %0, -1, 0\n\tv_mbcnt_hi_u32_b32 %0, -1, %0" : "=v"(ln_));
          E(acc, cur, S, wr, wc, ln_ & 15, ln_ >> 4); }
        if (!has_next) break;
#pragma unroll
        for (int a = 0; a < 2; ++a)
#pragma unroll
            for (int b = 0; b < 2; ++b)
#pragma unroll
                for (int m = 0; m < 4; ++m)
#pragma unroll
                    for (int n = 0; n < 2; ++n) acc[a][b][m][n] = (f32x4){0.f, 0.f, 0.f, 0.f};
        cur = nxt; cA = nA; cB = nB; ++ui; vc00 = vn00; vc01 = vn01; vc10 = vn10; vc11 = vn11;
        if (wr == 1) PG8_BAR;
    }
    PG8_WAIT_V(0);
    PG8_BAR;
#undef PG8_SA
#undef PG8_SB
#undef PG8_STAGE2
#undef PG8_STAGEB
#undef PG8_LDA
#undef PG8_LDB
#undef PG8_MMA
#undef PG8_WAIT_V
#undef PG8_WAIT_L
#undef PG8_BAR
#undef PG8_SCHED
}

#ifndef WT_STORES
#define WT_STORES 0
#endif
__device__ __forceinline__ void store16_wt(void* p, u32x4 w) {
#if WT_STORES
    asm volatile("global_store_dwordx4 %0, %1, off sc1\n\ts_nop 1" :: "v"(p), "v"(w) : "memory");
#else
    *(u32x4*)p = w;
#endif
}
__device__ __forceinline__ float xrow16_sum(float x) {
    auto s = __builtin_amdgcn_permlane16_swap(__float_as_uint(x), __float_as_uint(x), false, false); x = __uint_as_float(s[0]) + __uint_as_float(s[1]);
    auto t = __builtin_amdgcn_permlane32_swap(__float_as_uint(x), __float_as_uint(x), false, false); return __uint_as_float(t[0]) + __uint_as_float(t[1]);
}
__device__ __forceinline__ float rms_from_part(const float* part, int row, int g0, int nq, float inv_n) {
    float s = 0.f;
#pragma unroll
    for (int q = 0; q < 3; ++q) if (q < nq) { const f32x4 p = *(const f32x4*)(part + (size_t)row * 20 + g0 + 4 * q); s += (p[0] + p[1]) + (p[2] + p[3]); }
    return 1.0f / sqrtf(s * inv_n + RMS_EPS);
}
__device__ __forceinline__ void rms8_from_part(const float* part, int row0, int g0, int nq, float inv_n, float (&sc)[2][4]) {
#pragma unroll
    for (int ai = 0; ai < 2; ++ai) { f32x4 p[4][3];
#pragma unroll
        for (int m = 0; m < 4; ++m)
#pragma unroll
            for (int q = 0; q < 3; ++q) if (q < nq) p[m][q] = *(const f32x4*)(part + (size_t)(row0 + ai * HALF + m * 16) * 20 + g0 + 4 * q);
#pragma unroll
        for (int m = 0; m < 4; ++m) { float s = 0.f;
#pragma unroll
            for (int q = 0; q < 3; ++q) if (q < nq) s += (p[m][q][0] + p[m][q][1]) + (p[m][q][2] + p[m][q][3]);
            sc[ai][m] = 1.0f / sqrtf(s * inv_n + RMS_EPS); }
        asm volatile("" ::: "memory"); }
}
struct EpiBf16 {
    static constexpr bool PERM = true;
    bf16_t* O; int ldc; const float* part; int g0, nq; float inv_n;
    template <class Sched>
    __device__ __forceinline__ void operator()(const f32x4 (&acc)[2][2][4][2], const Unit& u, const Sched&, int wr, int wc, int fr, int fq) const {
        const int row0 = u.pm * BM + wr * 64 + fr; const int col0 = u.pn * BM + wc * 32 + 8 * fq;
        float scs[2][4];
        if (part) rms8_from_part(part, row0, g0, nq, inv_n, scs);
#pragma unroll
        for (int ai = 0; ai < 2; ++ai)
#pragma unroll
            for (int m = 0; m < 4; ++m) { const int row = row0 + ai * HALF + m * 16; bf16_t* rowp = O + (size_t)row * ldc + col0;
                const float sc = part ? scs[ai][m] : 1.f;
#pragma unroll
                for (int bj = 0; bj < 2; ++bj) { const f32x4 v0 = acc[ai][bj][m][0] * sc, v1 = acc[ai][bj][m][1] * sc;
                    u32x4 w; w.x = pk2(v0[0], v0[1]); w.y = pk2(v0[2], v0[3]); w.z = pk2(v1[0], v1[1]); w.w = pk2(v1[2], v1[3]);
                    store16_wt(rowp + bj * HALF, w); } }
    }
};
struct EpiProj {
    static constexpr bool PERM = true;
    bf16_t* O; int ldc; float* part; bf16_t* KR; const float* cs; const float* sn; bool wt;
    template <class Sched>
    __device__ __forceinline__ void operator()(const f32x4 (&acc)[2][2][4][2], const Unit& u, const Sched&, int wr, int wc, int fr, int fq) const {
        const int row0 = u.pm * BM + wr * 64 + fr; const int col0 = u.pn * BM + wc * 32 + 8 * fq;
#pragma unroll
        for (int ai = 0; ai < 2; ++ai)
#pragma unroll
            for (int m = 0; m < 4; ++m) { const int row = row0 + ai * HALF + m * 16; bf16_t* rowp = O + (size_t)row * ldc + col0;
#pragma unroll
                for (int bj = 0; bj < 2; ++bj) { const f32x4 v0 = acc[ai][bj][m][0], v1 = acc[ai][bj][m][1];
                    u32x4 w; w.x = pk2(v0[0], v0[1]); w.y = pk2(v0[2], v0[3]); w.z = pk2(v1[0], v1[1]); w.w = pk2(v1[2], v1[3]);
                    store16_wt(rowp + bj * HALF, w);
                    const int g = u.pn * 8 + bj * 4 + wc;
                    if (g < 20) { float ss = (v0[0] * v0[0] + v0[1] * v0[1]) + (v0[2] * v0[2] + v0[3] * v0[3]) + (v1[0] * v1[0] + v1[1] * v1[1]) + (v1[2] * v1[2] + v1[3] * v1[3]);
                        ss = xrow16_sum(ss); if (fq == 0) __hip_atomic_store(part + (size_t)row * 20 + g, ss, __ATOMIC_RELAXED, __HIP_MEMORY_SCOPE_AGENT); }
                    else if (g == 20) {
                        const int pos = row & (SEQ - 1); const int ib = 8 * (fq & 1);
                        const f32x4 c0 = *(const f32x4*)(cs + pos * 16 + ib), c1 = *(const f32x4*)(cs + pos * 16 + ib + 4), s0 = *(const f32x4*)(sn + pos * 16 + ib), s1 = *(const f32x4*)(sn + pos * 16 + ib + 4);
                        f32x4 y0, y1;
#pragma unroll
                        for (int j = 0; j < 4; ++j) {
                            auto e0 = __builtin_amdgcn_permlane32_swap(__float_as_uint(v0[j]), __float_as_uint(v0[j]), false, false); const float oth0 = __uint_as_float(fq < 2 ? e0[1] : e0[0]);
                            auto e1 = __builtin_amdgcn_permlane32_swap(__float_as_uint(v1[j]), __float_as_uint(v1[j]), false, false); const float oth1 = __uint_as_float(fq < 2 ? e1[1] : e1[0]);
                            y0[j] = fq < 2 ? v0[j] * c0[j] - oth0 * s0[j] : oth0 * s0[j] + v0[j] * c0[j];
                            y1[j] = fq < 2 ? v1[j] * c1[j] - oth1 * s1[j] : oth1 * s1[j] + v1[j] * c1[j]; }
                        u32x4 kw; kw.x = pk2(y0[0], y0[1]); kw.y = pk2(y0[2], y0[3]); kw.z = pk2(y1[0], y1[1]); kw.w = pk2(y1[2], y1[3]);
                        *(u32x4*)(KR + (size_t)row * 32 + 8 * fq) = kw; } }
                asm volatile("" ::: "memory"); }
    }
};
struct EpiQRope {
    static constexpr bool PERM = false;
    bf16_t* O; int ldc; const float* part; const float* cs; const float* sn;
    template <class Sched>
    __device__ __forceinline__ void operator()(const f32x4 (&acc)[2][2][4][2], const Unit& u, const Sched&, int wr, int wc, int fr, int fq) const {
        const int row0 = u.pm * BM + wr * 64 + fr;
        float scs[2][4]; rms8_from_part(part, row0, 0, 3, 1.f / 384.f, scs);
#pragma unroll
        for (int ai = 0; ai < 2; ++ai) {
            f32x4 cc[4], ss[4];
#pragma unroll
            for (int m = 0; m < 4; ++m) { const int pos = (row0 + ai * HALF + m * 16) & (SEQ - 1); cc[m] = *(const f32x4*)(cs + pos * 16 + 4 * fq); ss[m] = *(const f32x4*)(sn + pos * 16 + 4 * fq); }
#pragma unroll
            for (int m = 0; m < 4; ++m) { const int row = row0 + ai * HALF + m * 16; const float sc = scs[ai][m];
                const f32x4 c4 = cc[m], s4 = ss[m];
#pragma unroll
                for (int bj = 0; bj < 2; ++bj) { const int colg = u.pn * BM + bj * HALF + wc * 32;
                    f32x4 x1 = acc[ai][bj][m][0] * sc, x2 = acc[ai][bj][m][1] * sc;
                    if (((colg >> 5) % 3) == 2) { const f32x4 y1 = x1 * c4 - x2 * s4, y2 = x1 * s4 + x2 * c4; x1 = y1; x2 = y2; }
                    bf16_t* p = O + (size_t)row * ldc + colg + 4 * fq;
                    u32x2 w1, w2; w1.x = pk2(x1[0], x1[1]); w1.y = pk2(x1[2], x1[3]); w2.x = pk2(x2[0], x2[1]); w2.y = pk2(x2[2], x2[3]);
                    *(u32x2*)p = w1; *(u32x2*)(p + 16) = w2; } }
            asm volatile("" ::: "memory"); }
    }
};
struct EpiMoe1 {
    static constexpr bool PERM = true;
    bf16_t* H; const float* gatew;
    template <class Sched>
    __device__ __forceinline__ void operator()(const f32x4 (&acc)[2][2][4][2], const Unit& u, const Sched& S, int wr, int wc, int fr, int fq) const {
        int pr[2][4]; float gws[2][4];
#pragma unroll
        for (int ai = 0; ai < 2; ++ai)
#pragma unroll
            for (int m = 0; m < 4; ++m) { const int r = ai * HALF + wr * 64 + m * 16 + fr; pr[ai][m] = S.elist[u.e * 16384 + u.pm * 256 + (r < u.nvalid ? r : 0)]; }
#pragma unroll
        for (int ai = 0; ai < 2; ++ai)
#pragma unroll
            for (int m = 0; m < 4; ++m) gws[ai][m] = gatew[pr[ai][m]];
#pragma unroll
        for (int ai = 0; ai < 2; ++ai)
#pragma unroll
            for (int m = 0; m < 4; ++m) { const int r = ai * HALF + wr * 64 + m * 16 + fr;
                if (r < u.nvalid) { const int pair = pr[ai][m]; const float gw = gws[ai][m];
#pragma unroll
                    for (int bj = 0; bj < 2; ++bj) { const f32x4 g = acc[ai][bj][m][0], up = acc[ai][bj][m][1]; f32x4 a;
#pragma unroll
                        for (int j = 0; j < 4; ++j) { const float sg = g[j] / (1.f + __expf(-g[j])); a[j] = sg * up[j] * gw; }
                        const int f = u.pn * 128 + bj * 64 + wc * 16 + fq * 4;
                        u32x2 w; w.x = pk2(a[0], a[1]); w.y = pk2(a[2], a[3]);
                        __hip_atomic_store((unsigned long long*)(H + (size_t)pair * DFF + f), (unsigned long long)w.x | ((unsigned long long)w.y << 32), __ATOMIC_RELAXED, __HIP_MEMORY_SCOPE_AGENT); } } }
    }
};
struct EpiMoe2 {
    static constexpr bool PERM = true;
    bf16_t* Y;
    template <class Sched>
    __device__ __forceinline__ void operator()(const f32x4 (&acc)[2][2][4][2], const Unit& u, const Sched& S, int wr, int wc, int fr, int fq) const {
        const int col0 = u.pn * BM + wc * 32 + 8 * fq;
        int pr[2][4];
#pragma unroll
        for (int ai = 0; ai < 2; ++ai)
#pragma unroll
            for (int m = 0; m < 4; ++m) { const int r = ai * HALF + wr * 64 + m * 16 + fr; pr[ai][m] = S.elist[u.e * 16384 + u.pm * 256 + (r < u.nvalid ? r : 0)]; }
#pragma unroll
        for (int ai = 0; ai < 2; ++ai)
#pragma unroll
            for (int m = 0; m < 4; ++m) { const int r = ai * HALF + wr * 64 + m * 16 + fr;
                if (r < u.nvalid) { bf16_t* rowp = Y + (size_t)pr[ai][m] * DM + col0;
#pragma unroll
                    for (int bj = 0; bj < 2; ++bj) { const f32x4 v0 = acc[ai][bj][m][0], v1 = acc[ai][bj][m][1];
                        u32x4 w; w.x = pk2(v0[0], v0[1]); w.y = pk2(v0[2], v0[3]); w.z = pk2(v1[0], v1[1]); w.w = pk2(v1[2], v1[3]);
                        store16_wt(rowp + bj * HALF, w); } } }
    }
};

struct Unit2 : Unit { int kind, mt; };
struct Moe12Sched {
    const bf16_t* X1B; const bf16_t* H; const bf16_t* WGU; const bf16_t* WD; const int* elist; const LAS int* tstart; const LAS int* ecnt; unsigned* ready; int G, v;
    __device__ __forceinline__ bool next(int i, Unit2& u) const {
        const int T4 = tstart[16] * 4; const int q1 = T4 / G, rem = T4 - q1 * G; const int g1 = q1 + (v < rem ? 1 : 0);
        int L, kind;
        if (i < g1) { L = v + i * G; kind = 0; }
        else { if (rem > 0 && v < rem) return false; const int nl = G - rem; const int p = (v - rem) + nl * (i - g1); if (p >= T4) return false; L = p; kind = 1; }
        const int mt = L >> 2; u.pn = L & 3; int e = 0;
#pragma unroll
        for (int k = 1; k < 16; ++k) if (mt >= tstart[k]) e = k;
        e = __builtin_amdgcn_readfirstlane(e);
        u.e = e; u.pm = __builtin_amdgcn_readfirstlane(mt - tstart[e]); u.mt = __builtin_amdgcn_readfirstlane(mt); u.kind = __builtin_amdgcn_readfirstlane(kind);
        int nv = ecnt[e] - u.pm * 256; nv = nv > 256 ? 256 : nv; u.nvalid = __builtin_amdgcn_readfirstlane(nv); return true;
    }
    __device__ __forceinline__ int kdim(const Unit2& u) const { return u.kind ? DFF : DM; }
    __device__ __forceinline__ bool perm(const Unit2&) const { return true; }
    __device__ __forceinline__ int epi(const Unit2& u) const { return u.kind; }
    __device__ __forceinline__ const char* a_base(const Unit2& u) const { return u.kind ? (const char*)H : (const char*)X1B; }
    __device__ __forceinline__ const char* b_base(const Unit2& u) const { return u.kind ? (const char*)WD + (size_t)u.e * (DM * DFF * 2) + (size_t)u.pn * (BM * DFF * 2) : (const char*)WGU + (size_t)u.e * (DM * DM * 2) + (size_t)u.pn * (BM * DM * 2); }
    __device__ __forceinline__ int row_id(const Unit& u, int r) const { const int rr = r < u.nvalid ? r : 0; return elist[u.e * 16384 + u.pm * 256 + rr]; }
    __device__ __forceinline__ unsigned a_off(const Unit2& u, int r) const { const int id = row_id(u, r); return u.kind ? (unsigned)id * (unsigned)(DFF * 2) : (unsigned)(id >> 1) * (unsigned)(DM * 2); }
    __device__ __forceinline__ void a_ready(const Unit2& u, int tid) const {
        if (u.kind) {
            if (tid < 64) { unsigned sp = 0;
                while ((unsigned)__builtin_amdgcn_readfirstlane(__hip_atomic_load(ready + u.mt, __ATOMIC_RELAXED, __HIP_MEMORY_SCOPE_AGENT)) < 32u) { __builtin_amdgcn_s_sleep(2); if (++sp > (1u << 22)) break; }
                __builtin_amdgcn_fence(__ATOMIC_ACQUIRE, "agent");
                asm volatile("s_waitcnt vmcnt(0)" ::: "memory"); }
            asm volatile("" ::: "memory"); __builtin_amdgcn_s_barrier(); asm volatile("" ::: "memory");
        }
    }
    __device__ __forceinline__ void done(const Unit2& u, int lane) const {
        if (!u.kind) { asm volatile("s_waitcnt vmcnt(0)" ::: "memory"); if (lane == 0) __hip_atomic_fetch_add(ready + u.mt, 1u, __ATOMIC_RELAXED, __HIP_MEMORY_SCOPE_AGENT); }
    }
};


struct ProjSched {
    const bf16_t* XB; const bf16_t* PROJ; const bf16_t* WIN; const bf16_t* WQUP; const bf16_t* WKV; unsigned* c01; unsigned* c12; int G, v;
    __device__ __forceinline__ bool next(int i, Unit2& u) const {
        const int g0 = v < 192 ? 2 : 1; int kind, pm, pn;
        if (i < g0) { const int L = v + i * G; kind = 0; pm = L & 63; pn = L >> 6; }
        else { const int j = i - g0;
            if (v < 192) { if (j >= 1) return false; kind = 2; pm = v >> 2; pn = v & 3; }
            else { const int w = v - 192; if (j < 3) { kind = 1; pm = w; pn = j; } else if (j == 3) { kind = 2; pm = 48 + (w >> 2); pn = w & 3; } else return false; } }
        u.kind = __builtin_amdgcn_readfirstlane(kind); u.pm = __builtin_amdgcn_readfirstlane(pm); u.pn = __builtin_amdgcn_readfirstlane(pn); u.e = 0; u.nvalid = 256; u.mt = u.pm; return true;
    }
    __device__ __forceinline__ int kdim(const Unit2& u) const { return u.kind == 0 ? DM : (u.kind == 1 ? 384 : 256); }
    __device__ __forceinline__ bool perm(const Unit2& u) const { return u.kind != 1; }
    __device__ __forceinline__ int epi(const Unit2& u) const { return u.kind; }
    __device__ __forceinline__ const char* a_base(const Unit2& u) const {
        return u.kind == 0 ? (const char*)XB + (size_t)u.pm * (BM * DM * 2) : (const char*)PROJ + (size_t)u.pm * (BM * NPROJ * 2) + (u.kind == 1 ? C_QA * 2 : C_KVA * 2); }
    __device__ __forceinline__ const char* b_base(const Unit2& u) const {
        return u.kind == 0 ? (const char*)WIN + (size_t)u.pn * (BM * DM * 2) : (u.kind == 1 ? (const char*)WQUP + (size_t)u.pn * (BM * 384 * 2) : (const char*)WKV + (size_t)u.pn * (BM * 256 * 2)); }
    __device__ __forceinline__ unsigned a_off(const Unit2& u, int r) const { return (unsigned)r * (u.kind == 0 ? (unsigned)(DM * 2) : (unsigned)(NPROJ * 2)); }
    __device__ __forceinline__ void a_ready(const Unit2& u, int tid) const {
        if (u.kind) {
            if (tid < 64) { unsigned* c = (u.kind == 1 ? c01 : c12) + u.pm; unsigned sp = 0;
                while ((unsigned)__builtin_amdgcn_readfirstlane(__hip_atomic_load(c, __ATOMIC_RELAXED, __HIP_MEMORY_SCOPE_AGENT)) < 16u) { __builtin_amdgcn_s_sleep(2); if (++sp > (1u << 22)) break; }
                __builtin_amdgcn_fence(__ATOMIC_ACQUIRE, "agent");
                asm volatile("s_waitcnt vmcnt(0)" ::: "memory"); }
            asm volatile("" ::: "memory"); __builtin_amdgcn_s_barrier(); asm volatile("" ::: "memory");
        }
    }
    __device__ __forceinline__ void done(const Unit2& u, int lane) const {
        if (u.kind == 0 && u.pn <= 2) { asm volatile("s_waitcnt vmcnt(0)" ::: "memory");
            if (lane == 0) { if (u.pn <= 1) __hip_atomic_fetch_add(c01 + u.pm, 1u, __ATOMIC_RELAXED, __HIP_MEMORY_SCOPE_AGENT); if (u.pn >= 1) __hip_atomic_fetch_add(c12 + u.pm, 1u, __ATOMIC_RELAXED, __HIP_MEMORY_SCOPE_AGENT); } }
    }
};

template <class SchedT, class E0T, class E1T, class E2T>
__device__ __forceinline__ void gemm_stream(LAS unsigned char* lds, const SchedT& S, const E0T& E0, const E1T& E1, const E2T& E2, const int tid) {
    const int wid = __builtin_amdgcn_readfirstlane(tid >> 6), lane = tid & 63, wr = wid >> 2, wc = wid & 3, fr = lane & 15, fq = lane >> 4;
#define PG8_GEOM() int RA[2], CA[2], RB[2]; { int tq_ = tid; asm volatile("" : "+v"(tq_)); _Pragma("unroll") for (int i = 0; i < 2; ++i) { int R, C; stage_rc(tq_ * 16 + i * 8192, R, C); RA[i] = R; CA[i] = C; RB[i] = (R & ~31) + perm32(R & 31); } }
    const size_t kstep = (size_t)(BK * 2);
    const unsigned ldsw = (unsigned)wid * 1024u;
    const int aoff = lds_byte(wr * 64 + fr, fq * 8), boff = lds_byte(wc * 32 + fr, fq * 8);
#define PG8_SA(b, h) (((b) * 2 + (h)) * HTB)
#define PG8_SB(b, h) ((4 + (b) * 2 + (h)) * HTB)
#define PG8_STAGE2(bufoff, gbase, v0, v1) do { \
        __builtin_amdgcn_global_load_lds((const unsigned*)((const char*)(gbase) + (v0)), (LAS unsigned*)(lds + (bufoff) + ldsw), 16, 0, 0); \
        __builtin_amdgcn_global_load_lds((const unsigned*)((const char*)(gbase) + (v1)), (LAS unsigned*)(lds + (bufoff) + ldsw + 8192), 16, 0, 0); } while (0)
#define PG8_LDA(dst, b, h) do { _Pragma("unroll") for (int m = 0; m < 4; ++m) _Pragma("unroll") for (int k = 0; k < 2; ++k) dst[m][k] = *(const LAS bf16x8*)(lds + PG8_SA(b, h) + aoff + m * 2048 + k * 1024); } while (0)
#define PG8_LDB(dst, b, h) do { _Pragma("unroll") for (int n = 0; n < 2; ++n) _Pragma("unroll") for (int k = 0; k < 2; ++k) dst[n][k] = *(const LAS bf16x8*)(lds + PG8_SB(b, h) + boff + n * 2048 + k * 1024); } while (0)
#define PG8_MMA(ai, bj, At, Bt) do { __builtin_amdgcn_s_setprio(1); _Pragma("unroll") for (int m = 0; m < 4; ++m) _Pragma("unroll") for (int n = 0; n < 2; ++n) _Pragma("unroll") for (int k = 0; k < 2; ++k) \
        acc[ai][bj][m][n] = __builtin_amdgcn_mfma_f32_16x16x32_bf16(Bt[n][k], At[m][k], acc[ai][bj][m][n], 0, 0, 0); __builtin_amdgcn_s_setprio(0); } while (0)
#define PG8_WAIT_V(n) asm volatile("s_waitcnt vmcnt(" #n ")" ::: "memory")
#define PG8_WAIT_L(n) asm volatile("s_waitcnt lgkmcnt(" #n ")" ::: "memory")
#define PG8_BAR __builtin_amdgcn_s_barrier()
#define PG8_SCHED __builtin_amdgcn_sched_barrier(0)
    Unit2 cur, nxt; int ui = 0;
    if (!S.next(0, cur)) return;
    f32x4 acc[2][2][4][2];
#pragma unroll
    for (int a = 0; a < 2; ++a)
#pragma unroll
        for (int b = 0; b < 2; ++b)
#pragma unroll
            for (int m = 0; m < 4; ++m)
#pragma unroll
                for (int n = 0; n < 2; ++n) acc[a][b][m][n] = (f32x4){0.f, 0.f, 0.f, 0.f};
    bf16x8 At[4][2], B0[2][2], B1[2][2];
    const char* cA = S.a_base(cur); const char* cB = S.b_base(cur);
    int Kc = S.kdim(cur); int ntc = Kc / BK; size_t hbc = (size_t)HALF * Kc * 2;
    unsigned bc0, bc1, bn0, bn1, vc00, vc01, vc10, vc11, vn00, vn01, vn10, vn11;
    { PG8_GEOM();
      bc0 = (unsigned)((S.perm(cur) ? RB[0] : RA[0]) * Kc + CA[0]) * 2u; bc1 = (unsigned)((S.perm(cur) ? RB[1] : RA[1]) * Kc + CA[1]) * 2u;
      vc00 = S.a_off(cur, RA[0]) + CA[0] * 2; vc01 = S.a_off(cur, RA[1]) + CA[1] * 2; vc10 = S.a_off(cur, HALF + RA[0]) + CA[0] * 2; vc11 = S.a_off(cur, HALF + RA[1]) + CA[1] * 2; }
    S.a_ready(cur, tid);
    PG8_STAGE2(PG8_SB(0, 0), cB, bc0, bc1); PG8_STAGE2(PG8_SB(0, 1), cB + hbc, bc0, bc1); PG8_STAGE2(PG8_SA(0, 0), cA, vc00, vc01); PG8_STAGE2(PG8_SA(0, 1), cA, vc10, vc11);
    if (wr == 1) PG8_BAR;
    PG8_WAIT_V(2); PG8_BAR;
    PG8_STAGE2(PG8_SB(1, 0), cB + kstep, bc0, bc1); PG8_STAGE2(PG8_SA(1, 0), cA + kstep, vc00, vc01); PG8_STAGE2(PG8_SB(1, 1), cB + hbc + kstep, bc0, bc1);
    PG8_WAIT_V(6); PG8_BAR;
    for (;;) {
        const bool has_next = S.next(ui + 1, nxt);
        const char* nA = cA; const char* nB = cB; int Kn = Kc; size_t hbn = hbc;
        bn0 = bc0; bn1 = bc1; vn00 = vc00; vn01 = vc01; vn10 = vc10; vn11 = vc11;
        if (has_next) { nA = S.a_base(nxt); nB = S.b_base(nxt); Kn = S.kdim(nxt); hbn = (size_t)HALF * Kn * 2; PG8_GEOM();
            bn0 = (unsigned)((S.perm(nxt) ? RB[0] : RA[0]) * Kn + CA[0]) * 2u; bn1 = (unsigned)((S.perm(nxt) ? RB[1] : RA[1]) * Kn + CA[1]) * 2u;
            vn00 = S.a_off(nxt, RA[0]) + CA[0] * 2; vn01 = S.a_off(nxt, RA[1]) + CA[1] * 2; vn10 = S.a_off(nxt, HALF + RA[0]) + CA[0] * 2; vn11 = S.a_off(nxt, HALF + RA[1]) + CA[1] * 2; }
        for (int t = 0; t < ntc; t += 2) {
            const bool last = (t == ntc - 2);
            if (last && has_next) S.a_ready(nxt, tid);
            const char* a1 = cA + (size_t)(t + 1) * kstep;
            const char* a2 = last ? nA : cA + (size_t)(t + 2) * kstep; const char* b2 = last ? nB : cB + (size_t)(t + 2) * kstep;
            const char* a3 = a2 + kstep; const char* b3 = b2 + kstep;
            unsigned w00 = vc00, w01 = vc01, w10 = vc10, w11 = vc11, x0 = bc0, x1 = bc1; size_t hb = hbc;
            if (last) { w00 = vn00; w01 = vn01; w10 = vn10; w11 = vn11; x0 = bn0; x1 = bn1; hb = hbn; }
            PG8_LDB(B0, 0, 0); PG8_LDB(B1, 0, 1); PG8_SCHED; PG8_LDA(At, 0, 0); PG8_STAGE2(PG8_SA(1, 1), a1, vc10, vc11);
            PG8_WAIT_V(8); PG8_WAIT_L(0); PG8_BAR; PG8_MMA(0, 0, At, B0); PG8_MMA(0, 1, At, B1); PG8_BAR; PG8_SCHED;
            PG8_LDA(At, 0, 1); PG8_STAGE2(PG8_SB(0, 0), b2, x0, x1); PG8_STAGE2(PG8_SB(0, 1), b2 + hb, x0, x1); PG8_STAGE2(PG8_SA(0, 0), a2, w00, w01);
            PG8_WAIT_V(8); PG8_WAIT_L(0); PG8_BAR; PG8_MMA(1, 0, At, B0); PG8_MMA(1, 1, At, B1); PG8_BAR; PG8_SCHED;
            PG8_LDB(B0, 1, 0); PG8_LDB(B1, 1, 1); PG8_SCHED; PG8_LDA(At, 1, 0); PG8_STAGE2(PG8_SA(0, 1), a2, w10, w11);
            PG8_WAIT_V(8); PG8_WAIT_L(0); PG8_BAR; PG8_MMA(0, 0, At, B0); PG8_MMA(0, 1, At, B1); PG8_BAR; PG8_SCHED;
            PG8_LDA(At, 1, 1); PG8_STAGE2(PG8_SB(1, 0), b3, x0, x1); PG8_STAGE2(PG8_SB(1, 1), b3 + hb, x0, x1); PG8_STAGE2(PG8_SA(1, 0), a3, w00, w01);
            PG8_WAIT_V(8); PG8_WAIT_L(0); PG8_BAR; PG8_MMA(1, 0, At, B0); PG8_MMA(1, 1, At, B1); PG8_BAR; PG8_SCHED;
        }
        if (wr == 0) PG8_BAR;
        { int ln_; asm volatile("v_mbcnt_lo_u32_b32 %0, -1, 0\n\tv_mbcnt_hi_u32_b32 %0, -1, %0" : "=v"(ln_));
          const int ek = S.epi(cur);
          if (ek == 0) E0(acc, cur, S, wr, wc, ln_ & 15, ln_ >> 4); else if (ek == 1) E1(acc, cur, S, wr, wc, ln_ & 15, ln_ >> 4); else E2(acc, cur, S, wr, wc, ln_ & 15, ln_ >> 4);
          S.done(cur, ln_); }
        if (!has_next) break;
#pragma unroll
        for (int a = 0; a < 2; ++a)
#pragma unroll
            for (int b = 0; b < 2; ++b)
#pragma unroll
                for (int m = 0; m < 4; ++m)
#pragma unroll
                    for (int n = 0; n < 2; ++n) acc[a][b][m][n] = (f32x4){0.f, 0.f, 0.f, 0.f};
        cur = nxt; cA = nA; cB = nB; ++ui; vc00 = vn00; vc01 = vn01; vc10 = vn10; vc11 = vn11; bc0 = bn0; bc1 = bn1; Kc = Kn; ntc = Kc / BK; hbc = hbn;
        if (wr == 1) PG8_BAR;
    }
    PG8_WAIT_V(0);
    PG8_BAR;
#undef PG8_GEOM
#undef PG8_SA
#undef PG8_SB
#undef PG8_STAGE2
#undef PG8_LDA
#undef PG8_LDB
#undef PG8_MMA
#undef PG8_WAIT_V
#undef PG8_WAIT_L
#undef PG8_BAR
#undef PG8_SCHED
}
}


struct Args {
    const float* x; const float* w_in; const float* q_norm_g; const float* w_q_up; const float* kv_norm_g; const float* w_uk; const float* w_uv; const float* w_o;
    const float* ln1_g; const float* ln1_b; const float* router_w; const float* router_bias; const float* w_gate; const float* w_up; const float* w_down;
    const float* ln2_g; const float* ln2_b;
    float* out; unsigned char* ws; int ph_lo, ph_hi, dup_mask, pad;
};

__device__ __forceinline__ void conv_item(const float* srcp, int ldw, float cs, const float* kscale, bf16_t* dst, int Kdst, LAS float* scr, int lane) {
    const int kr = lane >> 4, j = lane & 15;
    f32x4 v[8];
#pragma unroll
    for (int i = 0; i < 8; ++i) v[i] = srcp ? *(const f32x4*)(srcp + (size_t)(kr + 4 * i) * ldw) : (f32x4){0.f, 0.f, 0.f, 0.f};
#pragma unroll
    for (int i = 0; i < 8; ++i) { const int k = kr + 4 * i; const float ks = kscale ? kscale[k] * cs : cs; LAS float* p = scr + k * 65 + 4 * j;
        p[0] = v[i][0] * ks; p[1] = v[i][1] * ks; p[2] = v[i][2] * ks; p[3] = v[i][3] * ks; }
    asm volatile("s_waitcnt lgkmcnt(0)" ::: "memory");
    const int kc = lane & 3;
#pragma unroll
    for (int q = 0; q < 4; ++q) { const int n = (lane >> 2) + 16 * q; const LAS float* sp = scr + (8 * kc) * 65 + n;
        u32x4 o; o.x = pk2(sp[0 * 65], sp[1 * 65]); o.y = pk2(sp[2 * 65], sp[3 * 65]); o.z = pk2(sp[4 * 65], sp[5 * 65]); o.w = pk2(sp[6 * 65], sp[7 * 65]);
        *(u32x4*)(dst + (size_t)n * Kdst + 8 * kc) = o; }
    asm volatile("s_waitcnt lgkmcnt(0)" ::: "memory");
}

__device__ __forceinline__ void p0_small_weights(const Args& a, LAS float* scr, int gw, int NGW, int lane) {
    unsigned char* ws = a.ws;
    constexpr int I_IN = 28 * 32, I_QUP = 12 * 12, I_KV = 16 * 8, I_O = 16 * 32, I_L = I_IN + I_QUP + I_KV + I_O;
    const int j4 = (lane & 15) * 4;
    for (int it = gw; it < DEPTH * I_L; it += NGW) {
        const int l = it / I_L; int r = it % I_L;
        if (r < I_IN) { const int kb = r / 28, nb = r % 28, n = nb * 64 + j4, k0 = kb * 32;
            const float* sp = n < IN_COLS ? a.w_in + (size_t)l * DM * IN_COLS + (size_t)k0 * IN_COLS + n : nullptr;
            const float cs = (n >= C_DQ && n < C_DK) ? DSA_QSCALE : 1.f;
            conv_item(sp, IN_COLS, cs, nullptr, (bf16_t*)(ws + WS_WIN) + (size_t)l * NPROJ * DM + (size_t)(nb * 64) * DM + k0, DM, scr, lane); continue; }
        r -= I_IN;
        if (r < I_QUP) { const int kb = r / 12, nb = r % 12, n = nb * 64 + j4, k0 = kb * 32;
            conv_item(a.w_q_up + (size_t)l * 384 * 768 + (size_t)k0 * 768 + n, 768, MLA_QSCALE, a.q_norm_g + l * 384 + k0, (bf16_t*)(ws + WS_WQUP) + (size_t)l * 768 * 384 + (size_t)(nb * 64) * 384 + k0, 384, scr, lane); continue; }
        r -= I_QUP;
        if (r < I_KV) { const int kb = r / 16, nb = r % 16, n = nb * 64 + j4, k0 = kb * 32;
            const float* sp = n < 512 ? a.w_uk + (size_t)l * 256 * 512 + (size_t)k0 * 512 + n : a.w_uv + (size_t)l * 256 * 512 + (size_t)k0 * 512 + (n - 512);
            conv_item(sp, 512, 1.f, a.kv_norm_g + l * 256 + k0, (bf16_t*)(ws + WS_WKV) + (size_t)l * 1024 * 256 + (size_t)(nb * 64) * 256 + k0, 256, scr, lane); continue; }
        r -= I_KV;
        { const int kb = r / 16, nb = r % 16, n = nb * 64 + j4, k0 = kb * 32;
            conv_item(a.w_o + (size_t)l * DM * DM + (size_t)k0 * DM + n, DM, 1.f, nullptr, (bf16_t*)(ws + WS_WO) + (size_t)l * DM * DM + (size_t)(nb * 64) * DM + k0, DM, scr, lane); }
    }
}
__device__ __forceinline__ void p0_expert_weights(const Args& a, int l, LAS float* scr, int gw, int NGW, int lane) {
    unsigned char* ws = a.ws;
    constexpr int I_GU = 16 * 32 * 16, I_D = 16 * 16 * 16;
    const int j4 = (lane & 15) * 4;
    for (int it = gw; it < I_GU + I_D; it += NGW) {
        int r = it;
        if (r < I_GU) { const int e = r / 512, rr = r % 512, kb = rr / 16, nb = rr % 16, c0 = nb * 64 + j4, k0 = kb * 32;
            const int f = 4 * (c0 >> 3); const float* W = (c0 & 4) ? a.w_up : a.w_gate;
            conv_item(W + ((size_t)(l * NEXP + e) * DM + k0) * DFF + f, DFF, 1.f, nullptr, (bf16_t*)(ws + WS_WGU) + (size_t)e * DM * DM + (size_t)(nb * 64) * DM + k0, DM, scr, lane); continue; }
        r -= I_GU;
        { const int e = r / 256, rr = r % 256, kb = rr / 16, nb = rr % 16, n = nb * 64 + j4, k0 = kb * 32;
            conv_item(a.w_down + ((size_t)(l * NEXP + e) * DFF + k0) * DM + n, DM, 1.f, nullptr, (bf16_t*)(ws + WS_WD) + (size_t)e * DM * DFF + (size_t)(nb * 64) * DFF + k0, DFF, scr, lane); }
    }
}
__device__ __forceinline__ void p0_misc(const Args& a, int gw, int NGW, int lane) {
    unsigned char* ws = a.ws;
    for (int m = gw; m < M; m += NGW) { const f32x4* xr = (const f32x4*)(a.x + (size_t)m * DM) + lane; u32x2* o = (u32x2*)((bf16_t*)(ws + WS_XB) + (size_t)m * DM) + lane;
#pragma unroll
        for (int j = 0; j < 4; ++j) { const f32x4 v = xr[64 * j]; u32x2 w; w.x = pk2(v[0], v[1]); w.y = pk2(v[2], v[3]); o[64 * j] = w; } }
    float* cs = (float*)(ws + WS_ROPE); float* sn = cs + SEQ * 16;
    for (int i = gw * 64 + lane; i < SEQ * 16; i += NGW * 64) { const int pos = i >> 4, k = i & 15; const float inv = powf(10000.0f, -(float)k / 16.0f); const float ang = (float)pos * inv; cs[i] = cosf(ang); sn[i] = sinf(ang); }
    if (gw == 0) for (int i = lane; i < 1024; i += 64) ((int*)(ws + WS_CTL))[i] = 0;
}

__device__ __forceinline__ void p1b_token_stats(const Args& a, int gw, int NGW, int lane) {
    unsigned char* ws = a.ws; const bf16_t* PROJ = (const bf16_t*)(ws + WS_PROJ); float* RS = (float*)(ws + WS_RS); bf16_t* KR = (bf16_t*)(ws + WS_KR);
    const float* cs = (const float*)(ws + WS_ROPE); const float* sn = cs + SEQ * 16;
    for (int m = gw; m < M; m += NGW) {
        const bf16_t* row = PROJ + (size_t)m * NPROJ;
        float sq = 0.f, sk = 0.f;
        if (lane < 48) { const u32x4 w = *(const u32x4*)(row + C_QA + lane * 8);
#pragma unroll
            for (int j = 0; j < 4; ++j) { const float lo = bf_lo(w[j]), hi = bf_hi(w[j]); sq += lo * lo + hi * hi; } }
        if (lane < 32) { const u32x4 w = *(const u32x4*)(row + C_KVA + lane * 8);
#pragma unroll
            for (int j = 0; j < 4; ++j) { const float lo = bf_lo(w[j]), hi = bf_hi(w[j]); sk += lo * lo + hi * hi; } }
        sq = wave_sum(sq); sk = wave_sum(sk);
        if (lane == 0) { RS[(size_t)m * 2] = 1.0f / sqrtf(sq * (1.f / 384.f) + RMS_EPS); RS[(size_t)m * 2 + 1] = 1.0f / sqrtf(sk * (1.f / 256.f) + RMS_EPS); }
        if (lane < 16) { const int pos = m & (SEQ - 1); const float x1 = bf2f(row[C_KR + lane]), x2 = bf2f(row[C_KR + 16 + lane]); const float c = cs[pos * 16 + lane], s = sn[pos * 16 + lane];
            const unsigned y1 = pk2(x1 * c - x2 * s, 0.f) & 0xffffu, y2 = pk2(x1 * s + x2 * c, 0.f) & 0xffffu;
            KR[(size_t)m * 32 + lane] = (bf16_t)y1; KR[(size_t)m * 32 + 16 + lane] = (bf16_t)y2; }
    }
}

__device__ __forceinline__ float max3f(float a, float b, float c) { float r; asm("v_max3_f32 %0, %1, %2, %3" : "=v"(r) : "v"(a), "v"(b), "v"(c)); return r; }
__device__ __forceinline__ int crow(int r, int hi) { return (r & 3) + 8 * (r >> 2) + 4 * hi; }
__device__ __forceinline__ s16x4 vtr(const LAS unsigned char* p) { typedef short v4i16_t __attribute__((ext_vector_type(4))); return __builtin_bit_cast(s16x4, __builtin_amdgcn_ds_read_tr16_b64_v4i16((LAS v4i16_t*)p)); }

template <bool DSA>
__device__ __forceinline__ void attn_qk(LAS unsigned char* lds, const int bo, const int t, const bf16x8 (&qf)[DSA ? 4 : 6], f32x16& p0, f32x16& p1,
                                        const int q0, const int lane, const float sl2, const float (&slc)[16], const LAS unsigned char* mrow) {
    constexpr int DQK = DSA ? 64 : 96;
    const int r32 = lane & 31, hi = lane >> 5;
    if (DSA) { const float b0 = -sl2 * (float)(q0 + r32 - 64 * t - 4 * hi);
#pragma unroll
        for (int r = 0; r < 16; ++r) { p0[r] = b0 + slc[r]; p1[r] = p0[r] + 32.f * sl2; } }
    else { p0 = f32x16{}; p1 = f32x16{}; }
    constexpr int KP = DQK * 2 + 16;
    const LAS unsigned char* kb = lds + bo + r32 * KP + hi * 16;
    bf16x8 kf0[DQK / 16], kf1[DQK / 16];
#pragma unroll
    for (int d0 = 0; d0 < DQK / 16; ++d0) { kf0[d0] = *(const LAS bf16x8*)(kb + d0 * 32); kf1[d0] = *(const LAS bf16x8*)(kb + d0 * 32 + 32 * KP); }
    __builtin_amdgcn_s_setprio(1);
#pragma unroll
    for (int d0 = 0; d0 < DQK / 16; ++d0) { p0 = __builtin_amdgcn_mfma_f32_32x32x16_bf16(kf0[d0], qf[d0], p0, 0, 0, 0); p1 = __builtin_amdgcn_mfma_f32_32x32x16_bf16(kf1[d0], qf[d0], p1, 0, 0, 0); }
    __builtin_amdgcn_s_setprio(0);
    if (DSA) { const u32x2 mw = *(const LAS u32x2*)(mrow + 8 * t); const unsigned w0 = mw.x >> (4 * hi), w1 = mw.y >> (4 * hi);
#pragma unroll
        for (int r = 0; r < 16; ++r) { const unsigned bit = 1u << ((r & 3) + 8 * (r >> 2)); if (!(w0 & bit)) p0[r] = -INFINITY; if (!(w1 & bit)) p1[r] = -INFINITY; } }
    else if (64 * t + 63 > q0) { const int qa = q0 + r32, kbase = 64 * t + 4 * hi;
#pragma unroll
        for (int r = 0; r < 16; ++r) { const int kv = kbase + (r & 3) + 8 * (r >> 2); if (kv > qa) p0[r] = -INFINITY; if (kv + 32 > qa) p1[r] = -INFINITY; } }
}
template <bool DSA>
__device__ __forceinline__ void attn_sm_pv(LAS unsigned char* lds, const int bo, f32x16& p0, f32x16& p1, f32x16 (&o)[2], float& mrun, float& lrun, const int lane, LAS float* wsf) {
    constexpr int DQK = DSA ? 64 : 96, KBYTES = 64 * (DQK * 2 + 16);
    const int r32 = lane & 31, hi = lane >> 5;
    float mx = max3f(p0[0], p1[0], p0[1]), mx2 = max3f(p1[1], p0[2], p1[2]);
#pragma unroll
    for (int r = 3; r < 15; r += 2) { mx = max3f(mx, p0[r], p1[r]); mx2 = max3f(mx2, p0[r + 1], p1[r + 1]); }
    mx = max3f(mx, mx2, fmaxf(p0[15], p1[15]));
    { auto rr = __builtin_amdgcn_permlane32_swap(__float_as_uint(mx), __float_as_uint(mx), false, false); mx = fmaxf(__uint_as_float(rr[0]), __uint_as_float(rr[1])); }
    const float mnew = fmaxf(mrun, mx); const float alpha = fast_exp2(mrun - mnew); mrun = mnew;
    float sum = 0.f;
#pragma unroll
    for (int r = 0; r < 16; ++r) { p0[r] = fast_exp2(p0[r] - mnew); p1[r] = fast_exp2(p1[r] - mnew); sum += p0[r] + p1[r]; }
    lrun = lrun * alpha + sum;
    if (__any(alpha != 1.f)) {
        if (hi == 0) wsf[r32] = alpha;
        asm volatile("s_waitcnt lgkmcnt(0)" ::: "memory");
#pragma unroll
        for (int g = 0; g < 4; ++g) { const f32x4 av = *(const LAS f32x4*)(wsf + 8 * g + 4 * hi);
#pragma unroll
            for (int j = 0; j < 4; ++j) { o[0][4 * g + j] *= av[j]; o[1][4 * g + j] *= av[j]; } }
        asm volatile("s_waitcnt lgkmcnt(0)" ::: "memory");
    }
    bf16x8 pf[4];
#pragma unroll
    for (int s = 0; s < 4; ++s) { u32x4 w;
        if (s < 2) { w.x = pk2(p0[8 * s + 0], p0[8 * s + 1]); w.y = pk2(p0[8 * s + 2], p0[8 * s + 3]); w.z = pk2(p0[8 * s + 4], p0[8 * s + 5]); w.w = pk2(p0[8 * s + 6], p0[8 * s + 7]); }
        else { const int s2 = s - 2; w.x = pk2(p1[8 * s2 + 0], p1[8 * s2 + 1]); w.y = pk2(p1[8 * s2 + 2], p1[8 * s2 + 3]); w.z = pk2(p1[8 * s2 + 4], p1[8 * s2 + 5]); w.w = pk2(p1[8 * s2 + 6], p1[8 * s2 + 7]); }
        pf[s] = __builtin_bit_cast(bf16x8, w); }
    const LAS unsigned char* vb = lds + bo + KBYTES + ((lane >> 4) & 1) * 32 + (lane & 3) * 8 + (4 * hi + ((lane & 15) >> 2)) * 64;
    __builtin_amdgcn_s_setprio(1);
#pragma unroll
    for (int d0 = 0; d0 < 2; ++d0)
#pragma unroll
        for (int ks = 0; ks < 4; ++ks) { const s16x4 lo = vtr(vb + d0 * 4096 + ks * 1024), hh = vtr(vb + d0 * 4096 + ks * 1024 + 512);
            const bf16x8 vf = (bf16x8){lo[0], lo[1], lo[2], lo[3], hh[0], hh[1], hh[2], hh[3]};
            o[d0] = __builtin_amdgcn_mfma_f32_32x32x16_bf16(pf[ks], vf, o[d0], 0, 0, 0); }
    __builtin_amdgcn_s_setprio(0);
}

template <bool DSA>
__device__ __forceinline__ void attn_unit(LAS unsigned char* lds, const Args& a, int b, int hq  , int qblk  , int tid) {
    asm volatile("" : "+v"(tid));
    constexpr int DQK = DSA ? 64 : 96, KP = DQK * 2 + 16, KBYTES = 64 * KP, BUFB = KBYTES + 8192;
    constexpr int WS_OFF = 3 * BUFB;
    unsigned char* ws = a.ws;
    const int lane = tid & 63, r32 = lane & 31, hi = lane >> 5; const int wid = __builtin_amdgcn_readfirstlane(tid >> 6);
    const size_t rowbase = (size_t)b * SEQ;
    const int q0 = DSA ? qblk * 32 : qblk * 256 + wid * 32;
    const int qlast_unit = DSA ? qblk * 32 + 31 : qblk * 256 + 255;
    const int NT = qlast_unit / 64 + 1;
    const int h = DSA ? wid : hq;
    const bf16_t* PROJ = (const bf16_t*)(ws + WS_PROJ); const bf16_t* KVU = (const bf16_t*)(ws + WS_KVU); const bf16_t* KR = (const bf16_t*)(ws + WS_KR); const bf16_t* Qb = (const bf16_t*)(ws + WS_Q);
    const int krow = tid >> 3, kch = tid & 7, krowB = (tid >> 2) & 63, kchB = tid & 3;
    const bf16_t* ksrcA; const bf16_t* ksrcB; const bf16_t* vsrc; size_t kstrideA, kstrideB, vstride;
    if (DSA) { ksrcA = PROJ + (rowbase + krow) * NPROJ + C_DK + kch * 8; kstrideA = (size_t)64 * NPROJ; ksrcB = ksrcA; kstrideB = 0;
               vsrc = PROJ + (rowbase + 16 * (wid & 3) + (lane >> 2)) * NPROJ + C_DV + (wid >> 2) * 32 + (lane & 3) * 8; vstride = (size_t)64 * NPROJ; }
    else { ksrcA = KVU + (rowbase + krow) * 1024 + h * 64 + kch * 8; kstrideA = (size_t)64 * 1024;
           ksrcB = KR + (rowbase + krowB) * 32 + kchB * 8; kstrideB = (size_t)64 * 32;
           vsrc = KVU + (rowbase + 16 * (wid & 3) + (lane >> 2)) * 1024 + 512 + h * 64 + (wid >> 2) * 32 + (lane & 3) * 8; vstride = (size_t)64 * 1024; }
    const bool hasB = (!DSA) && (tid < 256);
    const int kdstA = krow * KP + kch * 16, kdstB = krowB * KP + 128 + kchB * 16, vdst = KBYTES + wid * 1024 + lane * 16;
    bf16x8 qf[DQK / 16];
    { const bf16_t* qp = DSA ? PROJ + (rowbase + q0 + r32) * NPROJ + C_DQ + h * 64 + 8 * hi : Qb + (rowbase + q0 + r32) * 768 + h * 96 + 8 * hi;
#pragma unroll
      for (int d0 = 0; d0 < DQK / 16; ++d0) qf[d0] = *(const bf16x8*)(qp + d0 * 16); }
    constexpr int MOFF = WS_OFF + 2048, MPITCH = 264;
    if (DSA) { const u32x4 mv = *(const u32x4*)((const unsigned*)(ws + WS_MASK) + (rowbase + q0 + (tid >> 4)) * 64 + (tid & 15) * 4);
        LAS unsigned char* md = lds + MOFF + (tid >> 4) * MPITCH + (tid & 15) * 16; *(LAS u32x2*)md = (u32x2){mv.x, mv.y}; *(LAS u32x2*)(md + 8) = (u32x2){mv.z, mv.w}; }
    const LAS unsigned char* mrow = lds + MOFF + r32 * MPITCH;
    const float sl2 = DSA ? exp2f(-(float)(h + 1)) * LOG2E : 0.f;
    float slc[16];
#pragma unroll
    for (int r = 0; r < 16; ++r) slc[r] = sl2 * (float)((r & 3) + 8 * (r >> 2));
    LAS float* wsf = (LAS float*)(lds + WS_OFF) + wid * 64;
    float mrun = -1e30f, lrun = 0.f; f32x16 o[2]; o[0] = f32x16{}; o[1] = f32x16{};
#define AT_LOAD(KA, KB, VV, tt) do { const int tc_ = (tt) < NT ? (tt) : NT - 1; KA = *(const u32x4*)(ksrcA + (size_t)tc_ * kstrideA); if (!DSA) KB = *(const u32x4*)(ksrcB + (size_t)tc_ * kstrideB); \
        VV = *(const u32x4*)(vsrc + (size_t)tc_ * vstride); } while (0)
#define AT_WRITE(KA, KB, VV, bn) do { *(LAS u32x4*)(lds + (bn) + kdstA) = KA; if (hasB) *(LAS u32x4*)(lds + (bn) + kdstB) = KB; *(LAS u32x4*)(lds + (bn) + vdst) = VV; } while (0)
#define AT_ACTIVE(tt) (64 * (tt) <= q0 + 31)
#define AT_ROT() do { const int t_ = bc; bc = bn; bn = bw; bw = t_; } while (0)
    u32x4 kA0, kB0 = (u32x4){0, 0, 0, 0}, vv0, kA1, kB1 = (u32x4){0, 0, 0, 0}, vv1;
    AT_LOAD(kA0, kB0, vv0, 0); AT_LOAD(kA1, kB1, vv1, 1);
    AT_WRITE(kA0, kB0, vv0, 0); AT_WRITE(kA1, kB1, vv1, BUFB);
    AT_LOAD(kA0, kB0, vv0, 2); AT_LOAD(kA1, kB1, vv1, 3);
    __syncthreads();
    int bc = 0, bn = BUFB, bw = 2 * BUFB;
    f32x16 pA0, pA1, pB0, pB1;
    attn_qk<DSA>(lds, 0, 0, qf, pA0, pA1, q0, lane, sl2, slc, mrow);
    for (int t = 0; t < NT; t += 2) {
        if (t + 1 < NT && AT_ACTIVE(t + 1)) attn_qk<DSA>(lds, bn, t + 1, qf, pB0, pB1, q0, lane, sl2, slc, mrow);
        if (AT_ACTIVE(t)) attn_sm_pv<DSA>(lds, bc, pA0, pA1, o, mrun, lrun, lane, wsf);
        if (t + 2 < NT) AT_WRITE(kA0, kB0, vv0, bw);
        AT_LOAD(kA0, kB0, vv0, t + 4);
        __syncthreads(); AT_ROT();
        if (t + 1 >= NT) break;
        if (t + 2 < NT && AT_ACTIVE(t + 2)) attn_qk<DSA>(lds, bn, t + 2, qf, pA0, pA1, q0, lane, sl2, slc, mrow);
        if (AT_ACTIVE(t + 1)) attn_sm_pv<DSA>(lds, bc, pB0, pB1, o, mrun, lrun, lane, wsf);
        if (t + 3 < NT) AT_WRITE(kA1, kB1, vv1, bw);
        AT_LOAD(kA1, kB1, vv1, t + 5);
        __syncthreads(); AT_ROT();
    }
#undef AT_ROT
#undef AT_LOAD
#undef AT_WRITE
#undef AT_ACTIVE
    { auto rr = __builtin_amdgcn_permlane32_swap(__float_as_uint(lrun), __float_as_uint(lrun), false, false); lrun = __uint_as_float(rr[0]) + __uint_as_float(rr[1]); }
    if (hi == 0) wsf[r32] = 1.0f / lrun;
    asm volatile("s_waitcnt lgkmcnt(0)" ::: "memory");
    bf16_t* Ob = (bf16_t*)(ws + WS_CONCAT) + (rowbase + q0) * DM + (DSA ? 512 : 0) + h * 64 + r32;
#pragma unroll
    for (int g = 0; g < 4; ++g) { const f32x4 li = *(const LAS f32x4*)(wsf + 8 * g + 4 * hi);
#pragma unroll
        for (int j = 0; j < 4; ++j) { const int r = 4 * g + j; const int orow = crow(r, hi);
            Ob[(size_t)orow * DM] = (bf16_t)(pk2(o[0][r] * li[j], 0.f) & 0xffffu); Ob[(size_t)orow * DM + 32] = (bf16_t)(pk2(o[1][r] * li[j], 0.f) & 0xffffu); } }
    asm volatile("s_waitcnt lgkmcnt(0)" ::: "memory");
    __syncthreads();
}

__device__ __forceinline__ unsigned f2key(float s) { s = s + 0.0f; const unsigned u = __float_as_uint(s); return (u & 0x80000000u) ? ~u : (u | 0x80000000u); }
#define SBAR0() __builtin_amdgcn_sched_barrier(0)
#ifndef IDX_ITCAP
#define IDX_ITCAP 16
#endif
__device__ __forceinline__ void cnt_ge4(int& cnt, unsigned k0, unsigned k1, unsigned k2, unsigned k3, unsigned t) {
    unsigned long long m0, m1, m2, m3;
    asm("v_cmp_ge_u32_e64 %1, %5, %9\n\tv_cmp_ge_u32_e64 %2, %6, %9\n\tv_cmp_ge_u32_e64 %3, %7, %9\n\tv_cmp_ge_u32_e64 %4, %8, %9\n\t"
        "v_addc_co_u32_e64 %0, %1, %0, 0, %1\n\tv_addc_co_u32_e64 %0, %2, %0, 0, %2\n\tv_addc_co_u32_e64 %0, %3, %0, 0, %3\n\tv_addc_co_u32_e64 %0, %4, %0, 0, %4"
        : "+v"(cnt), "=&s"(m0), "=&s"(m1), "=&s"(m2), "=&s"(m3) : "v"(k0), "v"(k1), "v"(k2), "v"(k3), "v"(t));
}
__device__ __forceinline__ float relu1(float x) { return __builtin_amdgcn_fmed3f(x, 0.f, __builtin_inff()); }
__device__ __forceinline__ float key2f(unsigned k) { const unsigned u = (k & 0x80000000u) ? (k ^ 0x80000000u) : ~k; return __uint_as_float(u); }

__device__ __forceinline__ void idx_unit(LAS unsigned char* lds, const Args& a, int b, int qg, int tid) {
    asm volatile("" : "+v"(tid));
    unsigned char* ws = a.ws; const bf16_t* PROJ = (const bf16_t*)(ws + WS_PROJ); unsigned* MASK = (unsigned*)(ws + WS_MASK);
    const int lane = tid & 63; const int wid = __builtin_amdgcn_readfirstlane(tid >> 6);
    const size_t rowbase = (size_t)b * SEQ; const int hl = lane >> 5, c = lane & 31;
    const int nkeys = 32 * qg + 32;
    const int nstage = (nkeys + 511) & ~511;
    for (int i0 = tid; i0 < nstage * 4; i0 += 4 * NTHREADS) {
        u32x4 v[4];
#pragma unroll
        for (int q = 0; q < 4; ++q) { const int i = i0 + q * NTHREADS; v[q] = *(const u32x4*)(PROJ + (rowbase + (i >> 2)) * NPROJ + C_IK + (i & 3) * 8); }
#pragma unroll
        for (int q = 0; q < 4; ++q) { const int i = i0 + q * NTHREADS; const int r = i >> 2, ch = i & 3; *(LAS u32x4*)(lds + r * 64 + ((ch ^ ((r >> 2) & 3)) * 16)) = v[q]; }
    }
    __syncthreads();
    const int t0 = 32 * qg + 4 * wid;
    const int tqa = t0 + 2 * hl, tqb = tqa + 1; const int ntile = (t0 + 3) / 32 + 1;
    const int aq = 2 * ((c >> 2) & 1) + (c >> 4), ah = (c & 3) + 4 * ((c >> 3) & 1);
    const bf16_t* ap = PROJ + (rowbase + t0 + aq) * NPROJ + C_IQ + ah * 32 + 8 * hl;
    const bf16x8 a0 = *(const bf16x8*)ap, a1 = *(const bf16x8*)(ap + 16);
    float wa[8], wb[8];
    { const u32x4 wv = *(const u32x4*)(PROJ + (rowbase + tqa) * NPROJ + C_IW), wv2 = *(const u32x4*)(PROJ + (rowbase + tqb) * NPROJ + C_IW);
#pragma unroll
      for (int j = 0; j < 4; ++j) { wa[2 * j] = bf_lo(wv[j]); wa[2 * j + 1] = bf_hi(wv[j]); wb[2 * j] = bf_lo(wv2[j]); wb[2 * j + 1] = bf_hi(wv2[j]); } }
    unsigned keyA[64], keyB[64];
    const int sw = (c >> 2) & 3;
    const LAS unsigned char* kb0 = lds + c * 64 + ((hl ^ sw) * 16); const LAS unsigned char* kb1 = lds + c * 64 + (((2 + hl) ^ sw) * 16);
#pragma unroll
    for (int blk = 0; blk < 16; ++blk) {
        if (blk * 4 < ntile) {
#pragma unroll
            for (int j4 = 0; j4 < 4; ++j4) { const int i = blk * 4 + j4;
                if (i < ntile) {
                    const bf16x8 b0 = *(const LAS bf16x8*)(kb0 + i * 2048), b1 = *(const LAS bf16x8*)(kb1 + i * 2048);
                    f32x16 z = f32x16{};
                    z = __builtin_amdgcn_mfma_f32_32x32x16_bf16(a0, b0, z, 0, 0, 0); z = __builtin_amdgcn_mfma_f32_32x32x16_bf16(a1, b1, z, 0, 0, 0);
                    float sa = 0.f, sb = 0.f;
#pragma unroll
                    for (int r = 0; r < 8; ++r) { sa += wa[r] * relu1(z[r]); sb += wb[r] * relu1(z[8 + r]); }
                    const int kidx = 32 * i + c;
                    keyA[i] = (kidx <= tqa) ? f2key(sa) : 0u; keyB[i] = (kidx <= tqb) ? f2key(sb) : 0u;
                } else { keyA[i] = 0u; keyB[i] = 0u; } }
        } else {
#pragma unroll
            for (int j4 = 0; j4 < 4; ++j4) { keyA[blk * 4 + j4] = 0u; keyB[blk * 4 + j4] = 0u; }
        }
        SBAR0();
    }
    const int KqA = tqa + 1 < 256 ? tqa + 1 : 256, KqB = tqb + 1 < 256 ? tqb + 1 : 256;
    unsigned TA = 1u, TB = 1u; int cgeA = KqA, cgeB = KqB;
#define COUNT_GE(ta, tb, ca, cb) do { ca = 0; cb = 0; const unsigned ta_ = (ta), tb_ = (tb); _Pragma("unroll") for (int blk = 0; blk < 8; ++blk) { if (blk * 8 < ntile) { \
        cnt_ge4(ca, keyA[blk * 8 + 0], keyA[blk * 8 + 1], keyA[blk * 8 + 2], keyA[blk * 8 + 3], ta_); cnt_ge4(cb, keyB[blk * 8 + 0], keyB[blk * 8 + 1], keyB[blk * 8 + 2], keyB[blk * 8 + 3], tb_); \
        cnt_ge4(ca, keyA[blk * 8 + 4], keyA[blk * 8 + 5], keyA[blk * 8 + 6], keyA[blk * 8 + 7], ta_); cnt_ge4(cb, keyB[blk * 8 + 4], keyB[blk * 8 + 5], keyB[blk * 8 + 6], keyB[blk * 8 + 7], tb_); } SBAR0(); } \
        ca = half32_sum(ca); cb = half32_sum(cb); } while (0)
    if (t0 + 3 >= 256) {
        unsigned mxA = 0u, mxB = 0u, mnA = 0xffffffffu, mnB = 0xffffffffu;
#pragma unroll
        for (int i = 0; i < 64; ++i) { mxA = max(mxA, keyA[i]); mxB = max(mxB, keyB[i]); mnA = min(mnA, keyA[i] ? keyA[i] : 0xffffffffu); mnB = min(mnB, keyB[i] ? keyB[i] : 0xffffffffu); }
        unsigned loA = ~half32_max(~mnA), hiA = half32_max(mxA), loB = ~half32_max(~mnB), hiB = half32_max(mxB);
        int cloA = tqa + 1, cloB = tqb + 1;
        if (cloA == KqA) hiA = loA;
        if (cloB == KqB) hiB = loB;
        for (int it = 0; it < IDX_ITCAP; ++it) {
            if (__all(loA == hiA && loB == hiB)) break;
            unsigned gA = f2key(0.5f * key2f(loA) + 0.5f * key2f(hiA)), gB = f2key(0.5f * key2f(loB) + 0.5f * key2f(hiB));
            gA = gA <= loA ? loA + 1u : gA; gA = gA > hiA ? hiA : gA; gB = gB <= loB ? loB + 1u : gB; gB = gB > hiB ? hiB : gB;
            const unsigned midA = gA, midB = gB;
            int ca, cb; COUNT_GE(midA, midB, ca, cb);
            if (loA != hiA) { if (ca >= KqA) { loA = midA; cloA = ca; } else hiA = midA - 1u; if (ca == KqA) hiA = midA; }
            if (loB != hiB) { if (cb >= KqB) { loB = midB; cloB = cb; } else hiB = midB - 1u; if (cb == KqB) hiB = midB; }
        }
        for (int ms = 0; ms < 4096; ++ms) {
            if (__all(loA == hiA && loB == hiB)) break;
            unsigned mA = 0u, mB = 0u;
#pragma unroll
            for (int blk = 0; blk < 8; ++blk) { if (blk * 8 < ntile) {
#pragma unroll
                for (int j8 = 0; j8 < 8; ++j8) { const unsigned ka = keyA[blk * 8 + j8], kb = keyB[blk * 8 + j8]; mA = max(mA, ka <= hiA ? ka : 0u); mB = max(mB, kb <= hiB ? kb : 0u); } } SBAR0(); }
            mA = half32_max(mA); mB = half32_max(mB);
            int ca, cb; COUNT_GE(mA, mB, ca, cb);
            if (loA != hiA) { if (ca >= KqA) { loA = mA; hiA = mA; cloA = ca; } else hiA = mA - 1u; }
            if (loB != hiB) { if (cb >= KqB) { loB = mB; hiB = mB; cloB = cb; } else hiB = mB - 1u; }
        }
        TA = loA; TB = loB; cgeA = cloA; cgeB = cloB;
    }
    const bool ties = __any(cgeA != KqA || cgeB != KqB);
    int needA = 0, needB = 0, runA = 0, runB = 0;
    if (ties) { int ca, cb; COUNT_GE(TA + 1u, TB + 1u, ca, cb); needA = KqA - ca; needB = KqB - cb; }
    unsigned mw0 = 0u, mw1 = 0u, mw2 = 0u, mw3 = 0u;
#pragma unroll
    for (int blk = 0; blk < 16; ++blk) {
        if (blk * 4 < ntile) {
#pragma unroll
            for (int j4 = 0; j4 < 4; ++j4) { const int i = blk * 4 + j4;
                bool selA = keyA[i] >= TA && keyA[i] != 0u, selB = keyB[i] >= TB && keyB[i] != 0u;
                if (ties) {
                    const bool eqA = keyA[i] == TA && keyA[i] != 0u, eqB = keyB[i] == TB && keyB[i] != 0u;
                    const unsigned long long balA = __ballot(eqA), balB = __ballot(eqB);
                    const unsigned eA = hl ? (unsigned)(balA >> 32) : (unsigned)balA, eB = hl ? (unsigned)(balB >> 32) : (unsigned)balB;
                    const unsigned below = (1u << c) - 1u;
                    selA = (keyA[i] > TA) || (eqA && (runA + __popc(eA & below) < needA)); selB = (keyB[i] > TB) || (eqB && (runB + __popc(eB & below) < needB));
                    runA += __popc(eA); runB += __popc(eB);
                }
                const unsigned long long sA = __ballot(selA), sB = __ballot(selB);
                if (lane == i) { mw0 = (unsigned)sA; mw2 = (unsigned)(sA >> 32); mw1 = (unsigned)sB; mw3 = (unsigned)(sB >> 32); } }
        }
        SBAR0();
    }
#undef COUNT_GE
    unsigned* mrow = MASK + (rowbase + t0) * 64 + lane;
    mrow[0] = mw0; mrow[64] = mw1; mrow[128] = mw2; mrow[192] = mw3;
    __syncthreads();
}

__device__ __forceinline__ void ln_row(f32x4 (&v)[4], const float* gam, const float* bet, int lane) {
    float s = 0.f;
#pragma unroll
    for (int j = 0; j < 4; ++j) s += (v[j][0] + v[j][1]) + (v[j][2] + v[j][3]);
    const float mean = wave_sum(s) * (1.f / DM); float s2 = 0.f;
#pragma unroll
    for (int j = 0; j < 4; ++j) { v[j] = v[j] - mean; s2 += (v[j][0] * v[j][0] + v[j][1] * v[j][1]) + (v[j][2] * v[j][2] + v[j][3] * v[j][3]); }
    const float rstd = 1.0f / sqrtf(wave_sum(s2) * (1.f / DM) + LN_EPS);
#pragma unroll
    for (int j = 0; j < 4; ++j) { const f32x4 gg = *((const f32x4*)gam + lane + 64 * j), bb = *((const f32x4*)bet + lane + 64 * j); v[j] = v[j] * rstd * gg + bb; }
}

__device__ __forceinline__ void p6_ln1_router(LAS unsigned char* lds, const Args& a, int l, const int tid, const int nrep) {
    const int lane = tid & 63; const int wave = __builtin_amdgcn_readfirstlane(tid >> 6);
    unsigned char* ws = a.ws;
    LAS float* rwt = (LAS float*)lds;
    LAS int* ent_e = (LAS int*)(lds + 65536);
    LAS int* ent_p = ent_e + 128;
    LAS float* bias_l = (LAS float*)(ent_p + 128);
    { f32x4 rv[8];
#pragma unroll
      for (int q = 0; q < 8; ++q) rv[q] = *((const f32x4*)a.router_w + tid + q * NTHREADS);
#pragma unroll
      for (int q = 0; q < 8; ++q) { const int i4 = tid + q * NTHREADS, k = i4 >> 2, e0 = (i4 & 3) * 4;
#pragma unroll
          for (int c = 0; c < 4; ++c) rwt[(e0 + c) * DM + k] = rv[q][c]; } }
    if (tid < 16) bias_l[tid] = a.router_bias[tid];
    if (tid < 128) { ent_e[tid] = -1; ent_p[tid] = 0; }
    __syncthreads();
    const bf16_t* MIX = (const bf16_t*)(ws + WS_MIX); const bf16_t* XBr = (const bf16_t*)(ws + WS_XB); bf16_t* X1B = (bf16_t*)(ws + WS_X1B); float* GATE = (float*)(ws + WS_GATE);
    const float* gam = a.ln1_g + l * DM; const float* bet = a.ln1_b + l * DM;
    const int G = gridDim.x;
    const int ntok = (M / (256 * 8)) * nrep;
    u32x2 xw[4], mw[4];
    { const int m0 = blockIdx.x * 8 + wave;
#pragma unroll
      for (int j = 0; j < 4; ++j) { xw[j] = *((const u32x2*)(XBr + (size_t)m0 * DM) + lane + 64 * j); mw[j] = *((const u32x2*)(MIX + (size_t)m0 * DM) + lane + 64 * j); } }
    for (int it2 = 0; it2 < ntok; ++it2) {
        const int it = it2 & 7;
        const int m = (it * G + blockIdx.x) * 8 + wave;
        u32x2 nxw[4], nmw[4];
        { const int itn = (it2 + 1 < ntok ? it2 + 1 : it2) & 7; const int mn = (itn * G + blockIdx.x) * 8 + wave;
#pragma unroll
          for (int j = 0; j < 4; ++j) { nxw[j] = *((const u32x2*)(XBr + (size_t)mn * DM) + lane + 64 * j); nmw[j] = *((const u32x2*)(MIX + (size_t)mn * DM) + lane + 64 * j); } }
        f32x4 v[4];
#pragma unroll
        for (int j = 0; j < 4; ++j) { v[j][0] = ALPHA * bf_lo(xw[j].x) + bf_lo(mw[j].x); v[j][1] = ALPHA * bf_hi(xw[j].x) + bf_hi(mw[j].x); v[j][2] = ALPHA * bf_lo(xw[j].y) + bf_lo(mw[j].y); v[j][3] = ALPHA * bf_hi(xw[j].y) + bf_hi(mw[j].y); }
        ln_row(v, gam, bet, lane);
#pragma unroll
        for (int j = 0; j < 4; ++j) { u32x2 w; w.x = pk2(v[j][0], v[j][1]); w.y = pk2(v[j][2], v[j][3]); *((u32x2*)(X1B + (size_t)m * DM) + lane + 64 * j) = w; }
        float ps[16];
#pragma unroll
        for (int e = 0; e < 16; ++e) { float s = 0.f;
#pragma unroll
            for (int j = 0; j < 4; ++j) { const f32x4 r = *((const LAS f32x4*)(rwt + e * DM) + lane + 64 * j); s += v[j][0] * r[0] + v[j][1] * r[1] + v[j][2] * r[2] + v[j][3] * r[3]; }
            ps[e] = s; }
        float t8[8], u4[4];
#pragma unroll
        for (int e = 0; e < 8; ++e) { auto rr = __builtin_amdgcn_permlane32_swap(__float_as_uint(ps[e]), __float_as_uint(ps[e + 8]), false, false); t8[e] = __uint_as_float(rr[0]) + __uint_as_float(rr[1]); }
#pragma unroll
        for (int e = 0; e < 4; ++e) { auto rr = __builtin_amdgcn_permlane16_swap(__float_as_uint(t8[e]), __float_as_uint(t8[e + 4]), false, false); u4[e] = __uint_as_float(rr[0]) + __uint_as_float(rr[1]); }
#pragma unroll
        for (int e = 0; e < 4; ++e) { float x = u4[e]; x += dpp_f<0xB1>(x); x += dpp_f<0x4E>(x); x += dpp_f<0x141>(x); x += dpp_f<0x140>(x); u4[e] = x; }
        float lg[16];
#pragma unroll
        for (int e = 0; e < 4; ++e) { const int ub = (int)__float_as_uint(u4[e]);
            lg[e] = __uint_as_float((unsigned)__builtin_amdgcn_readlane(ub, 0)); lg[e + 4] = __uint_as_float((unsigned)__builtin_amdgcn_readlane(ub, 16));
            lg[e + 8] = __uint_as_float((unsigned)__builtin_amdgcn_readlane(ub, 32)); lg[e + 12] = __uint_as_float((unsigned)__builtin_amdgcn_readlane(ub, 48)); }
#pragma unroll
        for (int j = 0; j < 4; ++j) { xw[j] = nxw[j]; mw[j] = nmw[j]; }
        float best_gs = -INFINITY, be_a1 = 0.f, be_a2 = 0.f; int be1 = 0, be2 = 0;
#pragma unroll
        for (int gi = 0; gi < 4; ++gi) {
            float af[4], bs[4];
#pragma unroll
            for (int j = 0; j < 4; ++j) { af[j] = 1.0f / (1.0f + expf(-lg[gi * 4 + j])); bs[j] = af[j] + bias_l[gi * 4 + j]; }
            int i1 = 0; float m1 = bs[0], a1 = af[0];
#pragma unroll
            for (int j = 1; j < 4; ++j) if (bs[j] > m1) { m1 = bs[j]; a1 = af[j]; i1 = j; }
            int i2 = -1; float m2 = -INFINITY, a2 = 0.f;
#pragma unroll
            for (int j = 0; j < 4; ++j) if (j != i1 && bs[j] > m2) { m2 = bs[j]; a2 = af[j]; i2 = j; }
            const float gs = m1 + m2;
            if (gs > best_gs) { best_gs = gs; be1 = gi * 4 + i1; be2 = gi * 4 + i2; be_a1 = a1; be_a2 = a2; }
        }
        if (lane == 0) { const float inv = 1.0f / (be_a1 + be_a2); GATE[(size_t)m * 2] = be_a1 * inv; GATE[(size_t)m * 2 + 1] = be_a2 * inv;
            const int slot = (it * 8 + wave) * 2; ent_e[slot] = be1; ent_p[slot] = m * 2; ent_e[slot + 1] = be2; ent_p[slot + 1] = m * 2 + 1; }
    }
    __syncthreads();
    if (tid < 16) { const int e = tid; int cnt = 0;
        for (int i = 0; i < 128; ++i) cnt += (ent_e[i] == e) ? 1 : 0;
        if (cnt > 0) { int* ctr = (int*)(ws + WS_CTL) + l * 16 + e; int base = atomicAdd(ctr, cnt); int* el = (int*)(ws + WS_ELIST) + ((size_t)l * 16 + e) * 16384;
            for (int i = 0; i < 128; ++i) if (ent_e[i] == e) el[base++] = ent_p[i]; } }
    __syncthreads();
}

__device__ __forceinline__ void p9_ln2(const Args& a, int l, int gw, int NGW, int lane) {
    unsigned char* ws = a.ws; const bf16_t* X1B = (const bf16_t*)(ws + WS_X1B); const bf16_t* Y = (const bf16_t*)(ws + WS_Y); bf16_t* XB = (bf16_t*)(ws + WS_XB);
    const float* gam = a.ln2_g + l * DM; const float* bet = a.ln2_b + l * DM;
    u32x2 xw[4], y0[4], y1[4];
#pragma unroll
    for (int j = 0; j < 4; ++j) { xw[j] = *((const u32x2*)(X1B + (size_t)gw * DM) + lane + 64 * j); y0[j] = *((const u32x2*)(Y + (size_t)(2 * gw) * DM) + lane + 64 * j); y1[j] = *((const u32x2*)(Y + (size_t)(2 * gw + 1) * DM) + lane + 64 * j); }
    for (int m = gw; m < M; m += NGW) {
        u32x2 nxw[4], ny0[4], ny1[4];
        { const int mn = m + NGW < M ? m + NGW : m;
#pragma unroll
          for (int j = 0; j < 4; ++j) { nxw[j] = *((const u32x2*)(X1B + (size_t)mn * DM) + lane + 64 * j); ny0[j] = *((const u32x2*)(Y + (size_t)(2 * mn) * DM) + lane + 64 * j); ny1[j] = *((const u32x2*)(Y + (size_t)(2 * mn + 1) * DM) + lane + 64 * j); } }
        f32x4 v[4];
#pragma unroll
        for (int j = 0; j < 4; ++j) {
            v[j][0] = ALPHA * bf_lo(xw[j].x) + (bf_lo(y0[j].x) + bf_lo(y1[j].x)); v[j][1] = ALPHA * bf_hi(xw[j].x) + (bf_hi(y0[j].x) + bf_hi(y1[j].x));
            v[j][2] = ALPHA * bf_lo(xw[j].y) + (bf_lo(y0[j].y) + bf_lo(y1[j].y)); v[j][3] = ALPHA * bf_hi(xw[j].y) + (bf_hi(y0[j].y) + bf_hi(y1[j].y)); }
#pragma unroll
        for (int j = 0; j < 4; ++j) { xw[j] = nxw[j]; y0[j] = ny0[j]; y1[j] = ny1[j]; }
        ln_row(v, gam, bet, lane);
#pragma unroll
        for (int j = 0; j < 4; ++j) {
            if (l + 1 < DEPTH) { u32x2 w; w.x = pk2(v[j][0], v[j][1]); w.y = pk2(v[j][2], v[j][3]); *((u32x2*)(XB + (size_t)m * DM) + lane + 64 * j) = w; }
            else *((f32x4*)(a.out + (size_t)m * DM) + lane + 64 * j) = v[j]; }
    }
}


#define XB_TMO      128
#define XB_XCNT(j)  (256  + 64 * (j))
#define XB_XSUB(j)  (1280 + 64 * (j))
#define XB_XGEN(j)  (2304 + 64 * (j))
#define XB_TOP      3328
#define XB_TOPGEN   3392
#define XCD_BAR_WORDS 3456
#define XB_SPIN_CAP (1u << 18)
__device__ __forceinline__ unsigned xb_ld(unsigned* p)              { return __hip_atomic_load(p, __ATOMIC_RELAXED, __HIP_MEMORY_SCOPE_AGENT); }
__device__ __forceinline__ unsigned xb_add(unsigned* p, unsigned v) { return __hip_atomic_fetch_add(p, v, __ATOMIC_RELAXED, __HIP_MEMORY_SCOPE_AGENT); }
__device__ __forceinline__ unsigned xb_xcc_id() { return (unsigned)__builtin_amdgcn_s_getreg((3 << 11) | 20) & 0xFu; }
#define XB_SPIN(cond, bar) do { unsigned _sp = 0; while (cond) { __builtin_amdgcn_s_sleep(1); \
    if ((++_sp & 255u) == 0u) { if (xb_ld(&(bar)[XB_TMO])) break; if (_sp > XB_SPIN_CAP) { atomicAdd(&(bar)[XB_TMO], 1u); break; } } } } while (0)
struct XcdBarrier { unsigned* bar; unsigned x; volatile LAS unsigned* st; };
__device__ __forceinline__ XcdBarrier xcd_barrier_post(unsigned* bar, volatile LAS unsigned* st) {
    XcdBarrier b; b.bar = bar; b.x = xb_xcc_id(); b.st = st;
    if (threadIdx.x == 0) (void)xb_add(&bar[XB_XCNT(b.x)], 1u);
    return b;
}
__device__ __forceinline__ void xcd_barrier_complete(unsigned* bar, unsigned x, unsigned& nloc, unsigned& nx) {
    const unsigned G = gridDim.x * gridDim.y * gridDim.z;
    unsigned sum, cnt, mine, sp = 0u;
    for (;;) {
        sum = 0u; cnt = 0u; mine = 0u;
#pragma unroll
        for (unsigned j = 0; j < 16; ++j) { const unsigned c = xb_ld(&bar[XB_XCNT(j)]); sum += c; cnt += (c > 0u) ? 1u : 0u; mine = (j == x) ? c : mine; }
        if (sum == G) break;
        __builtin_amdgcn_s_sleep(1);
        if ((++sp & 255u) == 0u) { if (xb_ld(&bar[XB_TMO])) break; if (sp > XB_SPIN_CAP) { atomicAdd(&bar[XB_TMO], 1u); break; } }
    }
    nloc = mine > 0u ? mine : 1u; nx = cnt > 0u ? cnt : 1u;
}
__device__ __forceinline__ void xcd_barrier(const XcdBarrier& b) {
    asm volatile("s_waitcnt vmcnt(0)" ::: "memory");
    __syncthreads();
    if (threadIdx.x == 0) {
        unsigned* bar = b.bar;
        __builtin_amdgcn_s_waitcnt(0);
        unsigned nloc = b.st[0], nx = b.st[1];
        if (nloc == 0u) { xcd_barrier_complete(bar, b.x, nloc, nx); b.st[0] = nloc; b.st[1] = nx; }
        const unsigned old = xb_add(&bar[XB_XSUB(b.x)], 1u);
        const unsigned gen = old / nloc;
        if (old + 1u == (gen + 1u) * nloc) {
            __builtin_amdgcn_fence(__ATOMIC_RELEASE, "agent");
            asm volatile("s_waitcnt vmcnt(0)" ::: "memory");
            const unsigned og = xb_add(&bar[XB_TOP], 1u);
            const unsigned tg = og / nx;
            if (og + 1u == (tg + 1u) * nx) xb_add(&bar[XB_TOPGEN], 1u);
            else XB_SPIN(xb_ld(&bar[XB_TOPGEN]) == tg, bar);
            __builtin_amdgcn_fence(__ATOMIC_ACQUIRE, "agent");
            xb_add(&bar[XB_XGEN(b.x)], 1u);
            asm volatile("s_waitcnt vmcnt(0)" ::: "memory");
        } else {
            XB_SPIN(xb_ld(&bar[XB_XGEN(b.x)]) == gen, bar);
            __builtin_amdgcn_fence(__ATOMIC_ACQUIRE, "agent");
            asm volatile("s_waitcnt vmcnt(0)" ::: "memory");
        }
    }
    __syncthreads();
}

#ifndef PROJ_MERGED
#define PROJ_MERGED 0
#endif
#ifndef MOE_MERGED
#define MOE_MERGED 1
#endif
constexpr int N_PHASES = 1 + 10 * DEPTH;
#ifndef DUP_MASK
#define DUP_MASK 0
#endif
#define NREP(k) ((((DUP_MASK) >> (k)) & 1) ? (((a.dup_mask >> (k)) & 1) + 1) : 1)

__global__ void __launch_bounds__(NTHREADS, 2) mega_fwd(Args a_param) {
    extern __shared__ __attribute__((aligned(16))) unsigned char lds_raw[];
    LAS unsigned char* const lds0 = (LAS unsigned char*)lds_raw;
    cg::grid_group grid = cg::this_grid();
    const int wave0 = __builtin_amdgcn_readfirstlane((int)threadIdx.x >> 6);
    const int G0 = gridDim.x, bx0 = blockIdx.x;
    volatile LAS unsigned* bar_st = (volatile LAS unsigned*)(lds0 + MISC_OFF + 1024);
    if (threadIdx.x < 4) bar_st[threadIdx.x] = 0u;
    __syncthreads();
    (void)xcd_barrier_post((unsigned*)(a_param.ws + WS_BAR), bar_st);
    typedef const __attribute__((address_space(4))) Args* kargs_t;
#define PHASE_IDS() int G = G0, bx = bx0; unsigned ldsu_ = (unsigned)(uintptr_t)lds0; asm volatile("" : "+s"(G), "+s"(bx), "+s"(ldsu_)); LAS unsigned char* lds = (LAS unsigned char*)(uintptr_t)ldsu_; const int vcu = (G % 8 == 0) ? (bx % 8) * (G / 8) + bx / 8 : bx; const int NGW = G * NWAVES; (void)NGW; (void)vcu; \
        kargs_t ap_ = (kargs_t)__builtin_amdgcn_kernarg_segment_ptr(); asm volatile("" : "+s"(ap_)); Args a; __builtin_memcpy(&a, ap_, sizeof(Args)); unsigned char* ws = a.ws; (void)ws; int tid; asm volatile("v_mbcnt_lo_u32_b32 %0, -1, 0\n\tv_mbcnt_hi_u32_b32 %0, -1, %0" : "=v"(tid)); tid += wave0 * 64; const int lane = tid & 63; const int wave = __builtin_amdgcn_readfirstlane(tid >> 6); const int gw = vcu * NWAVES + wave; (void)lane; (void)gw; \
        LAS float* scr = (LAS float*)(lds + wave * 16384); (void)scr
    const int lo = a_param.ph_lo, hi = a_param.ph_hi;
    if (lo < 0) grid.sync();
#ifdef DBG_ONLY
#define IN(k) ((((k) - 1) % 10 + 1 == DBG_ONLY || ((k) == 0 && DBG_ONLY == 0)) && lo <= (k) && (k) < hi)
#else
#define IN(k) (lo <= (k) && (k) < hi)
#endif
#define SEAM_BAR() do { kargs_t bp_ = (kargs_t)__builtin_amdgcn_kernarg_segment_ptr(); asm volatile("" : "+s"(bp_)); \
        XcdBarrier xb_; xb_.bar = (unsigned*)(bp_->ws + WS_BAR); xb_.x = xb_xcc_id(); xb_.st = (volatile LAS unsigned*)(lds0 + MISC_OFF + 1024); xcd_barrier(xb_); } while (0)
#define SEAM(k) do { if (IN(k) && IN((k) + 1)) { { kargs_t bp_ = (kargs_t)__builtin_amdgcn_kernarg_segment_ptr(); asm volatile("" : "+s"(bp_)); \
        XcdBarrier xb_; xb_.bar = (unsigned*)(bp_->ws + WS_BAR); xb_.x = xb_xcc_id(); xb_.st = (volatile LAS unsigned*)(lds0 + MISC_OFF + 1024); xcd_barrier(xb_); if ((DUP_MASK) & 0x2000) xcd_barrier(xb_); } } } while (0)

    if (IN(0)) { PHASE_IDS(); for (int rep = 0; rep < NREP(10); ++rep) { p0_small_weights(a, scr, gw, NGW, lane); p0_expert_weights(a, 0, scr, gw, NGW, lane); p0_misc(a, gw, NGW, lane); } }
    SEAM(0);
    for (int l = 0; l < DEPTH; ++l) {
        const int P = 1 + 10 * l;
#if PROJ_MERGED
        if (IN(P + 0)) { PHASE_IDS();
            pg8::ProjSched S; S.XB = (const bf16_t*)(ws + WS_XB); S.PROJ = (const bf16_t*)(ws + WS_PROJ); S.WIN = (const bf16_t*)(ws + WS_WIN) + (size_t)l * NPROJ * DM;
            S.WQUP = (const bf16_t*)(ws + WS_WQUP) + (size_t)l * 768 * 384; S.WKV = (const bf16_t*)(ws + WS_WKV) + (size_t)l * 1024 * 256;
            S.c01 = (unsigned*)(ws + WS_CTL) + 768 + l * 128; S.c12 = S.c01 + 64; S.G = G; S.v = bx;
            pg8::EpiProj E0{(bf16_t*)(ws + WS_PROJ), NPROJ, (float*)(ws + WS_RS), (bf16_t*)(ws + WS_KR), (const float*)(ws + WS_ROPE), (const float*)(ws + WS_ROPE) + SEQ * 16, true};
            pg8::EpiQRope E1{(bf16_t*)(ws + WS_Q), 768, (const float*)(ws + WS_RS), (const float*)(ws + WS_ROPE), (const float*)(ws + WS_ROPE) + SEQ * 16};
            pg8::EpiBf16 E2{(bf16_t*)(ws + WS_KVU), 1024, (const float*)(ws + WS_RS), 12, 2, 1.f / 256.f};
            pg8::gemm_stream(lds, S, E0, E1, E2, tid);
        }
        if (IN(P + 0) && IN(P + 3)) SEAM_BAR();
#else
        if (IN(P + 0)) { PHASE_IDS();
            pg8::DenseSched S; S.A = (const bf16_t*)(ws + WS_XB); S.Bt = (const bf16_t*)(ws + WS_WIN) + (size_t)l * NPROJ * DM; S.lda = DM; S.K = DM; S.so.init(M, NPROJ, G, bx, NREP(0));
            pg8::EpiProj E{(bf16_t*)(ws + WS_PROJ), NPROJ, (float*)(ws + WS_RS), (bf16_t*)(ws + WS_KR), (const float*)(ws + WS_ROPE), (const float*)(ws + WS_ROPE) + SEQ * 16, false};
            pg8::gemm_phase(lds, S, E, tid);
        }
        if (IN(P + 0) && IN(P + 2)) SEAM_BAR();
        if (IN(P + 2)) { PHASE_IDS();
            { pg8::DenseSched S; S.A = (const bf16_t*)(ws + WS_PROJ) + C_QA; S.Bt = (const bf16_t*)(ws + WS_WQUP) + (size_t)l * 768 * 384; S.lda = NPROJ; S.K = 384; S.so.init(M, 768, G, bx - 64, NREP(2));
              pg8::EpiQRope E{(bf16_t*)(ws + WS_Q), 768, (const float*)(ws + WS_RS), (const float*)(ws + WS_ROPE), (const float*)(ws + WS_ROPE) + SEQ * 16};
              pg8::gemm_phase(lds, S, E, tid); }
            { pg8::DenseSched S; S.A = (const bf16_t*)(ws + WS_PROJ) + C_KVA; S.Bt = (const bf16_t*)(ws + WS_WKV) + (size_t)l * 1024 * 256; S.lda = NPROJ; S.K = 256; S.so.init(M, 1024, G, bx, NREP(2));
              pg8::EpiBf16 E{(bf16_t*)(ws + WS_KVU), 1024, (const float*)(ws + WS_RS), 12, 2, 1.f / 256.f};
              pg8::gemm_phase(lds, S, E, tid); }
        }
        SEAM(P + 2);
#endif
        if (IN(P + 3)) { PHASE_IDS();
#ifndef DBG_NOMLA
            for (int rep = 0; rep < NREP(3); ++rep)
            for (int u = vcu; u < 256; u += G) { const int bh = u >> 2, s = u & 3;
                for (int k = 0; k < 2; ++k) attn_unit<false>(lds, a, bh >> 3, bh & 7, k ? s : 7 - s, tid); }
#endif
#ifndef DBG_NOIDX
            for (int uu = vcu; uu < 256 * NREP(11); uu += G) { const int u = uu & 255; const int b = u >> 5, s = u & 31;
                for (int k = 0; k < 2; ++k) idx_unit(lds, a, b, k ? s : 63 - s, tid); }
#endif
        }
        SEAM(P + 3);
        if (IN(P + 4)) { PHASE_IDS();
            for (int uu = vcu; uu < 256 * NREP(4); uu += G) { const int u = uu & 255; const int b = u >> 5, s = u & 31;
                for (int k = 0; k < 2; ++k) attn_unit<true>(lds, a, b, 0, k ? s : 63 - s, tid); }
        }
        SEAM(P + 4);
        if (IN(P + 5)) { PHASE_IDS();
            pg8::DenseSched S; S.A = (const bf16_t*)(ws + WS_CONCAT); S.Bt = (const bf16_t*)(ws + WS_WO) + (size_t)l * DM * DM; S.lda = DM; S.K = DM; S.so.init(M, DM, G, bx, NREP(5));
            pg8::EpiBf16 E{(bf16_t*)(ws + WS_MIX), DM, nullptr, 0, 0, 0.f};
            pg8::gemm_phase(lds, S, E, tid);
        }
        SEAM(P + 5);
        if (IN(P + 6)) { PHASE_IDS(); p6_ln1_router(lds, a, l, tid, NREP(6)); }
        SEAM(P + 6);
        if (IN(P + 7) || IN(P + 8)) { PHASE_IDS();
            LAS int* tstart = (LAS int*)(lds + MISC_OFF); LAS int* ecnt = tstart + 32;
            if (tid < 16) ecnt[tid] = __hip_atomic_load((const int*)(ws + WS_CTL) + l * 16 + tid, __ATOMIC_RELAXED, __HIP_MEMORY_SCOPE_AGENT);
            __syncthreads();
            if (tid == 0) { int acc = 0;
                for (int e = 0; e < 16; ++e) { tstart[e] = acc; acc += (ecnt[e] + 255) >> 8; }
                tstart[16] = acc; }
            __syncthreads();
#if MOE_MERGED
            { pg8::Moe12Sched S; S.X1B = (const bf16_t*)(ws + WS_X1B); S.H = (const bf16_t*)(ws + WS_H); S.WGU = (const bf16_t*)(ws + WS_WGU); S.WD = (const bf16_t*)(ws + WS_WD);
              S.elist = (const int*)(ws + WS_ELIST) + (size_t)l * 16 * 16384; S.tstart = tstart; S.ecnt = ecnt; S.ready = (unsigned*)(ws + WS_CTL) + 256 + l * 256; S.G = G; S.v = vcu;
              pg8::EpiMoe1 E1{(bf16_t*)(ws + WS_H), (const float*)(ws + WS_GATE)}; pg8::EpiMoe2 E2{(bf16_t*)(ws + WS_Y)};
              pg8::gemm_stream(lds, S, E1, E2, E2, tid); }
#else
            if (IN(P + 7)) {
                pg8::MoeSched S; S.A = (const bf16_t*)(ws + WS_X1B); S.Bt = (const bf16_t*)(ws + WS_WGU); S.lda = DM; S.K = DM; S.b_estride = (size_t)DM * DM * 2; S.elist = (const int*)(ws + WS_ELIST) + (size_t)l * 16 * 16384; S.rsh = 1;
                S.tstart = tstart; S.ecnt = ecnt; S.G = G; S.v = vcu; S.nrep = NREP(7);
                pg8::EpiMoe1 E{(bf16_t*)(ws + WS_H), (const float*)(ws + WS_GATE)};
                pg8::gemm_phase(lds, S, E, tid);
            }
            SEAM(P + 7);
            if (IN(P + 8)) {
                pg8::MoeSched S; S.A = (const bf16_t*)(ws + WS_H); S.Bt = (const bf16_t*)(ws + WS_WD); S.lda = DFF; S.K = DFF; S.b_estride = (size_t)DM * DFF * 2; S.elist = (const int*)(ws + WS_ELIST) + (size_t)l * 16 * 16384; S.rsh = 0;
                S.tstart = tstart; S.ecnt = ecnt; S.G = G; S.v = vcu; S.nrep = NREP(8);
                pg8::EpiMoe2 E{(bf16_t*)(ws + WS_Y)};
                pg8::gemm_phase(lds, S, E, tid);
            }
#endif
        } else { SEAM(P + 7); }
        SEAM(P + 8);
        if (IN(P + 9)) { PHASE_IDS(); for (int rep = 0; rep < NREP(9); ++rep) p9_ln2(a, l, gw, NGW, lane); if (l + 1 < DEPTH) for (int rep = 0; rep < NREP(12); ++rep) p0_expert_weights(a, l + 1, scr, gw, NGW, lane); }
        SEAM(P + 9);
    }
#undef IN
#undef SEAM
}

#ifndef MK_PER_PHASE
#define MK_PER_PHASE 0
#endif
extern "C" void kernel_launch(void* const* d_in, const int* in_sizes, int n_in, void* d_out, int out_size, void* d_ws, size_t ws_size, hipStream_t stream) {
    static int grid_blocks = 0;
    if (grid_blocks == 0) {
        if (n_in != 17 || in_sizes[0] != M * DM || out_size != M * DM || ws_size < WS_END) { fprintf(stderr, "kernel_launch: unexpected shapes / workspace (n_in %d, in0 %d, out %d, ws %zu); nothing launched\n", n_in, n_in > 0 ? in_sizes[0] : -1, out_size, ws_size); grid_blocks = -1; return; }
        int dev = 0, cus = 0, per_cu = 0;
        (void)hipGetDevice(&dev);
        (void)hipDeviceGetAttribute(&cus, hipDeviceAttributeMultiprocessorCount, dev);
        (void)hipFuncSetAttribute((const void*)mega_fwd, hipFuncAttributeMaxDynamicSharedMemorySize, LDS_BYTES);
        (void)hipOccupancyMaxActiveBlocksPerMultiprocessor(&per_cu, (const void*)mega_fwd, NTHREADS, LDS_BYTES);
        fprintf(stderr, "kernel_launch: cus %d per_cu %d ws_size %zu\n", cus, per_cu, ws_size);
        if (per_cu < 1 || cus < 1) { grid_blocks = -1; return; }
        grid_blocks = cus > 256 ? 256 : cus;
    }
    if (grid_blocks < 0) return;
    (void)hipMemsetAsync((unsigned char*)d_ws + WS_BAR, 0, XCD_BAR_WORDS * 4, stream);
    Args a{};
    a.x = (const float*)d_in[0]; a.w_in = (const float*)d_in[1]; a.q_norm_g = (const float*)d_in[2]; a.w_q_up = (const float*)d_in[3]; a.kv_norm_g = (const float*)d_in[4];
    a.w_uk = (const float*)d_in[5]; a.w_uv = (const float*)d_in[6]; a.w_o = (const float*)d_in[7]; a.ln1_g = (const float*)d_in[8]; a.ln1_b = (const float*)d_in[9];
    a.router_w = (const float*)d_in[10]; a.router_bias = (const float*)d_in[11]; a.w_gate = (const float*)d_in[12]; a.w_up = (const float*)d_in[13]; a.w_down = (const float*)d_in[14];
    a.ln2_g = (const float*)d_in[15]; a.ln2_b = (const float*)d_in[16];
    a.out = (float*)d_out; a.ws = (unsigned char*)d_ws;
#if MK_PER_PHASE
    for (int p = 0; p < N_PHASES; ++p) { a.ph_lo = p; a.ph_hi = p + 1; void* args[] = {&a};
        hipError_t e = hipLaunchCooperativeKernel((const void*)mega_fwd, dim3(grid_blocks), dim3(NTHREADS), args, LDS_BYTES, stream);
        if (e != hipSuccess) { fprintf(stderr, "launch %d failed: %s\n", p, hipGetErrorString(e)); break; } }
#else
    a.ph_lo = 0; a.ph_hi = N_PHASES; a.dup_mask = DUP_MASK; void* args[] = {&a};
    hipError_t e = hipLaunchCooperativeKernel((const void*)mega_fwd, dim3(grid_blocks), dim3(NTHREADS), args, LDS_BYTES, stream);
    if (e != hipSuccess) fprintf(stderr, "cooperative launch failed: %s (grid %d)\n", hipGetErrorString(e), grid_blocks);
#endif
}
```

```cpp
#include <hip/hip_runtime.h>
#include <hip/hip_cooperative_groups.h>
#include <cstdio>
#include <cstdint>
namespace cg = cooperative_groups;

#define LAS __attribute__((address_space(3)))
typedef unsigned short bf16_t;
typedef short bf16x8 __attribute__((ext_vector_type(8)));
typedef short s16x4 __attribute__((ext_vector_type(4)));
typedef float f32x2 __attribute__((ext_vector_type(2)));
typedef float f32x4 __attribute__((ext_vector_type(4)));
typedef float f32x16 __attribute__((ext_vector_type(16)));
typedef unsigned u32x2 __attribute__((ext_vector_type(2)));
typedef unsigned u32x4 __attribute__((ext_vector_type(4)));
typedef __bf16 bf16x2_t __attribute__((ext_vector_type(2)));

constexpr int DM = 1024, NBATCH = 8, SEQ = 2048, M = NBATCH * SEQ, DEPTH = 2;
constexpr int NPROJ = 1792;
constexpr int IN_COLS = 1608;
constexpr int C_QA = 0, C_KVA = 384, C_KR = 640, C_DQ = 672, C_DK = 1184, C_DV = 1248, C_IQ = 1312, C_IK = 1568, C_IW = 1600;
constexpr int NEXP = 16, DFF = 512;
constexpr float ALPHA = 1.4142135623730951f;
constexpr float LN_EPS = 1e-5f, RMS_EPS = 1e-6f;
constexpr float LOG2E = 1.4426950408889634f;
constexpr float MLA_QSCALE = 0.10206207261596575f * LOG2E;
constexpr float DSA_QSCALE = 0.125f * LOG2E;
constexpr int NTHREADS = 512, NWAVES = 8;
constexpr int LDS_BYTES = 147456;
constexpr int RING_BYTES = 131072;
constexpr int MISC_OFF = RING_BYTES;

constexpr size_t MiB = 1u << 20;
constexpr size_t WS_CTL   = 0;
constexpr size_t WS_BAR   = 65536;
constexpr size_t WS_ELIST = 1 * MiB;
constexpr size_t WS_GATE  = 3 * MiB;
constexpr size_t WS_ROPE  = 3 * MiB + 512 * 1024;
constexpr size_t WS_MASK  = 4 * MiB;
constexpr size_t WS_WIN   = 8 * MiB;
constexpr size_t WS_WQUP  = 15 * MiB;
constexpr size_t WS_WKV   = 17 * MiB;
constexpr size_t WS_WO    = 18 * MiB;
constexpr size_t WS_WGU   = 22 * MiB;
constexpr size_t WS_WD    = 54 * MiB;
constexpr size_t WS_R1    = 70 * MiB;
constexpr size_t WS_R2    = 134 * MiB;
constexpr size_t WS_R3    = 166 * MiB;
constexpr size_t WS_R4    = 198 * MiB;
constexpr size_t WS_R5    = 230 * MiB;
constexpr size_t WS_END   = 262 * MiB;
constexpr size_t WS_PROJ = WS_R1, WS_MIX = WS_R1, WS_X1B = WS_R3, WS_Y = WS_R1;
constexpr size_t WS_XB = WS_R5, WS_Q = WS_R2, WS_KR = WS_R2 + 24 * MiB, WS_RS = WS_R2 + 25 * MiB  , WS_H = WS_R2;
constexpr size_t WS_KVU = WS_R3, WS_CONCAT = WS_R4;

__device__ __forceinline__ unsigned pk2(float lo, float hi) { f32x2 v = {lo, hi}; bf16x2_t b = __builtin_convertvector(v, bf16x2_t); return __builtin_bit_cast(unsigned, b); }
__device__ __forceinline__ float bf_lo(unsigned w) { return __uint_as_float(w << 16); }
__device__ __forceinline__ float bf_hi(unsigned w) { return __uint_as_float(w & 0xffff0000u); }
__device__ __forceinline__ float bf2f(bf16_t h) { return __uint_as_float((unsigned)h << 16); }
template <int CTRL> __device__ __forceinline__ float dpp_f(float x) { return __builtin_bit_cast(float, __builtin_amdgcn_mov_dpp(__builtin_bit_cast(int, x), CTRL, 0xf, 0xf, true)); }
template <int CTRL> __device__ __forceinline__ int dpp_i(int x) { return __builtin_amdgcn_mov_dpp(x, CTRL, 0xf, 0xf, true); }
__device__ __forceinline__ float wave_sum(float v) {
    v += dpp_f<0xB1>(v); v += dpp_f<0x4E>(v); v += dpp_f<0x141>(v); v += dpp_f<0x140>(v);
    { auto s = __builtin_amdgcn_permlane16_swap(__float_as_uint(v), __float_as_uint(v), false, false); v = __uint_as_float(s[0]) + __uint_as_float(s[1]); }
    { auto t = __builtin_amdgcn_permlane32_swap(__float_as_uint(v), __float_as_uint(v), false, false); v = __uint_as_float(t[0]) + __uint_as_float(t[1]); }
    return v;
}
__device__ __forceinline__ int half32_sum(int v) {
    v += dpp_i<0xB1>(v); v += dpp_i<0x4E>(v); v += dpp_i<0x141>(v); v += dpp_i<0x140>(v);
    auto s = __builtin_amdgcn_permlane16_swap((unsigned)v, (unsigned)v, false, false); return (int)(s[0] + s[1]);
}
__device__ __forceinline__ unsigned half32_max(unsigned v) {
    v = max(v, (unsigned)dpp_i<0xB1>((int)v)); v = max(v, (unsigned)dpp_i<0x4E>((int)v)); v = max(v, (unsigned)dpp_i<0x141>((int)v)); v = max(v, (unsigned)dpp_i<0x140>((int)v));
    auto s = __builtin_amdgcn_permlane16_swap(v, v, false, false); return max(s[0], s[1]);
}
__device__ __forceinline__ float fast_exp2(float x) { return __builtin_amdgcn_exp2f(x); }

namespace pg8 {
constexpr int BM = 256, BK = 64, HALF = 128, HTB = HALF * BK * 2, NXCD = 8, WGM = 8;
__device__ __forceinline__ int lds_byte(int r, int c) { const int st = (r >> 4) * 2 + (c >> 5), rr = r & 15, cc = c & 31, ob = rr * 64 + cc * 2; return st * 1024 + (ob ^ (((ob >> 9) & 1) << 5)); }
__device__ __forceinline__ void stage_rc(int b, int& R, int& C) { const int st = b / 1024, sb = b % 1024, swz = sb ^ (((sb >> 9) & 1) << 5); R = (st >> 1) * 16 + swz / 64; C = (st & 1) * 32 + (swz % 64) / 2; }
__device__ __forceinline__ int perm32(int rho) { const int n = rho >> 4, i = rho & 15; return 8 * (i >> 2) + 4 * n + (i & 3); }

struct Unit { int pm, pn, e, nvalid; };

struct StaticOrder {
    int nM, nN, nwg, G, c, nrep;
    __device__ void init(int Mrows, int N, int G_, int c_, int nrep_ = 1) { nM = Mrows / BM; nN = N / BM; nwg = nM * nN; G = G_; c = c_; nrep = nrep_; }
    __device__ bool next(int i, Unit& u) const {
        long L = (long)i * G + c; if (c < 0 || L >= (long)nwg * nrep) return false;
        L %= nwg;
        int wgid = (int)L; { const int q = nwg / NXCD, r = nwg % NXCD, xcd = wgid % NXCD, off = wgid / NXCD; wgid = (xcd < r ? xcd * (q + 1) : r * (q + 1) + (xcd - r) * q) + off; }
        const int nig = WGM * nN, gid = wgid / nig, fm = gid * WGM, gsz = (nM - fm) < WGM ? (nM - fm) : WGM;
        u.pm = fm + ((wgid % nig) % gsz); u.pn = (wgid % nig) / gsz; u.e = 0; u.nvalid = 256; return true;
    }
};
struct DenseSched {
    static constexpr bool GATHER = false;
    const bf16_t* A; const bf16_t* Bt; int lda, K; StaticOrder so;
    __device__ __forceinline__ bool next(int i, Unit& u) const { return so.next(i, u); }
    __device__ __forceinline__ const char* a_base(const Unit& u) const { return (const char*)A + (size_t)u.pm * BM * lda * 2; }
    __device__ __forceinline__ const char* b_base(const Unit& u) const { return (const char*)Bt + (size_t)u.pn * BM * K * 2; }
    __device__ __forceinline__ unsigned a_off(const Unit&, int r) const { return (unsigned)r * (unsigned)lda * 2u; }
};
struct MoeSched {
    static constexpr bool GATHER = true;
    const bf16_t* A; const bf16_t* Bt; int lda, K; size_t b_estride; const int* elist; int rsh;
    const LAS int* tstart; const LAS int* ecnt; int G, v, nrep;
    __device__ __forceinline__ bool next(int i, Unit& u) const {
        int L = i * G + v; const int total = tstart[16] * 4; if (L >= total * nrep) return false;
        L %= total;
        const int mt = L >> 2; u.pn = L & 3; int e = 0;
#pragma unroll
        for (int k = 1; k < 16; ++k) if (mt >= tstart[k]) e = k;
        e = __builtin_amdgcn_readfirstlane(e);
        u.e = e; u.pm = __builtin_amdgcn_readfirstlane(mt - tstart[e]);
        int nv = ecnt[e] - u.pm * 256; nv = nv > 256 ? 256 : nv; u.nvalid = __builtin_amdgcn_readfirstlane(nv); return true;
    }
    __device__ __forceinline__ const char* a_base(const Unit&) const { return (const char*)A; }
    __device__ __forceinline__ const char* b_base(const Unit& u) const { return (const char*)Bt + (size_t)u.e * b_estride + (size_t)u.pn * BM * K * 2; }
    __device__ __forceinline__ int row_id(const Unit& u, int r) const { const int rr = r < u.nvalid ? r : 0; return elist[u.e * 16384 + u.pm * 256 + rr]; }
    __device__ __forceinline__ unsigned a_off(const Unit& u, int r) const { return (unsigned)(row_id(u, r) >> rsh) * (unsigned)lda * 2u; }
};

template <class Epi, class Sched>
__device__ __forceinline__ void gemm_phase(LAS unsigned char* lds, const Sched& S, const Epi& E, const int tid) {
    const int wid = __builtin_amdgcn_readfirstlane(tid >> 6), lane = tid & 63, wr = wid >> 2, wc = wid & 3, fr = lane & 15, fq = lane >> 4;
    const int K = S.K, nt = K / BK;
    int RA[2], CA[2]; unsigned voffB[2];
#pragma unroll
    for (int i = 0; i < 2; ++i) { int R, C; stage_rc(tid * 16 + i * 8192, R, C); const int Rb = Epi::PERM ? ((R & ~31) + perm32(R & 31)) : R;
        RA[i] = R; CA[i] = C; voffB[i] = (unsigned)(Rb * K + C) * 2u; }
    const size_t kstep = (size_t)(BK * 2);
    const size_t hstepB = (size_t)HALF * K * 2;
    const unsigned ldsw = (unsigned)wid * 1024u;
    const int aoff = lds_byte(wr * 64 + fr, fq * 8), boff = lds_byte(wc * 32 + fr, fq * 8);
#define PG8_SA(b, h) (((b) * 2 + (h)) * HTB)
#define PG8_SB(b, h) ((4 + (b) * 2 + (h)) * HTB)
#define PG8_STAGE2(bufoff, gbase, v0, v1) do { \
        __builtin_amdgcn_global_load_lds((const unsigned*)((const char*)(gbase) + (v0)), (LAS unsigned*)(lds + (bufoff) + ldsw), 16, 0, 0); \
        __builtin_amdgcn_global_load_lds((const unsigned*)((const char*)(gbase) + (v1)), (LAS unsigned*)(lds + (bufoff) + ldsw + 8192), 16, 0, 0); } while (0)
#define PG8_STAGEB(bufoff, gbase) PG8_STAGE2(bufoff, gbase, voffB[0], voffB[1])
#define PG8_LDA(dst, b, h) do { _Pragma("unroll") for (int m = 0; m < 4; ++m) _Pragma("unroll") for (int k = 0; k < 2; ++k) dst[m][k] = *(const LAS bf16x8*)(lds + PG8_SA(b, h) + aoff + m * 2048 + k * 1024); } while (0)
#define PG8_LDB(dst, b, h) do { _Pragma("unroll") for (int n = 0; n < 2; ++n) _Pragma("unroll") for (int k = 0; k < 2; ++k) dst[n][k] = *(const LAS bf16x8*)(lds + PG8_SB(b, h) + boff + n * 2048 + k * 1024); } while (0)
#define PG8_MMA(ai, bj, At, Bt) do { __builtin_amdgcn_s_setprio(1); _Pragma("unroll") for (int m = 0; m < 4; ++m) _Pragma("unroll") for (int n = 0; n < 2; ++n) _Pragma("unroll") for (int k = 0; k < 2; ++k) \
        acc[ai][bj][m][n] = __builtin_amdgcn_mfma_f32_16x16x32_bf16(Bt[n][k], At[m][k], acc[ai][bj][m][n], 0, 0, 0); __builtin_amdgcn_s_setprio(0); } while (0)
#define PG8_WAIT_V(n) asm volatile("s_waitcnt vmcnt(" #n ")" ::: "memory")
#define PG8_WAIT_L(n) asm volatile("s_waitcnt lgkmcnt(" #n ")" ::: "memory")
#define PG8_BAR __builtin_amdgcn_s_barrier()
#define PG8_SCHED __builtin_amdgcn_sched_barrier(0)
    Unit cur, nxt; int ui = 0;
    if (!S.next(0, cur)) return;
    f32x4 acc[2][2][4][2];
#pragma unroll
    for (int a = 0; a < 2; ++a)
#pragma unroll
        for (int b = 0; b < 2; ++b)
#pragma unroll
            for (int m = 0; m < 4; ++m)
#pragma unroll
                for (int n = 0; n < 2; ++n) acc[a][b][m][n] = (f32x4){0.f, 0.f, 0.f, 0.f};
    bf16x8 At[4][2], B0[2][2], B1[2][2];
    const char* cA = S.a_base(cur); const char* cB = S.b_base(cur);
    unsigned vc00, vc01, vc10, vc11, vn00, vn01, vn10, vn11;
    vc00 = S.a_off(cur, RA[0]) + CA[0] * 2; vc01 = S.a_off(cur, RA[1]) + CA[1] * 2; vc10 = S.a_off(cur, HALF + RA[0]) + CA[0] * 2; vc11 = S.a_off(cur, HALF + RA[1]) + CA[1] * 2;
    PG8_STAGEB(PG8_SB(0, 0), cB); PG8_STAGEB(PG8_SB(0, 1), cB + hstepB); PG8_STAGE2(PG8_SA(0, 0), cA, vc00, vc01); PG8_STAGE2(PG8_SA(0, 1), cA, vc10, vc11);
    if (wr == 1) PG8_BAR;
    PG8_WAIT_V(2); PG8_BAR;
    PG8_STAGEB(PG8_SB(1, 0), cB + kstep); PG8_STAGE2(PG8_SA(1, 0), cA + kstep, vc00, vc01); PG8_STAGEB(PG8_SB(1, 1), cB + hstepB + kstep);
    PG8_WAIT_V(6); PG8_BAR;
    for (;;) {
        const bool has_next = S.next(ui + 1, nxt);
        const char* nA = has_next ? S.a_base(nxt) : cA; const char* nB = has_next ? S.b_base(nxt) : cB;
        if (Sched::GATHER) {
            if (has_next) { vn00 = S.a_off(nxt, RA[0]) + CA[0] * 2; vn01 = S.a_off(nxt, RA[1]) + CA[1] * 2; vn10 = S.a_off(nxt, HALF + RA[0]) + CA[0] * 2; vn11 = S.a_off(nxt, HALF + RA[1]) + CA[1] * 2; }
            else { vn00 = vc00; vn01 = vc01; vn10 = vc10; vn11 = vc11; }
        } else { vn00 = vc00; vn01 = vc01; vn10 = vc10; vn11 = vc11; }
        for (int t = 0; t < nt; t += 2) {
            const bool last = (t == nt - 2);
            const char* a1 = cA + (size_t)(t + 1) * kstep;
            const char* a2 = last ? nA : cA + (size_t)(t + 2) * kstep; const char* b2 = last ? nB : cB + (size_t)(t + 2) * kstep;
            const char* a3 = a2 + kstep; const char* b3 = b2 + kstep;
            unsigned w00 = vc00, w01 = vc01, w10 = vc10, w11 = vc11;
            if (Sched::GATHER) { if (last) { w00 = vn00; w01 = vn01; w10 = vn10; w11 = vn11; } }
            PG8_LDB(B0, 0, 0); PG8_LDB(B1, 0, 1); PG8_SCHED; PG8_LDA(At, 0, 0); PG8_STAGE2(PG8_SA(1, 1), a1, vc10, vc11);
            PG8_WAIT_V(8); PG8_WAIT_L(0); PG8_BAR; PG8_MMA(0, 0, At, B0); PG8_MMA(0, 1, At, B1); PG8_BAR; PG8_SCHED;
            PG8_LDA(At, 0, 1); PG8_STAGEB(PG8_SB(0, 0), b2); PG8_STAGEB(PG8_SB(0, 1), b2 + hstepB); PG8_STAGE2(PG8_SA(0, 0), a2, w00, w01);
            PG8_WAIT_V(8); PG8_WAIT_L(0); PG8_BAR; PG8_MMA(1, 0, At, B0); PG8_MMA(1, 1, At, B1); PG8_BAR; PG8_SCHED;
            PG8_LDB(B0, 1, 0); PG8_LDB(B1, 1, 1); PG8_SCHED; PG8_LDA(At, 1, 0); PG8_STAGE2(PG8_SA(0, 1), a2, w10, w11);
            PG8_WAIT_V(8); PG8_WAIT_L(0); PG8_BAR; PG8_MMA(0, 0, At, B0); PG8_MMA(0, 1, At, B1); PG8_BAR; PG8_SCHED;
            PG8_LDA(At, 1, 1); PG8_STAGEB(PG8_SB(1, 0), b3); PG8_STAGEB(PG8_SB(1, 1), b3 + hstepB); PG8_STAGE2(PG8_SA(1, 0), a3, w00, w01);
            PG8_WAIT_V(8); PG8_WAIT_L(0); PG8_BAR; PG8_MMA(1, 0, At, B0); PG8_MMA(1, 1, At, B1); PG8_BAR; PG8_SCHED;
        }
        if (wr == 0) PG8_BAR;
        { int ln_; asm volatile("v_mbcnt_lo_u32_b32 %0, -1, 0\n\tv_mbcnt_hi_u32_b32 %0, -1, %0" : "=v"(ln_));
          E(acc, cur, S, wr, wc, ln_ & 15, ln_ >> 4); }
        if (!has_next) break;
#pragma unroll
        for (int a = 0; a < 2; ++a)
#pragma unroll
            for (int b = 0; b < 2; ++b)
#pragma unroll
                for (int m = 0; m < 4; ++m)
#pragma unroll
                    for (int n = 0; n < 2; ++n) acc[a][b][m][n] = (f32x4){0.f, 0.f, 0.f, 0.f};
        cur = nxt; cA = nA; cB = nB; ++ui; vc00 = vn00; vc01 = vn01; vc10 = vn10; vc11 = vn11;
        if (wr == 1) PG8_BAR;
    }
    PG8_WAIT_V(0);
    PG8_BAR;
#undef PG8_SA
#undef PG8_SB
#undef PG8_STAGE2
#undef PG8_STAGEB
#undef PG8_LDA
#undef PG8_LDB
#undef PG8_MMA
#undef PG8_WAIT_V
#undef PG8_WAIT_L
#undef PG8_BAR
#undef PG8_SCHED
}

#ifndef WT_STORES
#define WT_STORES 0
#endif
__device__ __forceinline__ void store16_wt(void* p, u32x4 w) {
#if WT_STORES
    asm volatile("global_store_dwordx4 %0, %1, off sc1\n\ts_nop 1" :: "v"(p), "v"(w) : "memory");
#else
    *(u32x4*)p = w;
#endif
}
__device__ __forceinline__ float xrow16_sum(float x) {
    auto s = __builtin_amdgcn_permlane16_swap(__float_as_uint(x), __float_as_uint(x), false, false); x = __uint_as_float(s[0]) + __uint_as_float(s[1]);
    auto t = __builtin_amdgcn_permlane32_swap(__float_as_uint(x), __float_as_uint(x), false, false); return __uint_as_float(t[0]) + __uint_as_float(t[1]);
}
__device__ __forceinline__ float rms_from_part(const float* part, int row, int g0, int nq, float inv_n) {
    float s = 0.f;
#pragma unroll
    for (int q = 0; q < 3; ++q) if (q < nq) { const f32x4 p = *(const f32x4*)(part + (size_t)row * 20 + g0 + 4 * q); s += (p[0] + p[1]) + (p[2] + p[3]); }
    return 1.0f / sqrtf(s * inv_n + RMS_EPS);
}
__device__ __forceinline__ void rms8_from_part(const float* part, int row0, int g0, int nq, float inv_n, float (&sc)[2][4]) {
#pragma unroll
    for (int ai = 0; ai < 2; ++ai) { f32x4 p[4][3];
#pragma unroll
        for (int m = 0; m < 4; ++m)
#pragma unroll
            for (int q = 0; q < 3; ++q) if (q < nq) p[m][q] = *(const f32x4*)(part + (size_t)(row0 + ai * HALF + m * 16) * 20 + g0 + 4 * q);
#pragma unroll
        for (int m = 0; m < 4; ++m) { float s = 0.f;
#pragma unroll
            for (int q = 0; q < 3; ++q) if (q < nq) s += (p[m][q][0] + p[m][q][1]) + (p[m][q][2] + p[m][q][3]);
            sc[ai][m] = 1.0f / sqrtf(s * inv_n + RMS_EPS); }
        asm volatile("" ::: "memory"); }
}
struct EpiBf16 {
    static constexpr bool PERM = true;
    bf16_t* O; int ldc; const float* part; int g0, nq; float inv_n;
    template <class Sched>
    __device__ __forceinline__ void operator()(const f32x4 (&acc)[2][2][4][2], const Unit& u, const Sched&, int wr, int wc, int fr, int fq) const {
        const int row0 = u.pm * BM + wr * 64 + fr; const int col0 = u.pn * BM + wc * 32 + 8 * fq;
        float scs[2][4];
        if (part) rms8_from_part(part, row0, g0, nq, inv_n, scs);
#pragma unroll
        for (int ai = 0; ai < 2; ++ai)
#pragma unroll
            for (int m = 0; m < 4; ++m) { const int row = row0 + ai * HALF + m * 16; bf16_t* rowp = O + (size_t)row * ldc + col0;
                const float sc = part ? scs[ai][m] : 1.f;
#pragma unroll
                for (int bj = 0; bj < 2; ++bj) { const f32x4 v0 = acc[ai][bj][m][0] * sc, v1 = acc[ai][bj][m][1] * sc;
                    u32x4 w; w.x = pk2(v0[0], v0[1]); w.y = pk2(v0[2], v0[3]); w.z = pk2(v1[0], v1[1]); w.w = pk2(v1[2], v1[3]);
                    store16_wt(rowp + bj * HALF, w); } }
    }
};
struct EpiProj {
    static constexpr bool PERM = true;
    bf16_t* O; int ldc; float* part; bf16_t* KR; const float* cs; const float* sn; bool wt;
    template <class Sched>
    __device__ __forceinline__ void operator()(const f32x4 (&acc)[2][2][4][2], const Unit& u, const Sched&, int wr, int wc, int fr, int fq) const {
        const int row0 = u.pm * BM + wr * 64 + fr; const int col0 = u.pn * BM + wc * 32 + 8 * fq;
#pragma unroll
        for (int ai = 0; ai < 2; ++ai)
#pragma unroll
            for (int m = 0; m < 4; ++m) { const int row = row0 + ai * HALF + m * 16; bf16_t* rowp = O + (size_t)row * ldc + col0;
#pragma unroll
                for (int bj = 0; bj < 2; ++bj) { const f32x4 v0 = acc[ai][bj][m][0], v1 = acc[ai][bj][m][1];
                    u32x4 w; w.x = pk2(v0[0], v0[1]); w.y = pk2(v0[2], v0[3]); w.z = pk2(v1[0], v1[1]); w.w = pk2(v1[2], v1[3]);
                    store16_wt(rowp + bj * HALF, w);
                    const int g = u.pn * 8 + bj * 4 + wc;
                    if (g < 20) { float ss = (v0[0] * v0[0] + v0[1] * v0[1]) + (v0[2] * v0[2] + v0[3] * v0[3]) + (v1[0] * v1[0] + v1[1] * v1[1]) + (v1[2] * v1[2] + v1[3] * v1[3]);
                        ss = xrow16_sum(ss); if (fq == 0) __hip_atomic_store(part + (size_t)row * 20 + g, ss, __ATOMIC_RELAXED, __HIP_MEMORY_SCOPE_AGENT); }
                    else if (g == 20) {
                        const int pos = row & (SEQ - 1); const int ib = 8 * (fq & 1);
                        const f32x4 c0 = *(const f32x4*)(cs + pos * 16 + ib), c1 = *(const f32x4*)(cs + pos * 16 + ib + 4), s0 = *(const f32x4*)(sn + pos * 16 + ib), s1 = *(const f32x4*)(sn + pos * 16 + ib + 4);
                        f32x4 y0, y1;
#pragma unroll
                        for (int j = 0; j < 4; ++j) {
                            auto e0 = __builtin_amdgcn_permlane32_swap(__float_as_uint(v0[j]), __float_as_uint(v0[j]), false, false); const float oth0 = __uint_as_float(fq < 2 ? e0[1] : e0[0]);
                            auto e1 = __builtin_amdgcn_permlane32_swap(__float_as_uint(v1[j]), __float_as_uint(v1[j]), false, false); const float oth1 = __uint_as_float(fq < 2 ? e1[1] : e1[0]);
                            y0[j] = fq < 2 ? v0[j] * c0[j] - oth0 * s0[j] : oth0 * s0[j] + v0[j] * c0[j];
                            y1[j] = fq < 2 ? v1[j] * c1[j] - oth1 * s1[j] : oth1 * s1[j] + v1[j] * c1[j]; }
                        u32x4 kw; kw.x = pk2(y0[0], y0[1]); kw.y = pk2(y0[2], y0[3]); kw.z = pk2(y1[0], y1[1]); kw.w = pk2(y1[2], y1[3]);
                        *(u32x4*)(KR + (size_t)row * 32 + 8 * fq) = kw; } }
                asm volatile("" ::: "memory"); }
    }
};
struct EpiQRope {
    static constexpr bool PERM = false;
    bf16_t* O; int ldc; const float* part; const float* cs; const float* sn;
    template <class Sched>
    __device__ __forceinline__ void operator()(const f32x4 (&acc)[2][2][4][2], const Unit& u, const Sched&, int wr, int wc, int fr, int fq) const {
        const int row0 = u.pm * BM + wr * 64 + fr;
        float scs[2][4]; rms8_from_part(part, row0, 0, 3, 1.f / 384.f, scs);
#pragma unroll
        for (int ai = 0; ai < 2; ++ai) {
            f32x4 cc[4], ss[4];
#pragma unroll
            for (int m = 0; m < 4; ++m) { const int pos = (row0 + ai * HALF + m * 16) & (SEQ - 1); cc[m] = *(const f32x4*)(cs + pos * 16 + 4 * fq); ss[m] = *(const f32x4*)(sn + pos * 16 + 4 * fq); }
#pragma unroll
            for (int m = 0; m < 4; ++m) { const int row = row0 + ai * HALF + m * 16; const float sc = scs[ai][m];
                const f32x4 c4 = cc[m], s4 = ss[m];
#pragma unroll
                for (int bj = 0; bj < 2; ++bj) { const int colg = u.pn * BM + bj * HALF + wc * 32;
                    f32x4 x1 = acc[ai][bj][m][0] * sc, x2 = acc[ai][bj][m][1] * sc;
                    if (((colg >> 5) % 3) == 2) { const f32x4 y1 = x1 * c4 - x2 * s4, y2 = x1 * s4 + x2 * c4; x1 = y1; x2 = y2; }
                    bf16_t* p = O + (size_t)row * ldc + colg + 4 * fq;
                    u32x2 w1, w2; w1.x = pk2(x1[0], x1[1]); w1.y = pk2(x1[2], x1[3]); w2.x = pk2(x2[0], x2[1]); w2.y = pk2(x2[2], x2[3]);
                    *(u32x2*)p = w1; *(u32x2*)(p + 16) = w2; } }
            asm volatile("" ::: "memory"); }
    }
};
struct EpiMoe1 {
    static constexpr bool PERM = true;
    bf16_t* H; const float* gatew;
    template <class Sched>
    __device__ __forceinline__ void operator()(const f32x4 (&acc)[2][2][4][2], const Unit& u, const Sched& S, int wr, int wc, int fr, int fq) const {
        int pr[2][4]; float gws[2][4];
#pragma unroll
        for (int ai = 0; ai < 2; ++ai)
#pragma unroll
            for (int m = 0; m < 4; ++m) { const int r = ai * HALF + wr * 64 + m * 16 + fr; pr[ai][m] = S.elist[u.e * 16384 + u.pm * 256 + (r < u.nvalid ? r : 0)]; }
#pragma unroll
        for (int ai = 0; ai < 2; ++ai)
#pragma unroll
            for (int m = 0; m < 4; ++m) gws[ai][m] = gatew[pr[ai][m]];
#pragma unroll
        for (int ai = 0; ai < 2; ++ai)
#pragma unroll
            for (int m = 0; m < 4; ++m) { const int r = ai * HALF + wr * 64 + m * 16 + fr;
                if (r < u.nvalid) { const int pair = pr[ai][m]; const float gw = gws[ai][m];
#pragma unroll
                    for (int bj = 0; bj < 2; ++bj) { const f32x4 g = acc[ai][bj][m][0], up = acc[ai][bj][m][1]; f32x4 a;
#pragma unroll
                        for (int j = 0; j < 4; ++j) { const float sg = g[j] / (1.f + __expf(-g[j])); a[j] = sg * up[j] * gw; }
                        const int f = u.pn * 128 + bj * 64 + wc * 16 + fq * 4;
                        u32x2 w; w.x = pk2(a[0], a[1]); w.y = pk2(a[2], a[3]);
                        __hip_atomic_store((unsigned long long*)(H + (size_t)pair * DFF + f), (unsigned long long)w.x | ((unsigned long long)w.y << 32), __ATOMIC_RELAXED, __HIP_MEMORY_SCOPE_AGENT); } } }
    }
};
struct EpiMoe2 {
    static constexpr bool PERM = true;
    bf16_t* Y;
    template <class Sched>
    __device__ __forceinline__ void operator()(const f32x4 (&acc)[2][2][4][2], const Unit& u, const Sched& S, int wr, int wc, int fr, int fq) const {
        const int col0 = u.pn * BM + wc * 32 + 8 * fq;
        int pr[2][4];
#pragma unroll
        for (int ai = 0; ai < 2; ++ai)
#pragma unroll
            for (int m = 0; m < 4; ++m) { const int r = ai * HALF + wr * 64 + m * 16 + fr; pr[ai][m] = S.elist[u.e * 16384 + u.pm * 256 + (r < u.nvalid ? r : 0)]; }
#pragma unroll
        for (int ai = 0; ai < 2; ++ai)
#pragma unroll
            for (int m = 0; m < 4; ++m) { const int r = ai * HALF + wr * 64 + m * 16 + fr;
                if (r < u.nvalid) { bf16_t* rowp = Y + (size_t)pr[ai][m] * DM + col0;
#pragma unroll
                    for (int bj = 0; bj < 2; ++bj) { const f32x4 v0 = acc[ai][bj][m][0], v1 = acc[ai][bj][m][1];
                        u32x4 w; w.x = pk2(v0[0], v0[1]); w.y = pk2(v0[2], v0[3]); w.z = pk2(v1[0], v1[1]); w.w = pk2(v1[2], v1[3]);
                        store16_wt(rowp + bj * HALF, w); } } }
    }
};

struct Unit2 : Unit { int kind, mt; };
struct Moe12Sched {
    const bf16_t* X1B; const bf16_t* H; const bf16_t* WGU; const bf16_t* WD; const int* elist; const LAS int* tstart; const LAS int* ecnt; unsigned* ready; int G, v;
    __device__ __forceinline__ bool next(int i, Unit2& u) const {
        const int T4 = tstart[16] * 4; const int q1 = T4 / G, rem = T4 - q1 * G; const int g1 = q1 + (v < rem ? 1 : 0);
        int L, kind;
        if (i < g1) { L = v + i * G; kind = 0; }
        else { if (rem > 0 && v < rem) return false; const int nl = G - rem; const int p = (v - rem) + nl * (i - g1); if (p >= T4) return false; L = p; kind = 1; }
        const int mt = L >> 2; u.pn = L & 3; int e = 0;
#pragma unroll
        for (int k = 1; k < 16; ++k) if (mt >= tstart[k]) e = k;
        e = __builtin_amdgcn_readfirstlane(e);
        u.e = e; u.pm = __builtin_amdgcn_readfirstlane(mt - tstart[e]); u.mt = __builtin_amdgcn_readfirstlane(mt); u.kind = __builtin_amdgcn_readfirstlane(kind);
        int nv = ecnt[e] - u.pm * 256; nv = nv > 256 ? 256 : nv; u.nvalid = __builtin_amdgcn_readfirstlane(nv); return true;
    }
    __device__ __forceinline__ int kdim(const Unit2& u) const { return u.kind ? DFF : DM; }
    __device__ __forceinline__ bool perm(const Unit2&) const { return true; }
    __device__ __forceinline__ int epi(const Unit2& u) const { return u.kind; }
    __device__ __forceinline__ const char* a_base(const Unit2& u) const { return u.kind ? (const char*)H : (const char*)X1B; }
    __device__ __forceinline__ const char* b_base(const Unit2& u) const { return u.kind ? (const char*)WD + (size_t)u.e * (DM * DFF * 2) + (size_t)u.pn * (BM * DFF * 2) : (const char*)WGU + (size_t)u.e * (DM * DM * 2) + (size_t)u.pn * (BM * DM * 2); }
    __device__ __forceinline__ int row_id(const Unit& u, int r) const { const int rr = r < u.nvalid ? r : 0; return elist[u.e * 16384 + u.pm * 256 + rr]; }
    __device__ __forceinline__ unsigned a_off(const Unit2& u, int r) const { const int id = row_id(u, r); return u.kind ? (unsigned)id * (unsigned)(DFF * 2) : (unsigned)(id >> 1) * (unsigned)(DM * 2); }
    __device__ __forceinline__ void a_ready(const Unit2& u, int tid) const {
        if (u.kind) {
            if (tid < 64) { unsigned sp = 0;
                while ((unsigned)__builtin_amdgcn_readfirstlane(__hip_atomic_load(ready + u.mt, __ATOMIC_RELAXED, __HIP_MEMORY_SCOPE_AGENT)) < 32u) { __builtin_amdgcn_s_sleep(2); if (++sp > (1u << 22)) break; }
                __builtin_amdgcn_fence(__ATOMIC_ACQUIRE, "agent");
                asm volatile("s_waitcnt vmcnt(0)" ::: "memory"); }
            asm volatile("" ::: "memory"); __builtin_amdgcn_s_barrier(); asm volatile("" ::: "memory");
        }
    }
    __device__ __forceinline__ void done(const Unit2& u, int lane) const {
        if (!u.kind) { asm volatile("s_waitcnt vmcnt(0)" ::: "memory"); if (lane == 0) __hip_atomic_fetch_add(ready + u.mt, 1u, __ATOMIC_RELAXED, __HIP_MEMORY_SCOPE_AGENT); }
    }
};


struct ProjSched {
    const bf16_t* XB; const bf16_t* PROJ; const bf16_t* WIN; const bf16_t* WQUP; const bf16_t* WKV; unsigned* c01; unsigned* c12; int G, v;
    __device__ __forceinline__ bool next(int i, Unit2& u) const {
        const int g0 = v < 192 ? 2 : 1; int kind, pm, pn;
        if (i < g0) { const int L = v + i * G; kind = 0; pm = L & 63; pn = L >> 6; }
        else { const int j = i - g0;
            if (v < 192) { if (j >= 1) return false; kind = 2; pm = v >> 2; pn = v & 3; }
            else { const int w = v - 192; if (j < 3) { kind = 1; pm = w; pn = j; } else if (j == 3) { kind = 2; pm = 48 + (w >> 2); pn = w & 3; } else return false; } }
        u.kind = __builtin_amdgcn_readfirstlane(kind); u.pm = __builtin_amdgcn_readfirstlane(pm); u.pn = __builtin_amdgcn_readfirstlane(pn); u.e = 0; u.nvalid = 256; u.mt = u.pm; return true;
    }
    __device__ __forceinline__ int kdim(const Unit2& u) const { return u.kind == 0 ? DM : (u.kind == 1 ? 384 : 256); }
    __device__ __forceinline__ bool perm(const Unit2& u) const { return u.kind != 1; }
    __device__ __forceinline__ int epi(const Unit2& u) const { return u.kind; }
    __device__ __forceinline__ const char* a_base(const Unit2& u) const {
        return u.kind == 0 ? (const char*)XB + (size_t)u.pm * (BM * DM * 2) : (const char*)PROJ + (size_t)u.pm * (BM * NPROJ * 2) + (u.kind == 1 ? C_QA * 2 : C_KVA * 2); }
    __device__ __forceinline__ const char* b_base(const Unit2& u) const {
        return u.kind == 0 ? (const char*)WIN + (size_t)u.pn * (BM * DM * 2) : (u.kind == 1 ? (const char*)WQUP + (size_t)u.pn * (BM * 384 * 2) : (const char*)WKV + (size_t)u.pn * (BM * 256 * 2)); }
    __device__ __forceinline__ unsigned a_off(const Unit2& u, int r) const { return (unsigned)r * (u.kind == 0 ? (unsigned)(DM * 2) : (unsigned)(NPROJ * 2)); }
    __device__ __forceinline__ void a_ready(const Unit2& u, int tid) const {
        if (u.kind) {
            if (tid < 64) { unsigned* c = (u.kind == 1 ? c01 : c12) + u.pm; unsigned sp = 0;
                while ((unsigned)__builtin_amdgcn_readfirstlane(__hip_atomic_load(c, __ATOMIC_RELAXED, __HIP_MEMORY_SCOPE_AGENT)) < 16u) { __builtin_amdgcn_s_sleep(2); if (++sp > (1u << 22)) break; }
                __builtin_amdgcn_fence(__ATOMIC_ACQUIRE, "agent");
                asm volatile("s_waitcnt vmcnt(0)" ::: "memory"); }
            asm volatile("" ::: "memory"); __builtin_amdgcn_s_barrier(); asm volatile("" ::: "memory");
        }
    }
    __device__ __forceinline__ void done(const Unit2& u, int lane) const {
        if (u.kind == 0 && u.pn <= 2) { asm volatile("s_waitcnt vmcnt(0)" ::: "memory");
            if (lane == 0) { if (u.pn <= 1) __hip_atomic_fetch_add(c01 + u.pm, 1u, __ATOMIC_RELAXED, __HIP_MEMORY_SCOPE_AGENT); if (u.pn >= 1) __hip_atomic_fetch_add(c12 + u.pm, 1u, __ATOMIC_RELAXED, __HIP_MEMORY_SCOPE_AGENT); } }
    }
};

template <class SchedT, class E0T, class E1T, class E2T>
__device__ __forceinline__ void gemm_stream(LAS unsigned char* lds, const SchedT& S, const E0T& E0, const E1T& E1, const E2T& E2, const int tid) {
    const int wid = __builtin_amdgcn_readfirstlane(tid >> 6), lane = tid & 63, wr = wid >> 2, wc = wid & 3, fr = lane & 15, fq = lane >> 4;
#define PG8_GEOM() int RA[2], CA[2], RB[2]; { int tq_ = tid; asm volatile("" : "+v"(tq_)); _Pragma("unroll") for (int i = 0; i < 2; ++i) { int R, C; stage_rc(tq_ * 16 + i * 8192, R, C); RA[i] = R; CA[i] = C; RB[i] = (R & ~31) + perm32(R & 31); } }
    const size_t kstep = (size_t)(BK * 2);
    const unsigned ldsw = (unsigned)wid * 1024u;
    const int aoff = lds_byte(wr * 64 + fr, fq * 8), boff = lds_byte(wc * 32 + fr, fq * 8);
#define PG8_SA(b, h) (((b) * 2 + (h)) * HTB)
#define PG8_SB(b, h) ((4 + (b) * 2 + (h)) * HTB)
#define PG8_STAGE2(bufoff, gbase, v0, v1) do { \
        __builtin_amdgcn_global_load_lds((const unsigned*)((const char*)(gbase) + (v0)), (LAS unsigned*)(lds + (bufoff) + ldsw), 16, 0, 0); \
        __builtin_amdgcn_global_load_lds((const unsigned*)((const char*)(gbase) + (v1)), (LAS unsigned*)(lds + (bufoff) + ldsw + 8192), 16, 0, 0); } while (0)
#define PG8_LDA(dst, b, h) do { _Pragma("unroll") for (int m = 0; m < 4; ++m) _Pragma("unroll") for (int k = 0; k < 2; ++k) dst[m][k] = *(const LAS bf16x8*)(lds + PG8_SA(b, h) + aoff + m * 2048 + k * 1024); } while (0)
#define PG8_LDB(dst, b, h) do { _Pragma("unroll") for (int n = 0; n < 2; ++n) _Pragma("unroll") for (int k = 0; k < 2; ++k) dst[n][k] = *(const LAS bf16x8*)(lds + PG8_SB(b, h) + boff + n * 2048 + k * 1024); } while (0)
#define PG8_MMA(ai, bj, At, Bt) do { __builtin_amdgcn_s_setprio(1); _Pragma("unroll") for (int m = 0; m < 4; ++m) _Pragma("unroll") for (int n = 0; n < 2; ++n) _Pragma("unroll") for (int k = 0; k < 2; ++k) \
        acc[ai][bj][m][n] = __builtin_amdgcn_mfma_f32_16x16x32_bf16(Bt[n][k], At[m][k], acc[ai][bj][m][n], 0, 0, 0); __builtin_amdgcn_s_setprio(0); } while (0)
#define PG8_WAIT_V(n) asm volatile("s_waitcnt vmcnt(" #n ")" ::: "memory")
#define PG8_WAIT_L(n) asm volatile("s_waitcnt lgkmcnt(" #n ")" ::: "memory")
#define PG8_BAR __builtin_amdgcn_s_barrier()
#define PG8_SCHED __builtin_amdgcn_sched_barrier(0)
    Unit2 cur, nxt; int ui = 0;
    if (!S.next(0, cur)) return;
    f32x4 acc[2][2][4][2];
#pragma unroll
    for (int a = 0; a < 2; ++a)
#pragma unroll
        for (int b = 0; b < 2; ++b)
#pragma unroll
            for (int m = 0; m < 4; ++m)
#pragma unroll
                for (int n = 0; n < 2; ++n) acc[a][b][m][n] = (f32x4){0.f, 0.f, 0.f, 0.f};
    bf16x8 At[4][2], B0[2][2], B1[2][2];
    const char* cA = S.a_base(cur); const char* cB = S.b_base(cur);
    int Kc = S.kdim(cur); int ntc = Kc / BK; size_t hbc = (size_t)HALF * Kc * 2;
    unsigned bc0, bc1, bn0, bn1, vc00, vc01, vc10, vc11, vn00, vn01, vn10, vn11;
    { PG8_GEOM();
      bc0 = (unsigned)((S.perm(cur) ? RB[0] : RA[0]) * Kc + CA[0]) * 2u; bc1 = (unsigned)((S.perm(cur) ? RB[1] : RA[1]) * Kc + CA[1]) * 2u;
      vc00 = S.a_off(cur, RA[0]) + CA[0] * 2; vc01 = S.a_off(cur, RA[1]) + CA[1] * 2; vc10 = S.a_off(cur, HALF + RA[0]) + CA[0] * 2; vc11 = S.a_off(cur, HALF + RA[1]) + CA[1] * 2; }
    S.a_ready(cur, tid);
    PG8_STAGE2(PG8_SB(0, 0), cB, bc0, bc1); PG8_STAGE2(PG8_SB(0, 1), cB + hbc, bc0, bc1); PG8_STAGE2(PG8_SA(0, 0), cA, vc00, vc01); PG8_STAGE2(PG8_SA(0, 1), cA, vc10, vc11);
    if (wr == 1) PG8_BAR;
    PG8_WAIT_V(2); PG8_BAR;
    PG8_STAGE2(PG8_SB(1, 0), cB + kstep, bc0, bc1); PG8_STAGE2(PG8_SA(1, 0), cA + kstep, vc00, vc01); PG8_STAGE2(PG8_SB(1, 1), cB + hbc + kstep, bc0, bc1);
    PG8_WAIT_V(6); PG8_BAR;
    for (;;) {
        const bool has_next = S.next(ui + 1, nxt);
        const char* nA = cA; const char* nB = cB; int Kn = Kc; size_t hbn = hbc;
        bn0 = bc0; bn1 = bc1; vn00 = vc00; vn01 = vc01; vn10 = vc10; vn11 = vc11;
        if (has_next) { nA = S.a_base(nxt); nB = S.b_base(nxt); Kn = S.kdim(nxt); hbn = (size_t)HALF * Kn * 2; PG8_GEOM();
            bn0 = (unsigned)((S.perm(nxt) ? RB[0] : RA[0]) * Kn + CA[0]) * 2u; bn1 = (unsigned)((S.perm(nxt) ? RB[1] : RA[1]) * Kn + CA[1]) * 2u;
            vn00 = S.a_off(nxt, RA[0]) + CA[0] * 2; vn01 = S.a_off(nxt, RA[1]) + CA[1] * 2; vn10 = S.a_off(nxt, HALF + RA[0]) + CA[0] * 2; vn11 = S.a_off(nxt, HALF + RA[1]) + CA[1] * 2; }
        for (int t = 0; t < ntc; t += 2) {
            const bool last = (t == ntc - 2);
            if (last && has_next) S.a_ready(nxt, tid);
            const char* a1 = cA + (size_t)(t + 1) * kstep;
            const char* a2 = last ? nA : cA + (size_t)(t + 2) * kstep; const char* b2 = last ? nB : cB + (size_t)(t + 2) * kstep;
            const char* a3 = a2 + kstep; const char* b3 = b2 + kstep;
            unsigned w00 = vc00, w01 = vc01, w10 = vc10, w11 = vc11, x0 = bc0, x1 = bc1; size_t hb = hbc;
            if (last) { w00 = vn00; w01 = vn01; w10 = vn10; w11 = vn11; x0 = bn0; x1 = bn1; hb = hbn; }
            PG8_LDB(B0, 0, 0); PG8_LDB(B1, 0, 1); PG8_SCHED; PG8_LDA(At, 0, 0); PG8_STAGE2(PG8_SA(1, 1), a1, vc10, vc11);
            PG8_WAIT_V(8); PG8_WAIT_L(0); PG8_BAR; PG8_MMA(0, 0, At, B0); PG8_MMA(0, 1, At, B1); PG8_BAR; PG8_SCHED;
            PG8_LDA(At, 0, 1); PG8_STAGE2(PG8_SB(0, 0), b2, x0, x1); PG8_STAGE2(PG8_SB(0, 1), b2 + hb, x0, x1); PG8_STAGE2(PG8_SA(0, 0), a2, w00, w01);
            PG8_WAIT_V(8); PG8_WAIT_L(0); PG8_BAR; PG8_MMA(1, 0, At, B0); PG8_MMA(1, 1, At, B1); PG8_BAR; PG8_SCHED;
            PG8_LDB(B0, 1, 0); PG8_LDB(B1, 1, 1); PG8_SCHED; PG8_LDA(At, 1, 0); PG8_STAGE2(PG8_SA(0, 1), a2, w10, w11);
            PG8_WAIT_V(8); PG8_WAIT_L(0); PG8_BAR; PG8_MMA(0, 0, At, B0); PG8_MMA(0, 1, At, B1); PG8_BAR; PG8_SCHED;
            PG8_LDA(At, 1, 1); PG8_STAGE2(PG8_SB(1, 0), b3, x0, x1); PG8_STAGE2(PG8_SB(1, 1), b3 + hb, x0, x1); PG8_STAGE2(PG8_SA(1, 0), a3, w00, w01);
            PG8_WAIT_V(8); PG8_WAIT_L(0); PG8_BAR; PG8_MMA(1, 0, At, B0); PG8_MMA(1, 1, At, B1); PG8_BAR; PG8_SCHED;
        }
        if (wr == 0) PG8_BAR;
        { int ln_; asm volatile("v_mbcnt_lo_u32_b32 %0, -1, 0\n\tv_mbcnt_hi_u32_b32 %0, -1, %0" : "=v"(ln_));
          const int ek = S.epi(cur);
          if (ek == 0) E0(acc, cur, S, wr, wc, ln_ & 15, ln_ >> 4); else if (ek == 1) E1(acc, cur, S, wr, wc, ln_ & 15, ln_ >> 4); else E2(acc, cur, S, wr, wc, ln_ & 15, ln_ >> 4);
          S.done(cur, ln_); }
        if (!has_next) break;
#pragma unroll
        for (int a = 0; a < 2; ++a)
#pragma unroll
            for (int b = 0; b < 2; ++b)
#pragma unroll
                for (int m = 0; m < 4; ++m)
#pragma unroll
                    for (int n = 0; n < 2; ++n) acc[a][b][m][n] = (f32x4){0.f, 0.f, 0.f, 0.f};
        cur = nxt; cA = nA; cB = nB; ++ui; vc00 = vn00; vc01 = vn01; vc10 = vn10; vc11 = vn11; bc0 = bn0; bc1 = bn1; Kc = Kn; ntc = Kc / BK; hbc = hbn;
        if (wr == 1) PG8_BAR;
    }
    PG8_WAIT_V(0);
    PG8_BAR;
#undef PG8_GEOM
#undef PG8_SA
#undef PG8_SB
#undef PG8_STAGE2
#undef PG8_LDA
#undef PG8_LDB
#undef PG8_MMA
#undef PG8_WAIT_V
#undef PG8_WAIT_L
#undef PG8_BAR
#undef PG8_SCHED
}
}


struct Args {
    const float* x; const float* w_in; const float* q_norm_g; const float* w_q_up; const float* kv_norm_g; const float* w_uk; const float* w_uv; const float* w_o;
    const float* ln1_g; const float* ln1_b; const float* router_w; const float* router_bias; const float* w_gate; const float* w_up; const float* w_down;
    const float* ln2_g; const float* ln2_b;
    float* out; unsigned char* ws; int ph_lo, ph_hi, dup_mask, pad;
};

__device__ __forceinline__ void conv_item(const float* srcp, int ldw, float cs, const float* kscale, bf16_t* dst, int Kdst, LAS float* scr, int lane) {
    const int kr = lane >> 4, j = lane & 15;
    f32x4 v[8];
#pragma unroll
    for (int i = 0; i < 8; ++i) v[i] = srcp ? *(const f32x4*)(srcp + (size_t)(kr + 4 * i) * ldw) : (f32x4){0.f, 0.f, 0.f, 0.f};
#pragma unroll
    for (int i = 0; i < 8; ++i) { const int k = kr + 4 * i; const float ks = kscale ? kscale[k] * cs : cs; LAS float* p = scr + k * 65 + 4 * j;
        p[0] = v[i][0] * ks; p[1] = v[i][1] * ks; p[2] = v[i][2] * ks; p[3] = v[i][3] * ks; }
    asm volatile("s_waitcnt lgkmcnt(0)" ::: "memory");
    const int kc = lane & 3;
#pragma unroll
    for (int q = 0; q < 4; ++q) { const int n = (lane >> 2) + 16 * q; const LAS float* sp = scr + (8 * kc) * 65 + n;
        u32x4 o; o.x = pk2(sp[0 * 65], sp[1 * 65]); o.y = pk2(sp[2 * 65], sp[3 * 65]); o.z = pk2(sp[4 * 65], sp[5 * 65]); o.w = pk2(sp[6 * 65], sp[7 * 65]);
        *(u32x4*)(dst + (size_t)n * Kdst + 8 * kc) = o; }
    asm volatile("s_waitcnt lgkmcnt(0)" ::: "memory");
}

__device__ __forceinline__ void p0_small_weights(const Args& a, LAS float* scr, int gw, int NGW, int lane) {
    unsigned char* ws = a.ws;
    constexpr int I_IN = 28 * 32, I_QUP = 12 * 12, I_KV = 16 * 8, I_O = 16 * 32, I_L = I_IN + I_QUP + I_KV + I_O;
    const int j4 = (lane & 15) * 4;
    for (int it = gw; it < DEPTH * I_L; it += NGW) {
        const int l = it / I_L; int r = it % I_L;
        if (r < I_IN) { const int kb = r / 28, nb = r % 28, n = nb * 64 + j4, k0 = kb * 32;
            const float* sp = n < IN_COLS ? a.w_in + (size_t)l * DM * IN_COLS + (size_t)k0 * IN_COLS + n : nullptr;
            const float cs = (n >= C_DQ && n < C_DK) ? DSA_QSCALE : 1.f;
            conv_item(sp, IN_COLS, cs, nullptr, (bf16_t*)(ws + WS_WIN) + (size_t)l * NPROJ * DM + (size_t)(nb * 64) * DM + k0, DM, scr, lane); continue; }
        r -= I_IN;
        if (r < I_QUP) { const int kb = r / 12, nb = r % 12, n = nb * 64 + j4, k0 = kb * 32;
            conv_item(a.w_q_up + (size_t)l * 384 * 768 + (size_t)k0 * 768 + n, 768, MLA_QSCALE, a.q_norm_g + l * 384 + k0, (bf16_t*)(ws + WS_WQUP) + (size_t)l * 768 * 384 + (size_t)(nb * 64) * 384 + k0, 384, scr, lane); continue; }
        r -= I_QUP;
        if (r < I_KV) { const int kb = r / 16, nb = r % 16, n = nb * 64 + j4, k0 = kb * 32;
            const float* sp = n < 512 ? a.w_uk + (size_t)l * 256 * 512 + (size_t)k0 * 512 + n : a.w_uv + (size_t)l * 256 * 512 + (size_t)k0 * 512 + (n - 512);
            conv_item(sp, 512, 1.f, a.kv_norm_g + l * 256 + k0, (bf16_t*)(ws + WS_WKV) + (size_t)l * 1024 * 256 + (size_t)(nb * 64) * 256 + k0, 256, scr, lane); continue; }
        r -= I_KV;
        { const int kb = r / 16, nb = r % 16, n = nb * 64 + j4, k0 = kb * 32;
            conv_item(a.w_o + (size_t)l * DM * DM + (size_t)k0 * DM + n, DM, 1.f, nullptr, (bf16_t*)(ws + WS_WO) + (size_t)l * DM * DM + (size_t)(nb * 64) * DM + k0, DM, scr, lane); }
    }
}
__device__ __forceinline__ void p0_expert_weights(const Args& a, int l, LAS float* scr, int gw, int NGW, int lane) {
    unsigned char* ws = a.ws;
    constexpr int I_GU = 16 * 32 * 16, I_D = 16 * 16 * 16;
    const int j4 = (lane & 15) * 4;
    for (int it = gw; it < I_GU + I_D; it += NGW) {
        int r = it;
        if (r < I_GU) { const int e = r / 512, rr = r % 512, kb = rr / 16, nb = rr % 16, c0 = nb * 64 + j4, k0 = kb * 32;
            const int f = 4 * (c0 >> 3); const float* W = (c0 & 4) ? a.w_up : a.w_gate;
            conv_item(W + ((size_t)(l * NEXP + e) * DM + k0) * DFF + f, DFF, 1.f, nullptr, (bf16_t*)(ws + WS_WGU) + (size_t)e * DM * DM + (size_t)(nb * 64) * DM + k0, DM, scr, lane); continue; }
        r -= I_GU;
        { const int e = r / 256, rr = r % 256, kb = rr / 16, nb = rr % 16, n = nb * 64 + j4, k0 = kb * 32;
            conv_item(a.w_down + ((size_t)(l * NEXP + e) * DFF + k0) * DM + n, DM, 1.f, nullptr, (bf16_t*)(ws + WS_WD) + (size_t)e * DM * DFF + (size_t)(nb * 64) * DFF + k0, DFF, scr, lane); }
    }
}
__device__ __forceinline__ void p0_misc(const Args& a, int gw, int NGW, int lane) {
    unsigned char* ws = a.ws;
    for (int m = gw; m < M; m += NGW) { const f32x4* xr = (const f32x4*)(a.x + (size_t)m * DM) + lane; u32x2* o = (u32x2*)((bf16_t*)(ws + WS_XB) + (size_t)m * DM) + lane;
#pragma unroll
        for (int j = 0; j < 4; ++j) { const f32x4 v = xr[64 * j]; u32x2 w; w.x = pk2(v[0], v[1]); w.y = pk2(v[2], v[3]); o[64 * j] = w; } }
    float* cs = (float*)(ws + WS_ROPE); float* sn = cs + SEQ * 16;
    for (int i = gw * 64 + lane; i < SEQ * 16; i += NGW * 64) { const int pos = i >> 4, k = i & 15; const float inv = powf(10000.0f, -(float)k / 16.0f); const float ang = (float)pos * inv; cs[i] = cosf(ang); sn[i] = sinf(ang); }
    if (gw == 0) for (int i = lane; i < 1024; i += 64) ((int*)(ws + WS_CTL))[i] = 0;
}

__device__ __forceinline__ void p1b_token_stats(const Args& a, int gw, int NGW, int lane) {
    unsigned char* ws = a.ws; const bf16_t* PROJ = (const bf16_t*)(ws + WS_PROJ); float* RS = (float*)(ws + WS_RS); bf16_t* KR = (bf16_t*)(ws + WS_KR);
    const float* cs = (const float*)(ws + WS_ROPE); const float* sn = cs + SEQ * 16;
    for (int m = gw; m < M; m += NGW) {
        const bf16_t* row = PROJ + (size_t)m * NPROJ;
        float sq = 0.f, sk = 0.f;
        if (lane < 48) { const u32x4 w = *(const u32x4*)(row + C_QA + lane * 8);
#pragma unroll
            for (int j = 0; j < 4; ++j) { const float lo = bf_lo(w[j]), hi = bf_hi(w[j]); sq += lo * lo + hi * hi; } }
        if (lane < 32) { const u32x4 w = *(const u32x4*)(row + C_KVA + lane * 8);
#pragma unroll
            for (int j = 0; j < 4; ++j) { const float lo = bf_lo(w[j]), hi = bf_hi(w[j]); sk += lo * lo + hi * hi; } }
        sq = wave_sum(sq); sk = wave_sum(sk);
        if (lane == 0) { RS[(size_t)m * 2] = 1.0f / sqrtf(sq * (1.f / 384.f) + RMS_EPS); RS[(size_t)m * 2 + 1] = 1.0f / sqrtf(sk * (1.f / 256.f) + RMS_EPS); }
        if (lane < 16) { const int pos = m & (SEQ - 1); const float x1 = bf2f(row[C_KR + lane]), x2 = bf2f(row[C_KR + 16 + lane]); const float c = cs[pos * 16 + lane], s = sn[pos * 16 + lane];
            const unsigned y1 = pk2(x1 * c - x2 * s, 0.f) & 0xffffu, y2 = pk2(x1 * s + x2 * c, 0.f) & 0xffffu;
            KR[(size_t)m * 32 + lane] = (bf16_t)y1; KR[(size_t)m * 32 + 16 + lane] = (bf16_t)y2; }
    }
}

__device__ __forceinline__ float max3f(float a, float b, float c) { float r; asm("v_max3_f32 %0, %1, %2, %3" : "=v"(r) : "v"(a), "v"(b), "v"(c)); return r; }
__device__ __forceinline__ int crow(int r, int hi) { return (r & 3) + 8 * (r >> 2) + 4 * hi; }
__device__ __forceinline__ s16x4 vtr(const LAS unsigned char* p) { typedef short v4i16_t __attribute__((ext_vector_type(4))); return __builtin_bit_cast(s16x4, __builtin_amdgcn_ds_read_tr16_b64_v4i16((LAS v4i16_t*)p)); }

template <bool DSA>
__device__ __forceinline__ void attn_qk(LAS unsigned char* lds, const int bo, const int t, const bf16x8 (&qf)[DSA ? 4 : 6], f32x16& p0, f32x16& p1,
                                        const int q0, const int lane, const float sl2, const float (&slc)[16], const LAS unsigned char* mrow) {
    constexpr int DQK = DSA ? 64 : 96;
    const int r32 = lane & 31, hi = lane >> 5;
    if (DSA) { const float b0 = -sl2 * (float)(q0 + r32 - 64 * t - 4 * hi);
#pragma unroll
        for (int r = 0; r < 16; ++r) { p0[r] = b0 + slc[r]; p1[r] = p0[r] + 32.f * sl2; } }
    else { p0 = f32x16{}; p1 = f32x16{}; }
    constexpr int KP = DQK * 2 + 16;
    const LAS unsigned char* kb = lds + bo + r32 * KP + hi * 16;
    bf16x8 kf0[DQK / 16], kf1[DQK / 16];
#pragma unroll
    for (int d0 = 0; d0 < DQK / 16; ++d0) { kf0[d0] = *(const LAS bf16x8*)(kb + d0 * 32); kf1[d0] = *(const LAS bf16x8*)(kb + d0 * 32 + 32 * KP); }
    __builtin_amdgcn_s_setprio(1);
#pragma unroll
    for (int d0 = 0; d0 < DQK / 16; ++d0) { p0 = __builtin_amdgcn_mfma_f32_32x32x16_bf16(kf0[d0], qf[d0], p0, 0, 0, 0); p1 = __builtin_amdgcn_mfma_f32_32x32x16_bf16(kf1[d0], qf[d0], p1, 0, 0, 0); }
    __builtin_amdgcn_s_setprio(0);
    if (DSA) { const u32x2 mw = *(const LAS u32x2*)(mrow + 8 * t); const unsigned w0 = mw.x >> (4 * hi), w1 = mw.y >> (4 * hi);
#pragma unroll
        for (int r = 0; r < 16; ++r) { const unsigned bit = 1u << ((r & 3) + 8 * (r >> 2)); if (!(w0 & bit)) p0[r] = -INFINITY; if (!(w1 & bit)) p1[r] = -INFINITY; } }
    else if (64 * t + 63 > q0) { const int qa = q0 + r32, kbase = 64 * t + 4 * hi;
#pragma unroll
        for (int r = 0; r < 16; ++r) { const int kv = kbase + (r & 3) + 8 * (r >> 2); if (kv > qa) p0[r] = -INFINITY; if (kv + 32 > qa) p1[r] = -INFINITY; } }
}
template <bool DSA>
__device__ __forceinline__ void attn_sm_pv(LAS unsigned char* lds, const int bo, f32x16& p0, f32x16& p1, f32x16 (&o)[2], float& mrun, float& lrun, const int lane, LAS float* wsf) {
    constexpr int DQK = DSA ? 64 : 96, KBYTES = 64 * (DQK * 2 + 16);
    const int r32 = lane & 31, hi = lane >> 5;
    float mx = max3f(p0[0], p1[0], p0[1]), mx2 = max3f(p1[1], p0[2], p1[2]);
#pragma unroll
    for (int r = 3; r < 15; r += 2) { mx = max3f(mx, p0[r], p1[r]); mx2 = max3f(mx2, p0[r + 1], p1[r + 1]); }
    mx = max3f(mx, mx2, fmaxf(p0[15], p1[15]));
    { auto rr = __builtin_amdgcn_permlane32_swap(__float_as_uint(mx), __float_as_uint(mx), false, false); mx = fmaxf(__uint_as_float(rr[0]), __uint_as_float(rr[1])); }
    const float mnew = fmaxf(mrun, mx); const float alpha = fast_exp2(mrun - mnew); mrun = mnew;
    float sum = 0.f;
#pragma unroll
    for (int r = 0; r < 16; ++r) { p0[r] = fast_exp2(p0[r] - mnew); p1[r] = fast_exp2(p1[r] - mnew); sum += p0[r] + p1[r]; }
    lrun = lrun * alpha + sum;
    if (__any(alpha != 1.f)) {
        if (hi == 0) wsf[r32] = alpha;
        asm volatile("s_waitcnt lgkmcnt(0)" ::: "memory");
#pragma unroll
        for (int g = 0; g < 4; ++g) { const f32x4 av = *(const LAS f32x4*)(wsf + 8 * g + 4 * hi);
#pragma unroll
            for (int j = 0; j < 4; ++j) { o[0][4 * g + j] *= av[j]; o[1][4 * g + j] *= av[j]; } }
        asm volatile("s_waitcnt lgkmcnt(0)" ::: "memory");
    }
    bf16x8 pf[4];
#pragma unroll
    for (int s = 0; s < 4; ++s) { u32x4 w;
        if (s < 2) { w.x = pk2(p0[8 * s + 0], p0[8 * s + 1]); w.y = pk2(p0[8 * s + 2], p0[8 * s + 3]); w.z = pk2(p0[8 * s + 4], p0[8 * s + 5]); w.w = pk2(p0[8 * s + 6], p0[8 * s + 7]); }
        else { const int s2 = s - 2; w.x = pk2(p1[8 * s2 + 0], p1[8 * s2 + 1]); w.y = pk2(p1[8 * s2 + 2], p1[8 * s2 + 3]); w.z = pk2(p1[8 * s2 + 4], p1[8 * s2 + 5]); w.w = pk2(p1[8 * s2 + 6], p1[8 * s2 + 7]); }
        pf[s] = __builtin_bit_cast(bf16x8, w); }
    const LAS unsigned char* vb = lds + bo + KBYTES + ((lane >> 4) & 1) * 32 + (lane & 3) * 8 + (4 * hi + ((lane & 15) >> 2)) * 64;
    __builtin_amdgcn_s_setprio(1);
#pragma unroll
    for (int d0 = 0; d0 < 2; ++d0)
#pragma unroll
        for (int ks = 0; ks < 4; ++ks) { const s16x4 lo = vtr(vb + d0 * 4096 + ks * 1024), hh = vtr(vb + d0 * 4096 + ks * 1024 + 512);
            const bf16x8 vf = (bf16x8){lo[0], lo[1], lo[2], lo[3], hh[0], hh[1], hh[2], hh[3]};
            o[d0] = __builtin_amdgcn_mfma_f32_32x32x16_bf16(pf[ks], vf, o[d0], 0, 0, 0); }
    __builtin_amdgcn_s_setprio(0);
}

template <bool DSA>
__device__ __forceinline__ void attn_unit(LAS unsigned char* lds, const Args& a, int b, int hq  , int qblk  , int tid) {
    asm volatile("" : "+v"(tid));
    constexpr int DQK = DSA ? 64 : 96, KP = DQK * 2 + 16, KBYTES = 64 * KP, BUFB = KBYTES + 8192;
    constexpr int WS_OFF = 3 * BUFB;
    unsigned char* ws = a.ws;
    const int lane = tid & 63, r32 = lane & 31, hi = lane >> 5; const int wid = __builtin_amdgcn_readfirstlane(tid >> 6);
    const size_t rowbase = (size_t)b * SEQ;
    const int q0 = DSA ? qblk * 32 : qblk * 256 + wid * 32;
    const int qlast_unit = DSA ? qblk * 32 + 31 : qblk * 256 + 255;
    const int NT = qlast_unit / 64 + 1;
    const int h = DSA ? wid : hq;
    const bf16_t* PROJ = (const bf16_t*)(ws + WS_PROJ); const bf16_t* KVU = (const bf16_t*)(ws + WS_KVU); const bf16_t* KR = (const bf16_t*)(ws + WS_KR); const bf16_t* Qb = (const bf16_t*)(ws + WS_Q);
    const int krow = tid >> 3, kch = tid & 7, krowB = (tid >> 2) & 63, kchB = tid & 3;
    const bf16_t* ksrcA; const bf16_t* ksrcB; const bf16_t* vsrc; size_t kstrideA, kstrideB, vstride;
    if (DSA) { ksrcA = PROJ + (rowbase + krow) * NPROJ + C_DK + kch * 8; kstrideA = (size_t)64 * NPROJ; ksrcB = ksrcA; kstrideB = 0;
               vsrc = PROJ + (rowbase + 16 * (wid & 3) + (lane >> 2)) * NPROJ + C_DV + (wid >> 2) * 32 + (lane & 3) * 8; vstride = (size_t)64 * NPROJ; }
    else { ksrcA = KVU + (rowbase + krow) * 1024 + h * 64 + kch * 8; kstrideA = (size_t)64 * 1024;
           ksrcB = KR + (rowbase + krowB) * 32 + kchB * 8; kstrideB = (size_t)64 * 32;
           vsrc = KVU + (rowbase + 16 * (wid & 3) + (lane >> 2)) * 1024 + 512 + h * 64 + (wid >> 2) * 32 + (lane & 3) * 8; vstride = (size_t)64 * 1024; }
    const bool hasB = (!DSA) && (tid < 256);
    const int kdstA = krow * KP + kch * 16, kdstB = krowB * KP + 128 + kchB * 16, vdst = KBYTES + wid * 1024 + lane * 16;
    bf16x8 qf[DQK / 16];
    { const bf16_t* qp = DSA ? PROJ + (rowbase + q0 + r32) * NPROJ + C_DQ + h * 64 + 8 * hi : Qb + (rowbase + q0 + r32) * 768 + h * 96 + 8 * hi;
#pragma unroll
      for (int d0 = 0; d0 < DQK / 16; ++d0) qf[d0] = *(const bf16x8*)(qp + d0 * 16); }
    constexpr int MOFF = WS_OFF + 2048, MPITCH = 264;
    if (DSA) { const u32x4 mv = *(const u32x4*)((const unsigned*)(ws + WS_MASK) + (rowbase + q0 + (tid >> 4)) * 64 + (tid & 15) * 4);
        LAS unsigned char* md = lds + MOFF + (tid >> 4) * MPITCH + (tid & 15) * 16; *(LAS u32x2*)md = (u32x2){mv.x, mv.y}; *(LAS u32x2*)(md + 8) = (u32x2){mv.z, mv.w}; }
    const LAS unsigned char* mrow = lds + MOFF + r32 * MPITCH;
    const float sl2 = DSA ? exp2f(-(float)(h + 1)) * LOG2E : 0.f;
    float slc[16];
#pragma unroll
    for (int r = 0; r < 16; ++r) slc[r] = sl2 * (float)((r & 3) + 8 * (r >> 2));
    LAS float* wsf = (LAS float*)(lds + WS_OFF) + wid * 64;
    float mrun = -1e30f, lrun = 0.f; f32x16 o[2]; o[0] = f32x16{}; o[1] = f32x16{};
#define AT_LOAD(KA, KB, VV, tt) do { const int tc_ = (tt) < NT ? (tt) : NT - 1; KA = *(const u32x4*)(ksrcA + (size_t)tc_ * kstrideA); if (!DSA) KB = *(const u32x4*)(ksrcB + (size_t)tc_ * kstrideB); \
        VV = *(const u32x4*)(vsrc + (size_t)tc_ * vstride); } while (0)
#define AT_WRITE(KA, KB, VV, bn) do { *(LAS u32x4*)(lds + (bn) + kdstA) = KA; if (hasB) *(LAS u32x4*)(lds + (bn) + kdstB) = KB; *(LAS u32x4*)(lds + (bn) + vdst) = VV; } while (0)
#define AT_ACTIVE(tt) (64 * (tt) <= q0 + 31)
#define AT_ROT() do { const int t_ = bc; bc = bn; bn = bw; bw = t_; } while (0)
    u32x4 kA0, kB0 = (u32x4){0, 0, 0, 0}, vv0, kA1, kB1 = (u32x4){0, 0, 0, 0}, vv1;
    AT_LOAD(kA0, kB0, vv0, 0); AT_LOAD(kA1, kB1, vv1, 1);
    AT_WRITE(kA0, kB0, vv0, 0); AT_WRITE(kA1, kB1, vv1, BUFB);
    AT_LOAD(kA0, kB0, vv0, 2); AT_LOAD(kA1, kB1, vv1, 3);
    __syncthreads();
    int bc = 0, bn = BUFB, bw = 2 * BUFB;
    f32x16 pA0, pA1, pB0, pB1;
    attn_qk<DSA>(lds, 0, 0, qf, pA0, pA1, q0, lane, sl2, slc, mrow);
    for (int t = 0; t < NT; t += 2) {
        if (t + 1 < NT && AT_ACTIVE(t + 1)) attn_qk<DSA>(lds, bn, t + 1, qf, pB0, pB1, q0, lane, sl2, slc, mrow);
        if (AT_ACTIVE(t)) attn_sm_pv<DSA>(lds, bc, pA0, pA1, o, mrun, lrun, lane, wsf);
        if (t + 2 < NT) AT_WRITE(kA0, kB0, vv0, bw);
        AT_LOAD(kA0, kB0, vv0, t + 4);
        __syncthreads(); AT_ROT();
        if (t + 1 >= NT) break;
        if (t + 2 < NT && AT_ACTIVE(t + 2)) attn_qk<DSA>(lds, bn, t + 2, qf, pA0, pA1, q0, lane, sl2, slc, mrow);
        if (AT_ACTIVE(t + 1)) attn_sm_pv<DSA>(lds, bc, pB0, pB1, o, mrun, lrun, lane, wsf);
        if (t + 3 < NT) AT_WRITE(kA1, kB1, vv1, bw);
        AT_LOAD(kA1, kB1, vv1, t + 5);
        __syncthreads(); AT_ROT();
    }
#undef AT_ROT
#undef AT_LOAD
#undef AT_WRITE
#undef AT_ACTIVE
    { auto rr = __builtin_amdgcn_permlane32_swap(__float_as_uint(lrun), __float_as_uint(lrun), false, false); lrun = __uint_as_float(rr[0]) + __uint_as_float(rr[1]); }
    if (hi == 0) wsf[r32] = 1.0f / lrun;
    asm volatile("s_waitcnt lgkmcnt(0)" ::: "memory");
    bf16_t* Ob = (bf16_t*)(ws + WS_CONCAT) + (rowbase + q0) * DM + (DSA ? 512 : 0) + h * 64 + r32;
#pragma unroll
    for (int g = 0; g < 4; ++g) { const f32x4 li = *(const LAS f32x4*)(wsf + 8 * g + 4 * hi);
#pragma unroll
        for (int j = 0; j < 4; ++j) { const int r = 4 * g + j; const int orow = crow(r, hi);
            Ob[(size_t)orow * DM] = (bf16_t)(pk2(o[0][r] * li[j], 0.f) & 0xffffu); Ob[(size_t)orow * DM + 32] = (bf16_t)(pk2(o[1][r] * li[j], 0.f) & 0xffffu); } }
    asm volatile("s_waitcnt lgkmcnt(0)" ::: "memory");
    __syncthreads();
}

__device__ __forceinline__ unsigned f2key(float s) { s = s + 0.0f; const unsigned u = __float_as_uint(s); return (u & 0x80000000u) ? ~u : (u | 0x80000000u); }
#define SBAR0() __builtin_amdgcn_sched_barrier(0)
#ifndef IDX_ITCAP
#define IDX_ITCAP 16
#endif
__device__ __forceinline__ void cnt_ge4(int& cnt, unsigned k0, unsigned k1, unsigned k2, unsigned k3, unsigned t) {
    unsigned long long m0, m1, m2, m3;
    asm("v_cmp_ge_u32_e64 %1, %5, %9\n\tv_cmp_ge_u32_e64 %2, %6, %9\n\tv_cmp_ge_u32_e64 %3, %7, %9\n\tv_cmp_ge_u32_e64 %4, %8, %9\n\t"
        "v_addc_co_u32_e64 %0, %1, %0, 0, %1\n\tv_addc_co_u32_e64 %0, %2, %0, 0, %2\n\tv_addc_co_u32_e64 %0, %3, %0, 0, %3\n\tv_addc_co_u32_e64 %0, %4, %0, 0, %4"
        : "+v"(cnt), "=&s"(m0), "=&s"(m1), "=&s"(m2), "=&s"(m3) : "v"(k0), "v"(k1), "v"(k2), "v"(k3), "v"(t));
}
__device__ __forceinline__ float relu1(float x) { return __builtin_amdgcn_fmed3f(x, 0.f, __builtin_inff()); }
__device__ __forceinline__ float key2f(unsigned k) { const unsigned u = (k & 0x80000000u) ? (k ^ 0x80000000u) : ~k; return __uint_as_float(u); }

__device__ __forceinline__ void idx_unit(LAS unsigned char* lds, const Args& a, int b, int qg, int tid) {
    asm volatile("" : "+v"(tid));
    unsigned char* ws = a.ws; const bf16_t* PROJ = (const bf16_t*)(ws + WS_PROJ); unsigned* MASK = (unsigned*)(ws + WS_MASK);
    const int lane = tid & 63; const int wid = __builtin_amdgcn_readfirstlane(tid >> 6);
    const size_t rowbase = (size_t)b * SEQ; const int hl = lane >> 5, c = lane & 31;
    const int nkeys = 32 * qg + 32;
    const int nstage = (nkeys + 511) & ~511;
    for (int i0 = tid; i0 < nstage * 4; i0 += 4 * NTHREADS) {
        u32x4 v[4];
#pragma unroll
        for (int q = 0; q < 4; ++q) { const int i = i0 + q * NTHREADS; v[q] = *(const u32x4*)(PROJ + (rowbase + (i >> 2)) * NPROJ + C_IK + (i & 3) * 8); }
#pragma unroll
        for (int q = 0; q < 4; ++q) { const int i = i0 + q * NTHREADS; const int r = i >> 2, ch = i & 3; *(LAS u32x4*)(lds + r * 64 + ((ch ^ ((r >> 2) & 3)) * 16)) = v[q]; }
    }
    __syncthreads();
    const int t0 = 32 * qg + 4 * wid;
    const int tqa = t0 + 2 * hl, tqb = tqa + 1; const int ntile = (t0 + 3) / 32 + 1;
    const int aq = 2 * ((c >> 2) & 1) + (c >> 4), ah = (c & 3) + 4 * ((c >> 3) & 1);
    const bf16_t* ap = PROJ + (rowbase + t0 + aq) * NPROJ + C_IQ + ah * 32 + 8 * hl;
    const bf16x8 a0 = *(const bf16x8*)ap, a1 = *(const bf16x8*)(ap + 16);
    float wa[8], wb[8];
    { const u32x4 wv = *(const u32x4*)(PROJ + (rowbase + tqa) * NPROJ + C_IW), wv2 = *(const u32x4*)(PROJ + (rowbase + tqb) * NPROJ + C_IW);
#pragma unroll
      for (int j = 0; j < 4; ++j) { wa[2 * j] = bf_lo(wv[j]); wa[2 * j + 1] = bf_hi(wv[j]); wb[2 * j] = bf_lo(wv2[j]); wb[2 * j + 1] = bf_hi(wv2[j]); } }
    unsigned keyA[64], keyB[64];
    const int sw = (c >> 2) & 3;
    const LAS unsigned char* kb0 = lds + c * 64 + ((hl ^ sw) * 16); const LAS unsigned char* kb1 = lds + c * 64 + (((2 + hl) ^ sw) * 16);
#pragma unroll
    for (int blk = 0; blk < 16; ++blk) {
        if (blk * 4 < ntile) {
#pragma unroll
            for (int j4 = 0; j4 < 4; ++j4) { const int i = blk * 4 + j4;
                if (i < ntile) {
                    const bf16x8 b0 = *(const LAS bf16x8*)(kb0 + i * 2048), b1 = *(const LAS bf16x8*)(kb1 + i * 2048);
                    f32x16 z = f32x16{};
                    z = __builtin_amdgcn_mfma_f32_32x32x16_bf16(a0, b0, z, 0, 0, 0); z = __builtin_amdgcn_mfma_f32_32x32x16_bf16(a1, b1, z, 0, 0, 0);
                    float sa = 0.f, sb = 0.f;
#pragma unroll
                    for (int r = 0; r < 8; ++r) { sa += wa[r] * relu1(z[r]); sb += wb[r] * relu1(z[8 + r]); }
                    const int kidx = 32 * i + c;
                    keyA[i] = (kidx <= tqa) ? f2key(sa) : 0u; keyB[i] = (kidx <= tqb) ? f2key(sb) : 0u;
                } else { keyA[i] = 0u; keyB[i] = 0u; } }
        } else {
#pragma unroll
            for (int j4 = 0; j4 < 4; ++j4) { keyA[blk * 4 + j4] = 0u; keyB[blk * 4 + j4] = 0u; }
        }
        SBAR0();
    }
    const int KqA = tqa + 1 < 256 ? tqa + 1 : 256, KqB = tqb + 1 < 256 ? tqb + 1 : 256;
    unsigned TA = 1u, TB = 1u; int cgeA = KqA, cgeB = KqB;
#define COUNT_GE(ta, tb, ca, cb) do { ca = 0; cb = 0; const unsigned ta_ = (ta), tb_ = (tb); _Pragma("unroll") for (int blk = 0; blk < 8; ++blk) { if (blk * 8 < ntile) { \
        cnt_ge4(ca, keyA[blk * 8 + 0], keyA[blk * 8 + 1], keyA[blk * 8 + 2], keyA[blk * 8 + 3], ta_); cnt_ge4(cb, keyB[blk * 8 + 0], keyB[blk * 8 + 1], keyB[blk * 8 + 2], keyB[blk * 8 + 3], tb_); \
        cnt_ge4(ca, keyA[blk * 8 + 4], keyA[blk * 8 + 5], keyA[blk * 8 + 6], keyA[blk * 8 + 7], ta_); cnt_ge4(cb, keyB[blk * 8 + 4], keyB[blk * 8 + 5], keyB[blk * 8 + 6], keyB[blk * 8 + 7], tb_); } SBAR0(); } \
        ca = half32_sum(ca); cb = half32_sum(cb); } while (0)
    if (t0 + 3 >= 256) {
        unsigned mxA = 0u, mxB = 0u, mnA = 0xffffffffu, mnB = 0xffffffffu;
#pragma unroll
        for (int i = 0; i < 64; ++i) { mxA = max(mxA, keyA[i]); mxB = max(mxB, keyB[i]); mnA = min(mnA, keyA[i] ? keyA[i] : 0xffffffffu); mnB = min(mnB, keyB[i] ? keyB[i] : 0xffffffffu); }
        unsigned loA = ~half32_max(~mnA), hiA = half32_max(mxA), loB = ~half32_max(~mnB), hiB = half32_max(mxB);
        int cloA = tqa + 1, cloB = tqb + 1;
        if (cloA == KqA) hiA = loA;
        if (cloB == KqB) hiB = loB;
        for (int it = 0; it < IDX_ITCAP; ++it) {
            if (__all(loA == hiA && loB == hiB)) break;
            unsigned gA = f2key(0.5f * key2f(loA) + 0.5f * key2f(hiA)), gB = f2key(0.5f * key2f(loB) + 0.5f * key2f(hiB));
            gA = gA <= loA ? loA + 1u : gA; gA = gA > hiA ? hiA : gA; gB = gB <= loB ? loB + 1u : gB; gB = gB > hiB ? hiB : gB;
            const unsigned midA = gA, midB = gB;
            int ca, cb; COUNT_GE(midA, midB, ca, cb);
            if (loA != hiA) { if (ca >= KqA) { loA = midA; cloA = ca; } else hiA = midA - 1u; if (ca == KqA) hiA = midA; }
            if (loB != hiB) { if (cb >= KqB) { loB = midB; cloB = cb; } else hiB = midB - 1u; if (cb == KqB) hiB = midB; }
        }
        for (int ms = 0; ms < 4096; ++ms) {
            if (__all(loA == hiA && loB == hiB)) break;
            unsigned mA = 0u, mB = 0u;
#pragma unroll
            for (int blk = 0; blk < 8; ++blk) { if (blk * 8 < ntile) {
#pragma unroll
                for (int j8 = 0; j8 < 8; ++j8) { const unsigned ka = keyA[blk * 8 + j8], kb = keyB[blk * 8 + j8]; mA = max(mA, ka <= hiA ? ka : 0u); mB = max(mB, kb <= hiB ? kb : 0u); } } SBAR0(); }
            mA = half32_max(mA); mB = half32_max(mB);
            int ca, cb; COUNT_GE(mA, mB, ca, cb);
            if (loA != hiA) { if (ca >= KqA) { loA = mA; hiA = mA; cloA = ca; } else hiA = mA - 1u; }
            if (loB != hiB) { if (cb >= KqB) { loB = mB; hiB = mB; cloB = cb; } else hiB = mB - 1u; }
        }
        TA = loA; TB = loB; cgeA = cloA; cgeB = cloB;
    }
    const bool ties = __any(cgeA != KqA || cgeB != KqB);
    int needA = 0, needB = 0, runA = 0, runB = 0;
    if (ties) { int ca, cb; COUNT_GE(TA + 1u, TB + 1u, ca, cb); needA = KqA - ca; needB = KqB - cb; }
    unsigned mw0 = 0u, mw1 = 0u, mw2 = 0u, mw3 = 0u;
#pragma unroll
    for (int blk = 0; blk < 16; ++blk) {
        if (blk * 4 < ntile) {
#pragma unroll
            for (int j4 = 0; j4 < 4; ++j4) { const int i = blk * 4 + j4;
                bool selA = keyA[i] >= TA && keyA[i] != 0u, selB = keyB[i] >= TB && keyB[i] != 0u;
                if (ties) {
                    const bool eqA = keyA[i] == TA && keyA[i] != 0u, eqB = keyB[i] == TB && keyB[i] != 0u;
                    const unsigned long long balA = __ballot(eqA), balB = __ballot(eqB);
                    const unsigned eA = hl ? (unsigned)(balA >> 32) : (unsigned)balA, eB = hl ? (unsigned)(balB >> 32) : (unsigned)balB;
                    const unsigned below = (1u << c) - 1u;
                    selA = (keyA[i] > TA) || (eqA && (runA + __popc(eA & below) < needA)); selB = (keyB[i] > TB) || (eqB && (runB + __popc(eB & below) < needB));
                    runA += __popc(eA); runB += __popc(eB);
                }
                const unsigned long long sA = __ballot(selA), sB = __ballot(selB);
                if (lane == i) { mw0 = (unsigned)sA; mw2 = (unsigned)(sA >> 32); mw1 = (unsigned)sB; mw3 = (unsigned)(sB >> 32); } }
        }
        SBAR0();
    }
#undef COUNT_GE
    unsigned* mrow = MASK + (rowbase + t0) * 64 + lane;
    mrow[0] = mw0; mrow[64] = mw1; mrow[128] = mw2; mrow[192] = mw3;
    __syncthreads();
}

__device__ __forceinline__ void ln_row(f32x4 (&v)[4], const float* gam, const float* bet, int lane) {
    float s = 0.f;
#pragma unroll
    for (int j = 0; j < 4; ++j) s += (v[j][0] + v[j][1]) + (v[j][2] + v[j][3]);
    const float mean = wave_sum(s) * (1.f / DM); float s2 = 0.f;
#pragma unroll
    for (int j = 0; j < 4; ++j) { v[j] = v[j] - mean; s2 += (v[j][0] * v[j][0] + v[j][1] * v[j][1]) + (v[j][2] * v[j][2] + v[j][3] * v[j][3]); }
    const float rstd = 1.0f / sqrtf(wave_sum(s2) * (1.f / DM) + LN_EPS);
#pragma unroll
    for (int j = 0; j < 4; ++j) { const f32x4 gg = *((const f32x4*)gam + lane + 64 * j), bb = *((const f32x4*)bet + lane + 64 * j); v[j] = v[j] * rstd * gg + bb; }
}

__device__ __forceinline__ void p6_ln1_router(LAS unsigned char* lds, const Args& a, int l, const int tid, const int nrep) {
    const int lane = tid & 63; const int wave = __builtin_amdgcn_readfirstlane(tid >> 6);
    unsigned char* ws = a.ws;
    LAS float* rwt = (LAS float*)lds;
    LAS int* ent_e = (LAS int*)(lds + 65536);
    LAS int* ent_p = ent_e + 128;
    LAS float* bias_l = (LAS float*)(ent_p + 128);
    { f32x4 rv[8];
#pragma unroll
      for (int q = 0; q < 8; ++q) rv[q] = *((const f32x4*)a.router_w + tid + q * NTHREADS);
#pragma unroll
      for (int q = 0; q < 8; ++q) { const int i4 = tid + q * NTHREADS, k = i4 >> 2, e0 = (i4 & 3) * 4;
#pragma unroll
          for (int c = 0; c < 4; ++c) rwt[(e0 + c) * DM + k] = rv[q][c]; } }
    if (tid < 16) bias_l[tid] = a.router_bias[tid];
    if (tid < 128) { ent_e[tid] = -1; ent_p[tid] = 0; }
    __syncthreads();
    const bf16_t* MIX = (const bf16_t*)(ws + WS_MIX); const bf16_t* XBr = (const bf16_t*)(ws + WS_XB); bf16_t* X1B = (bf16_t*)(ws + WS_X1B); float* GATE = (float*)(ws + WS_GATE);
    const float* gam = a.ln1_g + l * DM; const float* bet = a.ln1_b + l * DM;
    const int G = gridDim.x;
    const int ntok = (M / (256 * 8)) * nrep;
    u32x2 xw[4], mw[4];
    { const int m0 = blockIdx.x * 8 + wave;
#pragma unroll
      for (int j = 0; j < 4; ++j) { xw[j] = *((const u32x2*)(XBr + (size_t)m0 * DM) + lane + 64 * j); mw[j] = *((const u32x2*)(MIX + (size_t)m0 * DM) + lane + 64 * j); } }
    for (int it2 = 0; it2 < ntok; ++it2) {
        const int it = it2 & 7;
        const int m = (it * G + blockIdx.x) * 8 + wave;
        u32x2 nxw[4], nmw[4];
        { const int itn = (it2 + 1 < ntok ? it2 + 1 : it2) & 7; const int mn = (itn * G + blockIdx.x) * 8 + wave;
#pragma unroll
          for (int j = 0; j < 4; ++j) { nxw[j] = *((const u32x2*)(XBr + (size_t)mn * DM) + lane + 64 * j); nmw[j] = *((const u32x2*)(MIX + (size_t)mn * DM) + lane + 64 * j); } }
        f32x4 v[4];
#pragma unroll
        for (int j = 0; j < 4; ++j) { v[j][0] = ALPHA * bf_lo(xw[j].x) + bf_lo(mw[j].x); v[j][1] = ALPHA * bf_hi(xw[j].x) + bf_hi(mw[j].x); v[j][2] = ALPHA * bf_lo(xw[j].y) + bf_lo(mw[j].y); v[j][3] = ALPHA * bf_hi(xw[j].y) + bf_hi(mw[j].y); }
        ln_row(v, gam, bet, lane);
#pragma unroll
        for (int j = 0; j < 4; ++j) { u32x2 w; w.x = pk2(v[j][0], v[j][1]); w.y = pk2(v[j][2], v[j][3]); *((u32x2*)(X1B + (size_t)m * DM) + lane + 64 * j) = w; }
        float ps[16];
#pragma unroll
        for (int e = 0; e < 16; ++e) { float s = 0.f;
#pragma unroll
            for (int j = 0; j < 4; ++j) { const f32x4 r = *((const LAS f32x4*)(rwt + e * DM) + lane + 64 * j); s += v[j][0] * r[0] + v[j][1] * r[1] + v[j][2] * r[2] + v[j][3] * r[3]; }
            ps[e] = s; }
        float t8[8], u4[4];
#pragma unroll
        for (int e = 0; e < 8; ++e) { auto rr = __builtin_amdgcn_permlane32_swap(__float_as_uint(ps[e]), __float_as_uint(ps[e + 8]), false, false); t8[e] = __uint_as_float(rr[0]) + __uint_as_float(rr[1]); }
#pragma unroll
        for (int e = 0; e < 4; ++e) { auto rr = __builtin_amdgcn_permlane16_swap(__float_as_uint(t8[e]), __float_as_uint(t8[e + 4]), false, false); u4[e] = __uint_as_float(rr[0]) + __uint_as_float(rr[1]); }
#pragma unroll
        for (int e = 0; e < 4; ++e) { float x = u4[e]; x += dpp_f<0xB1>(x); x += dpp_f<0x4E>(x); x += dpp_f<0x141>(x); x += dpp_f<0x140>(x); u4[e] = x; }
        float lg[16];
#pragma unroll
        for (int e = 0; e < 4; ++e) { const int ub = (int)__float_as_uint(u4[e]);
            lg[e] = __uint_as_float((unsigned)__builtin_amdgcn_readlane(ub, 0)); lg[e + 4] = __uint_as_float((unsigned)__builtin_amdgcn_readlane(ub, 16));
            lg[e + 8] = __uint_as_float((unsigned)__builtin_amdgcn_readlane(ub, 32)); lg[e + 12] = __uint_as_float((unsigned)__builtin_amdgcn_readlane(ub, 48)); }
#pragma unroll
        for (int j = 0; j < 4; ++j) { xw[j] = nxw[j]; mw[j] = nmw[j]; }
        float best_gs = -INFINITY, be_a1 = 0.f, be_a2 = 0.f; int be1 = 0, be2 = 0;
#pragma unroll
        for (int gi = 0; gi < 4; ++gi) {
            float af[4], bs[4];
#pragma unroll
            for (int j = 0; j < 4; ++j) { af[j] = 1.0f / (1.0f + expf(-lg[gi * 4 + j])); bs[j] = af[j] + bias_l[gi * 4 + j]; }
            int i1 = 0; float m1 = bs[0], a1 = af[0];
#pragma unroll
            for (int j = 1; j < 4; ++j) if (bs[j] > m1) { m1 = bs[j]; a1 = af[j]; i1 = j; }
            int i2 = -1; float m2 = -INFINITY, a2 = 0.f;
#pragma unroll
            for (int j = 0; j < 4; ++j) if (j != i1 && bs[j] > m2) { m2 = bs[j]; a2 = af[j]; i2 = j; }
            const float gs = m1 + m2;
            if (gs > best_gs) { best_gs = gs; be1 = gi * 4 + i1; be2 = gi * 4 + i2; be_a1 = a1; be_a2 = a2; }
        }
        if (lane == 0) { const float inv = 1.0f / (be_a1 + be_a2); GATE[(size_t)m * 2] = be_a1 * inv; GATE[(size_t)m * 2 + 1] = be_a2 * inv;
            const int slot = (it * 8 + wave) * 2; ent_e[slot] = be1; ent_p[slot] = m * 2; ent_e[slot + 1] = be2; ent_p[slot + 1] = m * 2 + 1; }
    }
    __syncthreads();
    if (tid < 16) { const int e = tid; int cnt = 0;
        for (int i = 0; i < 128; ++i) cnt += (ent_e[i] == e) ? 1 : 0;
        if (cnt > 0) { int* ctr = (int*)(ws + WS_CTL) + l * 16 + e; int base = atomicAdd(ctr, cnt); int* el = (int*)(ws + WS_ELIST) + ((size_t)l * 16 + e) * 16384;
            for (int i = 0; i < 128; ++i) if (ent_e[i] == e) el[base++] = ent_p[i]; } }
    __syncthreads();
}

__device__ __forceinline__ void p9_ln2(const Args& a, int l, int gw, int NGW, int lane) {
    unsigned char* ws = a.ws; const bf16_t* X1B = (const bf16_t*)(ws + WS_X1B); const bf16_t* Y = (const bf16_t*)(ws + WS_Y); bf16_t* XB = (bf16_t*)(ws + WS_XB);
    const float* gam = a.ln2_g + l * DM; const float* bet = a.ln2_b + l * DM;
    u32x2 xw[4], y0[4], y1[4];
#pragma unroll
    for (int j = 0; j < 4; ++j) { xw[j] = *((const u32x2*)(X1B + (size_t)gw * DM) + lane + 64 * j); y0[j] = *((const u32x2*)(Y + (size_t)(2 * gw) * DM) + lane + 64 * j); y1[j] = *((const u32x2*)(Y + (size_t)(2 * gw + 1) * DM) + lane + 64 * j); }
    for (int m = gw; m < M; m += NGW) {
        u32x2 nxw[4], ny0[4], ny1[4];
        { const int mn = m + NGW < M ? m + NGW : m;
#pragma unroll
          for (int j = 0; j < 4; ++j) { nxw[j] = *((const u32x2*)(X1B + (size_t)mn * DM) + lane + 64 * j); ny0[j] = *((const u32x2*)(Y + (size_t)(2 * mn) * DM) + lane + 64 * j); ny1[j] = *((const u32x2*)(Y + (size_t)(2 * mn + 1) * DM) + lane + 64 * j); } }
        f32x4 v[4];
#pragma unroll
        for (int j = 0; j < 4; ++j) {
            v[j][0] = ALPHA * bf_lo(xw[j].x) + (bf_lo(y0[j].x) + bf_lo(y1[j].x)); v[j][1] = ALPHA * bf_hi(xw[j].x) + (bf_hi(y0[j].x) + bf_hi(y1[j].x));
            v[j][2] = ALPHA * bf_lo(xw[j].y) + (bf_lo(y0[j].y) + bf_lo(y1[j].y)); v[j][3] = ALPHA * bf_hi(xw[j].y) + (bf_hi(y0[j].y) + bf_hi(y1[j].y)); }
#pragma unroll
        for (int j = 0; j < 4; ++j) { xw[j] = nxw[j]; y0[j] = ny0[j]; y1[j] = ny1[j]; }
        ln_row(v, gam, bet, lane);
#pragma unroll
        for (int j = 0; j < 4; ++j) {
            if (l + 1 < DEPTH) { u32x2 w; w.x = pk2(v[j][0], v[j][1]); w.y = pk2(v[j][2], v[j][3]); *((u32x2*)(XB + (size_t)m * DM) + lane + 64 * j) = w; }
            else *((f32x4*)(a.out + (size_t)m * DM) + lane + 64 * j) = v[j]; }
    }
}


#define XB_TMO      128
#define XB_XCNT(j)  (256  + 64 * (j))
#define XB_XSUB(j)  (1280 + 64 * (j))
#define XB_XGEN(j)  (2304 + 64 * (j))
#define XB_TOP      3328
#define XB_TOPGEN   3392
#define XCD_BAR_WORDS 3456
#define XB_SPIN_CAP (1u << 18)
__device__ __forceinline__ unsigned xb_ld(unsigned* p)              { return __hip_atomic_load(p, __ATOMIC_RELAXED, __HIP_MEMORY_SCOPE_AGENT); }
__device__ __forceinline__ unsigned xb_add(unsigned* p, unsigned v) { return __hip_atomic_fetch_add(p, v, __ATOMIC_RELAXED, __HIP_MEMORY_SCOPE_AGENT); }
__device__ __forceinline__ unsigned xb_xcc_id() { return (unsigned)__builtin_amdgcn_s_getreg((3 << 11) | 20) & 0xFu; }
#define XB_SPIN(cond, bar) do { unsigned _sp = 0; while (cond) { __builtin_amdgcn_s_sleep(1); \
    if ((++_sp & 255u) == 0u) { if (xb_ld(&(bar)[XB_TMO])) break; if (_sp > XB_SPIN_CAP) { atomicAdd(&(bar)[XB_TMO], 1u); break; } } } } while (0)
struct XcdBarrier { unsigned* bar; unsigned x; volatile LAS unsigned* st; };
__device__ __forceinline__ XcdBarrier xcd_barrier_post(unsigned* bar, volatile LAS unsigned* st) {
    XcdBarrier b; b.bar = bar; b.x = xb_xcc_id(); b.st = st;
    if (threadIdx.x == 0) (void)xb_add(&bar[XB_XCNT(b.x)], 1u);
    return b;
}
__device__ __forceinline__ void xcd_barrier_complete(unsigned* bar, unsigned x, unsigned& nloc, unsigned& nx) {
    const unsigned G = gridDim.x * gridDim.y * gridDim.z;
    unsigned sum, cnt, mine, sp = 0u;
    for (;;) {
        sum = 0u; cnt = 0u; mine = 0u;
#pragma unroll
        for (unsigned j = 0; j < 16; ++j) { const unsigned c = xb_ld(&bar[XB_XCNT(j)]); sum += c; cnt += (c > 0u) ? 1u : 0u; mine = (j == x) ? c : mine; }
        if (sum == G) break;
        __builtin_amdgcn_s_sleep(1);
        if ((++sp & 255u) == 0u) { if (xb_ld(&bar[XB_TMO])) break; if (sp > XB_SPIN_CAP) { atomicAdd(&bar[XB_TMO], 1u); break; } }
    }
    nloc = mine > 0u ? mine : 1u; nx = cnt > 0u ? cnt : 1u;
}
__device__ __forceinline__ void xcd_barrier(const XcdBarrier& b) {
    asm volatile("s_waitcnt vmcnt(0)" ::: "memory");
    __syncthreads();
    if (threadIdx.x == 0) {
        unsigned* bar = b.bar;
        __builtin_amdgcn_s_waitcnt(0);
        unsigned nloc = b.st[0], nx = b.st[1];
        if (nloc == 0u) { xcd_barrier_complete(bar, b.x, nloc, nx); b.st[0] = nloc; b.st[1] = nx; }
        const unsigned old = xb_add(&bar[XB_XSUB(b.x)], 1u);
        const unsigned gen = old / nloc;
        if (old + 1u == (gen + 1u) * nloc) {
            __builtin_amdgcn_fence(__ATOMIC_RELEASE, "agent");
            asm volatile("s_waitcnt vmcnt(0)" ::: "memory");
            const unsigned og = xb_add(&bar[XB_TOP], 1u);
            const unsigned tg = og / nx;
            if (og + 1u == (tg + 1u) * nx) xb_add(&bar[XB_TOPGEN], 1u);
            else XB_SPIN(xb_ld(&bar[XB_TOPGEN]) == tg, bar);
            __builtin_amdgcn_fence(__ATOMIC_ACQUIRE, "agent");
            xb_add(&bar[XB_XGEN(b.x)], 1u);
            asm volatile("s_waitcnt vmcnt(0)" ::: "memory");
        } else {
            XB_SPIN(xb_ld(&bar[XB_XGEN(b.x)]) == gen, bar);
            __builtin_amdgcn_fence(__ATOMIC_ACQUIRE, "agent");
            asm volatile("s_waitcnt vmcnt(0)" ::: "memory");
        }
    }
    __syncthreads();
}

#ifndef PROJ_MERGED
#define PROJ_MERGED 0
#endif
#ifndef MOE_MERGED
#define MOE_MERGED 1
#endif
constexpr int N_PHASES = 1 + 10 * DEPTH;
#ifndef DUP_MASK
#define DUP_MASK 0
#endif
#define NREP(k) ((((DUP_MASK) >> (k)) & 1) ? (((a.dup_mask >> (k)) & 1) + 1) : 1)

__global__ void __launch_bounds__(NTHREADS, 2) mega_fwd(Args a_param) {
    extern __shared__ __attribute__((aligned(16))) unsigned char lds_raw[];
    LAS unsigned char* const lds0 = (LAS unsigned char*)lds_raw;
    cg::grid_group grid = cg::this_grid();
    const int wave0 = __builtin_amdgcn_readfirstlane((int)threadIdx.x >> 6);
    const int G0 = gridDim.x, bx0 = blockIdx.x;
    volatile LAS unsigned* bar_st = (volatile LAS unsigned*)(lds0 + MISC_OFF + 1024);
    if (threadIdx.x < 4) bar_st[threadIdx.x] = 0u;
    __syncthreads();
    (void)xcd_barrier_post((unsigned*)(a_param.ws + WS_BAR), bar_st);
    typedef const __attribute__((address_space(4))) Args* kargs_t;
#define PHASE_IDS() int G = G0, bx = bx0; unsigned ldsu_ = (unsigned)(uintptr_t)lds0; asm volatile("" : "+s"(G), "+s"(bx), "+s"(ldsu_)); LAS unsigned char* lds = (LAS unsigned char*)(uintptr_t)ldsu_; const int vcu = (G % 8 == 0) ? (bx % 8) * (G / 8) + bx / 8 : bx; const int NGW = G * NWAVES; (void)NGW; (void)vcu; \
        kargs_t ap_ = (kargs_t)__builtin_amdgcn_kernarg_segment_ptr(); asm volatile("" : "+s"(ap_)); Args a; __builtin_memcpy(&a, ap_, sizeof(Args)); unsigned char* ws = a.ws; (void)ws; int tid; asm volatile("v_mbcnt_lo_u32_b32 %0, -1, 0\n\tv_mbcnt_hi_u32_b32 %0, -1, %0" : "=v"(tid)); tid += wave0 * 64; const int lane = tid & 63; const int wave = __builtin_amdgcn_readfirstlane(tid >> 6); const int gw = vcu * NWAVES + wave; (void)lane; (void)gw; \
        LAS float* scr = (LAS float*)(lds + wave * 16384); (void)scr
    const int lo = a_param.ph_lo, hi = a_param.ph_hi;
    if (lo < 0) grid.sync();
#ifdef DBG_ONLY
#define IN(k) ((((k) - 1) % 10 + 1 == DBG_ONLY || ((k) == 0 && DBG_ONLY == 0)) && lo <= (k) && (k) < hi)
#else
#define IN(k) (lo <= (k) && (k) < hi)
#endif
#define SEAM_BAR() do { kargs_t bp_ = (kargs_t)__builtin_amdgcn_kernarg_segment_ptr(); asm volatile("" : "+s"(bp_)); \
        XcdBarrier xb_; xb_.bar = (unsigned*)(bp_->ws + WS_BAR); xb_.x = xb_xcc_id(); xb_.st = (volatile LAS unsigned*)(lds0 + MISC_OFF + 1024); xcd_barrier(xb_); } while (0)
#define SEAM(k) do { if (IN(k) && IN((k) + 1)) { { kargs_t bp_ = (kargs_t)__builtin_amdgcn_kernarg_segment_ptr(); asm volatile("" : "+s"(bp_)); \
        XcdBarrier xb_; xb_.bar = (unsigned*)(bp_->ws + WS_BAR); xb_.x = xb_xcc_id(); xb_.st = (volatile LAS unsigned*)(lds0 + MISC_OFF + 1024); xcd_barrier(xb_); if ((DUP_MASK) & 0x2000) xcd_barrier(xb_); } } } while (0)

    if (IN(0)) { PHASE_IDS(); for (int rep = 0; rep < NREP(10); ++rep) { p0_small_weights(a, scr, gw, NGW, lane); p0_expert_weights(a, 0, scr, gw, NGW, lane); p0_misc(a, gw, NGW, lane); } }
    SEAM(0);
    for (int l = 0; l < DEPTH; ++l) {
        const int P = 1 + 10 * l;
#if PROJ_MERGED
        if (IN(P + 0)) { PHASE_IDS();
            pg8::ProjSched S; S.XB = (const bf16_t*)(ws + WS_XB); S.PROJ = (const bf16_t*)(ws + WS_PROJ); S.WIN = (const bf16_t*)(ws + WS_WIN) + (size_t)l * NPROJ * DM;
            S.WQUP = (const bf16_t*)(ws + WS_WQUP) + (size_t)l * 768 * 384; S.WKV = (const bf16_t*)(ws + WS_WKV) + (size_t)l * 1024 * 256;
            S.c01 = (unsigned*)(ws + WS_CTL) + 768 + l * 128; S.c12 = S.c01 + 64; S.G = G; S.v = bx;
            pg8::EpiProj E0{(bf16_t*)(ws + WS_PROJ), NPROJ, (float*)(ws + WS_RS), (bf16_t*)(ws + WS_KR), (const float*)(ws + WS_ROPE), (const float*)(ws + WS_ROPE) + SEQ * 16, true};
            pg8::EpiQRope E1{(bf16_t*)(ws + WS_Q), 768, (const float*)(ws + WS_RS), (const float*)(ws + WS_ROPE), (const float*)(ws + WS_ROPE) + SEQ * 16};
            pg8::EpiBf16 E2{(bf16_t*)(ws + WS_KVU), 1024, (const float*)(ws + WS_RS), 12, 2, 1.f / 256.f};
            pg8::gemm_stream(lds, S, E0, E1, E2, tid);
        }
        if (IN(P + 0) && IN(P + 3)) SEAM_BAR();
#else
        if (IN(P + 0)) { PHASE_IDS();
            pg8::DenseSched S; S.A = (const bf16_t*)(ws + WS_XB); S.Bt = (const bf16_t*)(ws + WS_WIN) + (size_t)l * NPROJ * DM; S.lda = DM; S.K = DM; S.so.init(M, NPROJ, G, bx, NREP(0));
            pg8::EpiProj E{(bf16_t*)(ws + WS_PROJ), NPROJ, (float*)(ws + WS_RS), (bf16_t*)(ws + WS_KR), (const float*)(ws + WS_ROPE), (const float*)(ws + WS_ROPE) + SEQ * 16, false};
            pg8::gemm_phase(lds, S, E, tid);
        }
        if (IN(P + 0) && IN(P + 2)) SEAM_BAR();
        if (IN(P + 2)) { PHASE_IDS();
            { pg8::DenseSched S; S.A = (const bf16_t*)(ws + WS_PROJ) + C_QA; S.Bt = (const bf16_t*)(ws + WS_WQUP) + (size_t)l * 768 * 384; S.lda = NPROJ; S.K = 384; S.so.init(M, 768, G, bx - 64, NREP(2));
              pg8::EpiQRope E{(bf16_t*)(ws + WS_Q), 768, (const float*)(ws + WS_RS), (const float*)(ws + WS_ROPE), (const float*)(ws + WS_ROPE) + SEQ * 16};
              pg8::gemm_phase(lds, S, E, tid); }
            { pg8::DenseSched S; S.A = (const bf16_t*)(ws + WS_PROJ) + C_KVA; S.Bt = (const bf16_t*)(ws + WS_WKV) + (size_t)l * 1024 * 256; S.lda = NPROJ; S.K = 256; S.so.init(M, 1024, G, bx, NREP(2));
              pg8::EpiBf16 E{(bf16_t*)(ws + WS_KVU), 1024, (const float*)(ws + WS_RS), 12, 2, 1.f / 256.f};
              pg8::gemm_phase(lds, S, E, tid); }
            for (int uu = vcu; uu < 256 * NREP(11); uu += G) { const int u = uu & 255; const int b = u >> 5, s = u & 31;
                for (int k = 0; k < 2; ++k) idx_unit(lds, a, b, k ? s : 63 - s, tid); }
        }
        SEAM(P + 2);
#endif
        if (IN(P + 3)) { PHASE_IDS();
#ifndef DBG_NOMLA
            for (int rep = 0; rep < NREP(3); ++rep)
            for (int u = vcu; u < 256; u += G) { const int bh = u >> 2, s = u & 3;
                for (int k = 0; k < 2; ++k) attn_unit<false>(lds, a, bh >> 3, bh & 7, k ? s : 7 - s, tid); }
#endif
            for (int uu = vcu; uu < 256 * NREP(4); uu += G) { const int u = uu & 255; const int b = u >> 5, s = u & 31;
                for (int k = 0; k < 2; ++k) attn_unit<true>(lds, a, b, 0, k ? s : 63 - s, tid); }
        }
        if (IN(P + 3) && IN(P + 5)) SEAM_BAR();
        if (IN(P + 5)) { PHASE_IDS();
            pg8::DenseSched S; S.A = (const bf16_t*)(ws + WS_CONCAT); S.Bt = (const bf16_t*)(ws + WS_WO) + (size_t)l * DM * DM; S.lda = DM; S.K = DM; S.so.init(M, DM, G, bx, NREP(5));
            pg8::EpiBf16 E{(bf16_t*)(ws + WS_MIX), DM, nullptr, 0, 0, 0.f};
            pg8::gemm_phase(lds, S, E, tid);
        }
        SEAM(P + 5);
        if (IN(P + 6)) { PHASE_IDS(); p6_ln1_router(lds, a, l, tid, NREP(6)); }
        SEAM(P + 6);
        if (IN(P + 7) || IN(P + 8)) { PHASE_IDS();
            LAS int* tstart = (LAS int*)(lds + MISC_OFF); LAS int* ecnt = tstart + 32;
            if (tid < 16) ecnt[tid] = __hip_atomic_load((const int*)(ws + WS_CTL) + l * 16 + tid, __ATOMIC_RELAXED, __HIP_MEMORY_SCOPE_AGENT);
            __syncthreads();
            if (tid == 0) { int acc = 0;
                for (int e = 0; e < 16; ++e) { tstart[e] = acc; acc += (ecnt[e] + 255) >> 8; }
                tstart[16] = acc; }
            __syncthreads();
#if MOE_MERGED
            { pg8::Moe12Sched S; S.X1B = (const bf16_t*)(ws + WS_X1B); S.H = (const bf16_t*)(ws + WS_H); S.WGU = (const bf16_t*)(ws + WS_WGU); S.WD = (const bf16_t*)(ws + WS_WD);
              S.elist = (const int*)(ws + WS_ELIST) + (size_t)l * 16 * 16384; S.tstart = tstart; S.ecnt = ecnt; S.ready = (unsigned*)(ws + WS_CTL) + 256 + l * 256; S.G = G; S.v = vcu;
              pg8::EpiMoe1 E1{(bf16_t*)(ws + WS_H), (const float*)(ws + WS_GATE)}; pg8::EpiMoe2 E2{(bf16_t*)(ws + WS_Y)};
              pg8::gemm_stream(lds, S, E1, E2, E2, tid); }
#else
            if (IN(P + 7)) {
                pg8::MoeSched S; S.A = (const bf16_t*)(ws + WS_X1B); S.Bt = (const bf16_t*)(ws + WS_WGU); S.lda = DM; S.K = DM; S.b_estride = (size_t)DM * DM * 2; S.elist = (const int*)(ws + WS_ELIST) + (size_t)l * 16 * 16384; S.rsh = 1;
                S.tstart = tstart; S.ecnt = ecnt; S.G = G; S.v = vcu; S.nrep = NREP(7);
                pg8::EpiMoe1 E{(bf16_t*)(ws + WS_H), (const float*)(ws + WS_GATE)};
                pg8::gemm_phase(lds, S, E, tid);
            }
            SEAM(P + 7);
            if (IN(P + 8)) {
                pg8::MoeSched S; S.A = (const bf16_t*)(ws + WS_H); S.Bt = (const bf16_t*)(ws + WS_WD); S.lda = DFF; S.K = DFF; S.b_estride = (size_t)DM * DFF * 2; S.elist = (const int*)(ws + WS_ELIST) + (size_t)l * 16 * 16384; S.rsh = 0;
                S.tstart = tstart; S.ecnt = ecnt; S.G = G; S.v = vcu; S.nrep = NREP(8);
                pg8::EpiMoe2 E{(bf16_t*)(ws + WS_Y)};
                pg8::gemm_phase(lds, S, E, tid);
            }
#endif
        } else { SEAM(P + 7); }
        SEAM(P + 8);
        if (IN(P + 9)) { PHASE_IDS(); for (int rep = 0; rep < NREP(9); ++rep) p9_ln2(a, l, gw, NGW, lane); if (l + 1 < DEPTH) for (int rep = 0; rep < NREP(12); ++rep) p0_expert_weights(a, l + 1, scr, gw, NGW, lane); }
        SEAM(P + 9);
    }
#undef IN
#undef SEAM
}

#ifndef MK_PER_PHASE
#define MK_PER_PHASE 0
#endif
extern "C" void kernel_launch(void* const* d_in, const int* in_sizes, int n_in, void* d_out, int out_size, void* d_ws, size_t ws_size, hipStream_t stream) {
    static int grid_blocks = 0;
    if (grid_blocks == 0) {
        if (n_in != 17 || in_sizes[0] != M * DM || out_size != M * DM || ws_size < WS_END) { fprintf(stderr, "kernel_launch: unexpected shapes / workspace (n_in %d, in0 %d, out %d, ws %zu); nothing launched\n", n_in, n_in > 0 ? in_sizes[0] : -1, out_size, ws_size); grid_blocks = -1; return; }
        int dev = 0, cus = 0, per_cu = 0;
        (void)hipGetDevice(&dev);
        (void)hipDeviceGetAttribute(&cus, hipDeviceAttributeMultiprocessorCount, dev);
        (void)hipFuncSetAttribute((const void*)mega_fwd, hipFuncAttributeMaxDynamicSharedMemorySize, LDS_BYTES);
        (void)hipOccupancyMaxActiveBlocksPerMultiprocessor(&per_cu, (const void*)mega_fwd, NTHREADS, LDS_BYTES);
        fprintf(stderr, "kernel_launch: cus %d per_cu %d ws_size %zu\n", cus, per_cu, ws_size);
        if (per_cu < 1 || cus < 1) { grid_blocks = -1; return; }
        grid_blocks = cus > 256 ? 256 : cus;
    }
    if (grid_blocks < 0) return;
    (void)hipMemsetAsync((unsigned char*)d_ws + WS_BAR, 0, XCD_BAR_WORDS * 4, stream);
    Args a{};
    a.x = (const float*)d_in[0]; a.w_in = (const float*)d_in[1]; a.q_norm_g = (const float*)d_in[2]; a.w_q_up = (const float*)d_in[3]; a.kv_norm_g = (const float*)d_in[4];
    a.w_uk = (const float*)d_in[5]; a.w_uv = (const float*)d_in[6]; a.w_o = (const float*)d_in[7]; a.ln1_g = (const float*)d_in[8]; a.ln1_b = (const float*)d_in[9];
    a.router_w = (const float*)d_in[10]; a.router_bias = (const float*)d_in[11]; a.w_gate = (const float*)d_in[12]; a.w_up = (const float*)d_in[13]; a.w_down = (const float*)d_in[14];
    a.ln2_g = (const float*)d_in[15]; a.ln2_b = (const float*)d_in[16];
    a.out = (float*)d_out; a.ws = (unsigned char*)d_ws;
#if MK_PER_PHASE
    for (int p = 0; p < N_PHASES; ++p) { a.ph_lo = p; a.ph_hi = p + 1; void* args[] = {&a};
        hipError_t e = hipLaunchCooperativeKernel((const void*)mega_fwd, dim3(grid_blocks), dim3(NTHREADS), args, LDS_BYTES, stream);
        if (e != hipSuccess) { fprintf(stderr, "launch %d failed: %s\n", p, hipGetErrorString(e)); break; } }
#else
    a.ph_lo = 0; a.ph_hi = N_PHASES; a.dup_mask = DUP_MASK; void* args[] = {&a};
    hipError_t e = hipLaunchCooperativeKernel((const void*)mega_fwd, dim3(grid_blocks), dim3(NTHREADS), args, LDS_BYTES, stream);
    if (e != hipSuccess) fprintf(stderr, "cooperative launch failed: %s (grid %d)\n", hipGetErrorString(e), grid_blocks);
#endif
}
```

```cpp
#include <hip/hip_runtime.h>
#include <hip/hip_cooperative_groups.h>
#include <cstdio>
#include <cstdint>
namespace cg = cooperative_groups;

#define LAS __attribute__((address_space(3)))
typedef unsigned short bf16_t;
typedef short bf16x8 __attribute__((ext_vector_type(8)));
typedef short s16x4 __attribute__((ext_vector_type(4)));
typedef float f32x2 __attribute__((ext_vector_type(2)));
typedef float f32x4 __attribute__((ext_vector_type(4)));
typedef float f32x16 __attribute__((ext_vector_type(16)));
typedef unsigned u32x2 __attribute__((ext_vector_type(2)));
typedef unsigned u32x4 __attribute__((ext_vector_type(4)));
typedef __bf16 bf16x2_t __attribute__((ext_vector_type(2)));

constexpr int DM = 1024, NBATCH = 8, SEQ = 2048, M = NBATCH * SEQ, DEPTH = 2;
constexpr int NPROJ = 1792;
constexpr int IN_COLS = 1608;
constexpr int C_QA = 0, C_KVA = 384, C_KR = 640, C_DQ = 672, C_DK = 1184, C_DV = 1248, C_IQ = 1312, C_IK = 1568, C_IW = 1600;
constexpr int NEXP = 16, DFF = 512;
constexpr float ALPHA = 1.4142135623730951f;
constexpr float LN_EPS = 1e-5f, RMS_EPS = 1e-6f;
constexpr float LOG2E = 1.4426950408889634f;
constexpr float MLA_QSCALE = 0.10206207261596575f * LOG2E;
constexpr float DSA_QSCALE = 0.125f * LOG2E;
constexpr int NTHREADS = 512, NWAVES = 8;
constexpr int LDS_BYTES = 147456;
constexpr int RING_BYTES = 131072;
constexpr int MISC_OFF = RING_BYTES;

constexpr size_t MiB = 1u << 20;
constexpr size_t WS_CTL   = 0;
constexpr size_t WS_BAR   = 65536;
constexpr size_t WS_ELIST = 1 * MiB;
constexpr size_t WS_GATE  = 3 * MiB;
constexpr size_t WS_ROPE  = 3 * MiB + 512 * 1024;
constexpr size_t WS_MASK  = 4 * MiB;
constexpr size_t WS_WIN   = 8 * MiB;
constexpr size_t WS_WQUP  = 15 * MiB;
constexpr size_t WS_WKV   = 17 * MiB;
constexpr size_t WS_WO    = 18 * MiB;
constexpr size_t WS_WGU   = 22 * MiB;
constexpr size_t WS_WD    = 54 * MiB;
constexpr size_t WS_R1    = 70 * MiB;
constexpr size_t WS_R2    = 134 * MiB;
constexpr size_t WS_R3    = 166 * MiB;
constexpr size_t WS_R4    = 198 * MiB;
constexpr size_t WS_R5    = 230 * MiB;
constexpr size_t WS_END   = 262 * MiB;
constexpr size_t WS_PROJ = WS_R1, WS_MIX = WS_R1, WS_X1B = WS_R3, WS_Y = WS_R1;
constexpr size_t WS_XB = WS_R5, WS_Q = WS_R2, WS_KR = WS_R2 + 24 * MiB, WS_RS = WS_R2 + 25 * MiB  , WS_H = WS_R2;
constexpr size_t WS_KVU = WS_R3, WS_CONCAT = WS_R4;

__device__ __forceinline__ unsigned pk2(float lo, float hi) { f32x2 v = {lo, hi}; bf16x2_t b = __builtin_convertvector(v, bf16x2_t); return __builtin_bit_cast(unsigned, b); }
__device__ __forceinline__ float bf_lo(unsigned w) { return __uint_as_float(w << 16); }
__device__ __forceinline__ float bf_hi(unsigned w) { return __uint_as_float(w & 0xffff0000u); }
__device__ __forceinline__ float bf2f(bf16_t h) { return __uint_as_float((unsigned)h << 16); }
template <int CTRL> __device__ __forceinline__ float dpp_f(float x) { return __builtin_bit_cast(float, __builtin_amdgcn_mov_dpp(__builtin_bit_cast(int, x), CTRL, 0xf, 0xf, true)); }
template <int CTRL> __device__ __forceinline__ int dpp_i(int x) { return __builtin_amdgcn_mov_dpp(x, CTRL, 0xf, 0xf, true); }
__device__ __forceinline__ float wave_sum(float v) {
    v += dpp_f<0xB1>(v); v += dpp_f<0x4E>(v); v += dpp_f<0x141>(v); v += dpp_f<0x140>(v);
    { auto s = __builtin_amdgcn_permlane16_swap(__float_as_uint(v), __float_as_uint(v), false, false); v = __uint_as_float(s[0]) + __uint_as_float(s[1]); }
    { auto t = __builtin_amdgcn_permlane32_swap(__float_as_uint(v), __float_as_uint(v), false, false); v = __uint_as_float(t[0]) + __uint_as_float(t[1]); }
    return v;
}
__device__ __forceinline__ int half32_sum(int v) {
    v += dpp_i<0xB1>(v); v += dpp_i<0x4E>(v); v += dpp_i<0x141>(v); v += dpp_i<0x140>(v);
    auto s = __builtin_amdgcn_permlane16_swap((unsigned)v, (unsigned)v, false, false); return (int)(s[0] + s[1]);
}
__device__ __forceinline__ unsigned half32_max(unsigned v) {
    v = max(v, (unsigned)dpp_i<0xB1>((int)v)); v = max(v, (unsigned)dpp_i<0x4E>((int)v)); v = max(v, (unsigned)dpp_i<0x141>((int)v)); v = max(v, (unsigned)dpp_i<0x140>((int)v));
    auto s = __builtin_amdgcn_permlane16_swap(v, v, false, false); return max(s[0], s[1]);
}
__device__ __forceinline__ float fast_exp2(float x) { return __builtin_amdgcn_exp2f(x); }

namespace pg8 {
constexpr int BM = 256, BK = 64, HALF = 128, HTB = HALF * BK * 2, NXCD = 8, WGM = 8;
__device__ __forceinline__ int lds_byte(int r, int c) { const int st = (r >> 4) * 2 + (c >> 5), rr = r & 15, cc = c & 31, ob = rr * 64 + cc * 2; return st * 1024 + (ob ^ (((ob >> 9) & 1) << 5)); }
__device__ __forceinline__ void stage_rc(int b, int& R, int& C) { const int st = b / 1024, sb = b % 1024, swz = sb ^ (((sb >> 9) & 1) << 5); R = (st >> 1) * 16 + swz / 64; C = (st & 1) * 32 + (swz % 64) / 2; }
__device__ __forceinline__ int perm32(int rho) { const int n = rho >> 4, i = rho & 15; return 8 * (i >> 2) + 4 * n + (i & 3); }

struct Unit { int pm, pn, e, nvalid; };

struct StaticOrder {
    int nM, nN, nwg, G, c, nrep;
    __device__ void init(int Mrows, int N, int G_, int c_, int nrep_ = 1) { nM = Mrows / BM; nN = N / BM; nwg = nM * nN; G = G_; c = c_; nrep = nrep_; }
    __device__ bool next(int i, Unit& u) const {
        long L = (long)i * G + c; if (c < 0 || L >= (long)nwg * nrep) return false;
        L %= nwg;
        int wgid = (int)L; { const int q = nwg / NXCD, r = nwg % NXCD, xcd = wgid % NXCD, off = wgid / NXCD; wgid = (xcd < r ? xcd * (q + 1) : r * (q + 1) + (xcd - r) * q) + off; }
        const int nig = WGM * nN, gid = wgid / nig, fm = gid * WGM, gsz = (nM - fm) < WGM ? (nM - fm) : WGM;
        u.pm = fm + ((wgid % nig) % gsz); u.pn = (wgid % nig) / gsz; u.e = 0; u.nvalid = 256; return true;
    }
};
struct DenseSched {
    static constexpr bool GATHER = false;
    const bf16_t* A; const bf16_t* Bt; int lda, K; StaticOrder so;
    __device__ __forceinline__ bool next(int i, Unit& u) const { return so.next(i, u); }
    __device__ __forceinline__ const char* a_base(const Unit& u) const { return (const char*)A + (size_t)u.pm * BM * lda * 2; }
    __device__ __forceinline__ const char* b_base(const Unit& u) const { return (const char*)Bt + (size_t)u.pn * BM * K * 2; }
    __device__ __forceinline__ unsigned a_off(const Unit&, int r) const { return (unsigned)r * (unsigned)lda * 2u; }
};
struct MoeSched {
    static constexpr bool GATHER = true;
    const bf16_t* A; const bf16_t* Bt; int lda, K; size_t b_estride; const int* elist; int rsh;
    const LAS int* tstart; const LAS int* ecnt; int G, v, nrep;
    __device__ __forceinline__ bool next(int i, Unit& u) const {
        int L = i * G + v; const int total = tstart[16] * 4; if (L >= total * nrep) return false;
        L %= total;
        const int mt = L >> 2; u.pn = L & 3; int e = 0;
#pragma unroll
        for (int k = 1; k < 16; ++k) if (mt >= tstart[k]) e = k;
        e = __builtin_amdgcn_readfirstlane(e);
        u.e = e; u.pm = __builtin_amdgcn_readfirstlane(mt - tstart[e]);
        int nv = ecnt[e] - u.pm * 256; nv = nv > 256 ? 256 : nv; u.nvalid = __builtin_amdgcn_readfirstlane(nv); return true;
    }
    __device__ __forceinline__ const char* a_base(const Unit&) const { return (const char*)A; }
    __device__ __forceinline__ const char* b_base(const Unit& u) const { return (const char*)Bt + (size_t)u.e * b_estride + (size_t)u.pn * BM * K * 2; }
    __device__ __forceinline__ int row_id(const Unit& u, int r) const { const int rr = r < u.nvalid ? r : 0; return elist[u.e * 16384 + u.pm * 256 + rr]; }
    __device__ __forceinline__ unsigned a_off(const Unit& u, int r) const { return (unsigned)(row_id(u, r) >> rsh) * (unsigned)lda * 2u; }
};

template <class Epi, class Sched>
__device__ __forceinline__ void gemm_phase(LAS unsigned char* lds, const Sched& S, const Epi& E, const int tid) {
    const int wid = __builtin_amdgcn_readfirstlane(tid >> 6), lane = tid & 63, wr = wid >> 2, wc = wid & 3, fr = lane & 15, fq = lane >> 4;
    const int K = S.K, nt = K / BK;
    int RA[2], CA[2]; unsigned voffB[2];
#pragma unroll
    for (int i = 0; i < 2; ++i) { int R, C; stage_rc(tid * 16 + i * 8192, R, C); const int Rb = Epi::PERM ? ((R & ~31) + perm32(R & 31)) : R;
        RA[i] = R; CA[i] = C; voffB[i] = (unsigned)(Rb * K + C) * 2u; }
    const size_t kstep = (size_t)(BK * 2);
    const size_t hstepB = (size_t)HALF * K * 2;
    const unsigned ldsw = (unsigned)wid * 1024u;
    const int aoff = lds_byte(wr * 64 + fr, fq * 8), boff = lds_byte(wc * 32 + fr, fq * 8);
#define PG8_SA(b, h) (((b) * 2 + (h)) * HTB)
#define PG8_SB(b, h) ((4 + (b) * 2 + (h)) * HTB)
#define PG8_STAGE2(bufoff, gbase, v0, v1) do { \
        __builtin_amdgcn_global_load_lds((const unsigned*)((const char*)(gbase) + (v0)), (LAS unsigned*)(lds + (bufoff) + ldsw), 16, 0, 0); \
        __builtin_amdgcn_global_load_lds((const unsigned*)((const char*)(gbase) + (v1)), (LAS unsigned*)(lds + (bufoff) + ldsw + 8192), 16, 0, 0); } while (0)
#define PG8_STAGEB(bufoff, gbase) PG8_STAGE2(bufoff, gbase, voffB[0], voffB[1])
#define PG8_LDA(dst, b, h) do { _Pragma("unroll") for (int m = 0; m < 4; ++m) _Pragma("unroll") for (int k = 0; k < 2; ++k) dst[m][k] = *(const LAS bf16x8*)(lds + PG8_SA(b, h) + aoff + m * 2048 + k * 1024); } while (0)
#define PG8_LDB(dst, b, h) do { _Pragma("unroll") for (int n = 0; n < 2; ++n) _Pragma("unroll") for (int k = 0; k < 2; ++k) dst[n][k] = *(const LAS bf16x8*)(lds + PG8_SB(b, h) + boff + n * 2048 + k * 1024); } while (0)
#define PG8_MMA(ai, bj, At, Bt) do { __builtin_amdgcn_s_setprio(1); _Pragma("unroll") for (int m = 0; m < 4; ++m) _Pragma("unroll") for (int n = 0; n < 2; ++n) _Pragma("unroll") for (int k = 0; k < 2; ++k) \
        acc[ai][bj][m][n] = __builtin_amdgcn_mfma_f32_16x16x32_bf16(Bt[n][k], At[m][k], acc[ai][bj][m][n], 0, 0, 0); __builtin_amdgcn_s_setprio(0); } while (0)
#define PG8_WAIT_V(n) asm volatile("s_waitcnt vmcnt(" #n ")" ::: "memory")
#define PG8_WAIT_L(n) asm volatile("s_waitcnt lgkmcnt(" #n ")" ::: "memory")
#define PG8_BAR __builtin_amdgcn_s_barrier()
#define PG8_SCHED __builtin_amdgcn_sched_barrier(0)
    Unit cur, nxt; int ui = 0;
    if (!S.next(0, cur)) return;
    f32x4 acc[2][2][4][2];
#pragma unroll
    for (int a = 0; a < 2; ++a)
#pragma unroll
        for (int b = 0; b < 2; ++b)
#pragma unroll
            for (int m = 0; m < 4; ++m)
#pragma unroll
                for (int n = 0; n < 2; ++n) acc[a][b][m][n] = (f32x4){0.f, 0.f, 0.f, 0.f};
    bf16x8 At[4][2], B0[2][2], B1[2][2];
    const char* cA = S.a_base(cur); const char* cB = S.b_base(cur);
    unsigned vc00, vc01, vc10, vc11, vn00, vn01, vn10, vn11;
    vc00 = S.a_off(cur, RA[0]) + CA[0] * 2; vc01 = S.a_off(cur, RA[1]) + CA[1] * 2; vc10 = S.a_off(cur, HALF + RA[0]) + CA[0] * 2; vc11 = S.a_off(cur, HALF + RA[1]) + CA[1] * 2;
    PG8_STAGEB(PG8_SB(0, 0), cB); PG8_STAGEB(PG8_SB(0, 1), cB + hstepB); PG8_STAGE2(PG8_SA(0, 0), cA, vc00, vc01); PG8_STAGE2(PG8_SA(0, 1), cA, vc10, vc11);
    if (wr == 1) PG8_BAR;
    PG8_WAIT_V(2); PG8_BAR;
    PG8_STAGEB(PG8_SB(1, 0), cB + kstep); PG8_STAGE2(PG8_SA(1, 0), cA + kstep, vc00, vc01); PG8_STAGEB(PG8_SB(1, 1), cB + hstepB + kstep);
    PG8_WAIT_V(6); PG8_BAR;
    for (;;) {
        const bool has_next = S.next(ui + 1, nxt);
        const char* nA = has_next ? S.a_base(nxt) : cA; const char* nB = has_next ? S.b_base(nxt) : cB;
        if (Sched::GATHER) {
            if (has_next) { vn00 = S.a_off(nxt, RA[0]) + CA[0] * 2; vn01 = S.a_off(nxt, RA[1]) + CA[1] * 2; vn10 = S.a_off(nxt, HALF + RA[0]) + CA[0] * 2; vn11 = S.a_off(nxt, HALF + RA[1]) + CA[1] * 2; }
            else { vn00 = vc00; vn01 = vc01; vn10 = vc10; vn11 = vc11; }
        } else { vn00 = vc00; vn01 = vc01; vn10 = vc10; vn11 = vc11; }
        for (int t = 0; t < nt; t += 2) {
            const bool last = (t == nt - 2);
            const char* a1 = cA + (size_t)(t + 1) * kstep;
            const char* a2 = last ? nA : cA + (size_t)(t + 2) * kstep; const char* b2 = last ? nB : cB + (size_t)(t + 2) * kstep;
            const char* a3 = a2 + kstep; const char* b3 = b2 + kstep;
            unsigned w00 = vc00, w01 = vc01, w10 = vc10, w11 = vc11;
            if (Sched::GATHER) { if (last) { w00 = vn00; w01 = vn01; w10 = vn10; w11 = vn11; } }
            PG8_LDB(B0, 0, 0); PG8_LDB(B1, 0, 1); PG8_SCHED; PG8_LDA(At, 0, 0); PG8_STAGE2(PG8_SA(1, 1), a1, vc10, vc11);
            PG8_WAIT_V(8); PG8_WAIT_L(0); PG8_BAR; PG8_MMA(0, 0, At, B0); PG8_MMA(0, 1, At, B1); PG8_BAR; PG8_SCHED;
            PG8_LDA(At, 0, 1); PG8_STAGEB(PG8_SB(0, 0), b2); PG8_STAGEB(PG8_SB(0, 1), b2 + hstepB); PG8_STAGE2(PG8_SA(0, 0), a2, w00, w01);
            PG8_WAIT_V(8); PG8_WAIT_L(0); PG8_BAR; PG8_MMA(1, 0, At, B0); PG8_MMA(1, 1, At, B1); PG8_BAR; PG8_SCHED;
            PG8_LDB(B0, 1, 0); PG8_LDB(B1, 1, 1); PG8_SCHED; PG8_LDA(At, 1, 0); PG8_STAGE2(PG8_SA(0, 1), a2, w10, w11);
            PG8_WAIT_V(8); PG8_WAIT_L(0); PG8_BAR; PG8_MMA(0, 0, At, B0); PG8_MMA(0, 1, At, B1); PG8_BAR; PG8_SCHED;
            PG8_LDA(At, 1, 1); PG8_STAGEB(PG8_SB(1, 0), b3); PG8_STAGEB(PG8_SB(1, 1), b3 + hstepB); PG8_STAGE2(PG8_SA(1, 0), a3, w00, w01);
            PG8_WAIT_V(8); PG8_WAIT_L(0); PG8_BAR; PG8_MMA(1, 0, At, B0); PG8_MMA(1, 1, At, B1); PG8_BAR; PG8_SCHED;
        }
        if (wr == 0) PG8_BAR;
        { int ln_; asm volatile("v_mbcnt_lo_u32_b32 %0, -1, 0\n\tv_mbcnt_hi_u32_b32 %0, -1, %0" : "=v"(ln_));
          E(acc, cur, S, wr, wc, ln_ & 15, ln_ >> 4); }
        if (!has_next) break;
#pragma unroll
        for (int a = 0; a < 2; ++a)
#pragma unroll
            for (int b = 0; b < 2; ++b)
#pragma unroll
                for (int m = 0; m < 4; ++m)
#pragma unroll
                    for (int n = 0; n < 2; ++n) acc[a][b][m][n] = (f32x4){0.f, 0.f, 0.f, 0.f};
        cur = nxt; cA = nA; cB = nB; ++ui; vc00 = vn00; vc01 = vn01; vc10 = vn10; vc11 = vn11;
        if (wr == 1) PG8_BAR;
    }
    PG8_WAIT_V(0);
    PG8_BAR;
#undef PG8_SA
#undef PG8_SB
#undef PG8_STAGE2
#undef PG8_STAGEB
#undef PG8_LDA
#undef PG8_LDB
#undef PG8_MMA
#undef PG8_WAIT_V
#undef PG8_WAIT_L
#undef PG8_BAR
#undef PG8_SCHED
}

#ifndef WT_STORES
#define WT_STORES 0
#endif
__device__ __forceinline__ void store16_wt(void* p, u32x4 w) {
#if WT_STORES
    asm volatile("global_store_dwordx4 %0, %1, off sc1\n\ts_nop 1" :: "v"(p), "v"(w) : "memory");
#else
    *(u32x4*)p = w;
#endif
}
__device__ __forceinline__ float xrow16_sum(float x) {
    auto s = __builtin_amdgcn_permlane16_swap(__float_as_uint(x), __float_as_uint(x), false, false); x = __uint_as_float(s[0]) + __uint_as_float(s[1]);
    auto t = __builtin_amdgcn_permlane32_swap(__float_as_uint(x), __float_as_uint(x), false, false); return __uint_as_float(t[0]) + __uint_as_float(t[1]);
}
__device__ __forceinline__ float rms_from_part(const float* part, int row, int g0, int nq, float inv_n) {
    float s = 0.f;
#pragma unroll
    for (int q = 0; q < 3; ++q) if (q < nq) { const f32x4 p = *(const f32x4*)(part + (size_t)row * 20 + g0 + 4 * q); s += (p[0] + p[1]) + (p[2] + p[3]); }
    return 1.0f / sqrtf(s * inv_n + RMS_EPS);
}
__device__ __forceinline__ void rms8_from_part(const float* part, int row0, int g0, int nq, float inv_n, float (&sc)[2][4]) {
#pragma unroll
    for (int ai = 0; ai < 2; ++ai) { f32x4 p[4][3];
#pragma unroll
        for (int m = 0; m < 4; ++m)
#pragma unroll
            for (int q = 0; q < 3; ++q) if (q < nq) p[m][q] = *(const f32x4*)(part + (size_t)(row0 + ai * HALF + m * 16) * 20 + g0 + 4 * q);
#pragma unroll
        for (int m = 0; m < 4; ++m) { float s = 0.f;
#pragma unroll
            for (int q = 0; q < 3; ++q) if (q < nq) s += (p[m][q][0] + p[m][q][1]) + (p[m][q][2] + p[m][q][3]);
            sc[ai][m] = 1.0f / sqrtf(s * inv_n + RMS_EPS); }
        asm volatile("" ::: "memory"); }
}
struct EpiBf16 {
    static constexpr bool PERM = true;
    bf16_t* O; int ldc; const float* part; int g0, nq; float inv_n;
    template <class Sched>
    __device__ __forceinline__ void operator()(const f32x4 (&acc)[2][2][4][2], const Unit& u, const Sched&, int wr, int wc, int fr, int fq) const {
        const int row0 = u.pm * BM + wr * 64 + fr; const int col0 = u.pn * BM + wc * 32 + 8 * fq;
        float scs[2][4];
        if (part) rms8_from_part(part, row0, g0, nq, inv_n, scs);
#pragma unroll
        for (int ai = 0; ai < 2; ++ai)
#pragma unroll
            for (int m = 0; m < 4; ++m) { const int row = row0 + ai * HALF + m * 16; bf16_t* rowp = O + (size_t)row * ldc + col0;
                const float sc = part ? scs[ai][m] : 1.f;
#pragma unroll
                for (int bj = 0; bj < 2; ++bj) { const f32x4 v0 = acc[ai][bj][m][0] * sc, v1 = acc[ai][bj][m][1] * sc;
                    u32x4 w; w.x = pk2(v0[0], v0[1]); w.y = pk2(v0[2], v0[3]); w.z = pk2(v1[0], v1[1]); w.w = pk2(v1[2], v1[3]);
                    store16_wt(rowp + bj * HALF, w); } }
    }
};
struct EpiProj {
    static constexpr bool PERM = true;
    bf16_t* O; int ldc; float* part; bf16_t* KR; const float* cs; const float* sn; bool wt;
    template <class Sched>
    __device__ __forceinline__ void operator()(const f32x4 (&acc)[2][2][4][2], const Unit& u, const Sched&, int wr, int wc, int fr, int fq) const {
        const int row0 = u.pm * BM + wr * 64 + fr; const int col0 = u.pn * BM + wc * 32 + 8 * fq;
#pragma unroll
        for (int ai = 0; ai < 2; ++ai)
#pragma unroll
            for (int m = 0; m < 4; ++m) { const int row = row0 + ai * HALF + m * 16; bf16_t* rowp = O + (size_t)row * ldc + col0;
#pragma unroll
                for (int bj = 0; bj < 2; ++bj) { const f32x4 v0 = acc[ai][bj][m][0], v1 = acc[ai][bj][m][1];
                    u32x4 w; w.x = pk2(v0[0], v0[1]); w.y = pk2(v0[2], v0[3]); w.z = pk2(v1[0], v1[1]); w.w = pk2(v1[2], v1[3]);
                    store16_wt(rowp + bj * HALF, w);
                    const int g = u.pn * 8 + bj * 4 + wc;
                    if (g < 20) { float ss = (v0[0] * v0[0] + v0[1] * v0[1]) + (v0[2] * v0[2] + v0[3] * v0[3]) + (v1[0] * v1[0] + v1[1] * v1[1]) + (v1[2] * v1[2] + v1[3] * v1[3]);
                        ss = xrow16_sum(ss); if (fq == 0) __hip_atomic_store(part + (size_t)row * 20 + g, ss, __ATOMIC_RELAXED, __HIP_MEMORY_SCOPE_AGENT); }
                    else if (g == 20) {
                        const int pos = row & (SEQ - 1); const int ib = 8 * (fq & 1);
                        const f32x4 c0 = *(const f32x4*)(cs + pos * 16 + ib), c1 = *(const f32x4*)(cs + pos * 16 + ib + 4), s0 = *(const f32x4*)(sn + pos * 16 + ib), s1 = *(const f32x4*)(sn + pos * 16 + ib + 4);
                        f32x4 y0, y1;
#pragma unroll
                        for (int j = 0; j < 4; ++j) {
                            auto e0 = __builtin_amdgcn_permlane32_swap(__float_as_uint(v0[j]), __float_as_uint(v0[j]), false, false); const float oth0 = __uint_as_float(fq < 2 ? e0[1] : e0[0]);
                            auto e1 = __builtin_amdgcn_permlane32_swap(__float_as_uint(v1[j]), __float_as_uint(v1[j]), false, false); const float oth1 = __uint_as_float(fq < 2 ? e1[1] : e1[0]);
                            y0[j] = fq < 2 ? v0[j] * c0[j] - oth0 * s0[j] : oth0 * s0[j] + v0[j] * c0[j];
                            y1[j] = fq < 2 ? v1[j] * c1[j] - oth1 * s1[j] : oth1 * s1[j] + v1[j] * c1[j]; }
                        u32x4 kw; kw.x = pk2(y0[0], y0[1]); kw.y = pk2(y0[2], y0[3]); kw.z = pk2(y1[0], y1[1]); kw.w = pk2(y1[2], y1[3]);
                        *(u32x4*)(KR + (size_t)row * 32 + 8 * fq) = kw; } }
                asm volatile("" ::: "memory"); }
    }
};
struct EpiQRope {
    static constexpr bool PERM = false;
    bf16_t* O; int ldc; const float* part; const float* cs; const float* sn;
    template <class Sched>
    __device__ __forceinline__ void operator()(const f32x4 (&acc)[2][2][4][2], const Unit& u, const Sched&, int wr, int wc, int fr, int fq) const {
        const int row0 = u.pm * BM + wr * 64 + fr;
        float scs[2][4]; rms8_from_part(part, row0, 0, 3, 1.f / 384.f, scs);
#pragma unroll
        for (int ai = 0; ai < 2; ++ai) {
            f32x4 cc[4], ss[4];
#pragma unroll
            for (int m = 0; m < 4; ++m) { const int pos = (row0 + ai * HALF + m * 16) & (SEQ - 1); cc[m] = *(const f32x4*)(cs + pos * 16 + 4 * fq); ss[m] = *(const f32x4*)(sn + pos * 16 + 4 * fq); }
#pragma unroll
            for (int m = 0; m < 4; ++m) { const int row = row0 + ai * HALF + m * 16; const float sc = scs[ai][m];
                const f32x4 c4 = cc[m], s4 = ss[m];
#pragma unroll
                for (int bj = 0; bj < 2; ++bj) { const int colg = u.pn * BM + bj * HALF + wc * 32;
                    f32x4 x1 = acc[ai][bj][m][0] * sc, x2 = acc[ai][bj][m][1] * sc;
                    if (((colg >> 5) % 3) == 2) { const f32x4 y1 = x1 * c4 - x2 * s4, y2 = x1 * s4 + x2 * c4; x1 = y1; x2 = y2; }
                    bf16_t* p = O + (size_t)row * ldc + colg + 4 * fq;
                    u32x2 w1, w2; w1.x = pk2(x1[0], x1[1]); w1.y = pk2(x1[2], x1[3]); w2.x = pk2(x2[0], x2[1]); w2.y = pk2(x2[2], x2[3]);
                    *(u32x2*)p = w1; *(u32x2*)(p + 16) = w2; } }
            asm volatile("" ::: "memory"); }
    }
};
struct EpiMoe1 {
    static constexpr bool PERM = true;
    bf16_t* H; const float* gatew;
    template <class Sched>
    __device__ __forceinline__ void operator()(const f32x4 (&acc)[2][2][4][2], const Unit& u, const Sched& S, int wr, int wc, int fr, int fq) const {
        int pr[2][4]; float gws[2][4];
#pragma unroll
        for (int ai = 0; ai < 2; ++ai)
#pragma unroll
            for (int m = 0; m < 4; ++m) { const int r = ai * HALF + wr * 64 + m * 16 + fr; pr[ai][m] = S.elist[u.e * 16384 + u.pm * 256 + (r < u.nvalid ? r : 0)]; }
#pragma unroll
        for (int ai = 0; ai < 2; ++ai)
#pragma unroll
            for (int m = 0; m < 4; ++m) gws[ai][m] = gatew[pr[ai][m]];
#pragma unroll
        for (int ai = 0; ai < 2; ++ai)
#pragma unroll
            for (int m = 0; m < 4; ++m) { const int r = ai * HALF + wr * 64 + m * 16 + fr;
                if (r < u.nvalid) { const int pair = pr[ai][m]; const float gw = gws[ai][m];
#pragma unroll
                    for (int bj = 0; bj < 2; ++bj) { const f32x4 g = acc[ai][bj][m][0], up = acc[ai][bj][m][1]; f32x4 a;
#pragma unroll
                        for (int j = 0; j < 4; ++j) { const float sg = g[j] / (1.f + __expf(-g[j])); a[j] = sg * up[j] * gw; }
                        const int f = u.pn * 128 + bj * 64 + wc * 16 + fq * 4;
                        u32x2 w; w.x = pk2(a[0], a[1]); w.y = pk2(a[2], a[3]);
                        __hip_atomic_store((unsigned long long*)(H + (size_t)pair * DFF + f), (unsigned long long)w.x | ((unsigned long long)w.y << 32), __ATOMIC_RELAXED, __HIP_MEMORY_SCOPE_AGENT); } } }
    }
};
struct EpiMoe2 {
    static constexpr bool PERM = true;
    bf16_t* Y;
    template <class Sched>
    __device__ __forceinline__ void operator()(const f32x4 (&acc)[2][2][4][2], const Unit& u, const Sched& S, int wr, int wc, int fr, int fq) const {
        const int col0 = u.pn * BM + wc * 32 + 8 * fq;
        int pr[2][4];
#pragma unroll
        for (int ai = 0; ai < 2; ++ai)
#pragma unroll
            for (int m = 0; m < 4; ++m) { const int r = ai * HALF + wr * 64 + m * 16 + fr; pr[ai][m] = S.elist[u.e * 16384 + u.pm * 256 + (r < u.nvalid ? r : 0)]; }
#pragma unroll
        for (int ai = 0; ai < 2; ++ai)
#pragma unroll
            for (int m = 0; m < 4; ++m) { const int r = ai * HALF + wr * 64 + m * 16 + fr;
                if (r < u.nvalid) { bf16_t* rowp = Y + (size_t)pr[ai][m] * DM + col0;
#pragma unroll
                    for (int bj = 0; bj < 2; ++bj) { const f32x4 v0 = acc[ai][bj][m][0], v1 = acc[ai][bj][m][1];
                        u32x4 w; w.x = pk2(v0[0], v0[1]); w.y = pk2(v0[2], v0[3]); w.z = pk2(v1[0], v1[1]); w.w = pk2(v1[2], v1[3]);
                        store16_wt(rowp + bj * HALF, w); } } }
    }
};

struct Unit2 : Unit { int kind, mt; };
struct Moe12Sched {
    const bf16_t* X1B; const bf16_t* H; const bf16_t* WGU; const bf16_t* WD; const int* elist; const LAS int* tstart; const LAS int* ecnt; unsigned* ready; int G, v;
    __device__ __forceinline__ bool next(int i, Unit2& u) const {
        const int T4 = tstart[16] * 4; const int q1 = T4 / G, rem = T4 - q1 * G; const int g1 = q1 + (v < rem ? 1 : 0);
        int L, kind;
        if (i < g1) { L = v + i * G; kind = 0; }
        else { if (rem > 0 && v < rem) return false; const int nl = G - rem; const int p = (v - rem) + nl * (i - g1); if (p >= T4) return false; L = p; kind = 1; }
        const int mt = L >> 2; u.pn = L & 3; int e = 0;
#pragma unroll
        for (int k = 1; k < 16; ++k) if (mt >= tstart[k]) e = k;
        e = __builtin_amdgcn_readfirstlane(e);
        u.e = e; u.pm = __builtin_amdgcn_readfirstlane(mt - tstart[e]); u.mt = __builtin_amdgcn_readfirstlane(mt); u.kind = __builtin_amdgcn_readfirstlane(kind);
        int nv = ecnt[e] - u.pm * 256; nv = nv > 256 ? 256 : nv; u.nvalid = __builtin_amdgcn_readfirstlane(nv); return true;
    }
    __device__ __forceinline__ int kdim(const Unit2& u) const { return u.kind ? DFF : DM; }
    __device__ __forceinline__ bool perm(const Unit2&) const { return true; }
    __device__ __forceinline__ int epi(const Unit2& u) const { return u.kind; }
    __device__ __forceinline__ const char* a_base(const Unit2& u) const { return u.kind ? (const char*)H : (const char*)X1B; }
    __device__ __forceinline__ const char* b_base(const Unit2& u) const { return u.kind ? (const char*)WD + (size_t)u.e * (DM * DFF * 2) + (size_t)u.pn * (BM * DFF * 2) : (const char*)WGU + (size_t)u.e * (DM * DM * 2) + (size_t)u.pn * (BM * DM * 2); }
    __device__ __forceinline__ int row_id(const Unit& u, int r) const { const int rr = r < u.nvalid ? r : 0; return elist[u.e * 16384 + u.pm * 256 + rr]; }
    __device__ __forceinline__ unsigned a_off(const Unit2& u, int r) const { const int id = row_id(u, r); return u.kind ? (unsigned)id * (unsigned)(DFF * 2) : (unsigned)(id >> 1) * (unsigned)(DM * 2); }
    __device__ __forceinline__ void a_ready(const Unit2& u, int tid) const {
        if (u.kind) {
            if (tid < 64) { unsigned sp = 0;
                while ((unsigned)__builtin_amdgcn_readfirstlane(__hip_atomic_load(ready + u.mt, __ATOMIC_RELAXED, __HIP_MEMORY_SCOPE_AGENT)) < 32u) { __builtin_amdgcn_s_sleep(2); if (++sp > (1u << 22)) break; }
                __builtin_amdgcn_fence(__ATOMIC_ACQUIRE, "agent");
                asm volatile("s_waitcnt vmcnt(0)" ::: "memory"); }
            asm volatile("" ::: "memory"); __builtin_amdgcn_s_barrier(); asm volatile("" ::: "memory");
        }
    }
    __device__ __forceinline__ void done(const Unit2& u, int lane) const {
        if (!u.kind) { asm volatile("s_waitcnt vmcnt(0)" ::: "memory"); if (lane == 0) __hip_atomic_fetch_add(ready + u.mt, 1u, __ATOMIC_RELAXED, __HIP_MEMORY_SCOPE_AGENT); }
    }
};


struct ProjSched {
    const bf16_t* XB; const bf16_t* PROJ; const bf16_t* WIN; const bf16_t* WQUP; const bf16_t* WKV; unsigned* c01; unsigned* c12; int G, v;
    __device__ __forceinline__ bool next(int i, Unit2& u) const {
        const int g0 = v < 192 ? 2 : 1; int kind, pm, pn;
        if (i < g0) { const int L = v + i * G; kind = 0; pm = L & 63; pn = L >> 6; }
        else { const int j = i - g0;
            if (v < 192) { if (j >= 1) return false; kind = 2; pm = v >> 2; pn = v & 3; }
            else { const int w = v - 192; if (j < 3) { kind = 1; pm = w; pn = j; } else if (j == 3) { kind = 2; pm = 48 + (w >> 2); pn = w & 3; } else return false; } }
        u.kind = __builtin_amdgcn_readfirstlane(kind); u.pm = __builtin_amdgcn_readfirstlane(pm); u.pn = __builtin_amdgcn_readfirstlane(pn); u.e = 0; u.nvalid = 256; u.mt = u.pm; return true;
    }
    __device__ __forceinline__ int kdim(const Unit2& u) const { return u.kind == 0 ? DM : (u.kind == 1 ? 384 : 256); }
    __device__ __forceinline__ bool perm(const Unit2& u) const { return u.kind != 1; }
    __device__ __forceinline__ int epi(const Unit2& u) const { return u.kind; }
    __device__ __forceinline__ const char* a_base(const Unit2& u) const {
        return u.kind == 0 ? (const char*)XB + (size_t)u.pm * (BM * DM * 2) : (const char*)PROJ + (size_t)u.pm * (BM * NPROJ * 2) + (u.kind == 1 ? C_QA * 2 : C_KVA * 2); }
    __device__ __forceinline__ const char* b_base(const Unit2& u) const {
        return u.kind == 0 ? (const char*)WIN + (size_t)u.pn * (BM * DM * 2) : (u.kind == 1 ? (const char*)WQUP + (size_t)u.pn * (BM * 384 * 2) : (const char*)WKV + (size_t)u.pn * (BM * 256 * 2)); }
    __device__ __forceinline__ unsigned a_off(const Unit2& u, int r) const { return (unsigned)r * (u.kind == 0 ? (unsigned)(DM * 2) : (unsigned)(NPROJ * 2)); }
    __device__ __forceinline__ void a_ready(const Unit2& u, int tid) const {
        if (u.kind) {
            if (tid < 64) { unsigned* c = (u.kind == 1 ? c01 : c12) + u.pm; unsigned sp = 0;
                while ((unsigned)__builtin_amdgcn_readfirstlane(__hip_atomic_load(c, __ATOMIC_RELAXED, __HIP_MEMORY_SCOPE_AGENT)) < 16u) { __builtin_amdgcn_s_sleep(2); if (++sp > (1u << 22)) break; }
                __builtin_amdgcn_fence(__ATOMIC_ACQUIRE, "agent");
                asm volatile("s_waitcnt vmcnt(0)" ::: "memory"); }
            asm volatile("" ::: "memory"); __builtin_amdgcn_s_barrier(); asm volatile("" ::: "memory");
        }
    }
    __device__ __forceinline__ void done(const Unit2& u, int lane) const {
        if (u.kind == 0 && u.pn <= 2) { asm volatile("s_waitcnt vmcnt(0)" ::: "memory");
            if (lane == 0) { if (u.pn <= 1) __hip_atomic_fetch_add(c01 + u.pm, 1u, __ATOMIC_RELAXED, __HIP_MEMORY_SCOPE_AGENT); if (u.pn >= 1) __hip_atomic_fetch_add(c12 + u.pm, 1u, __ATOMIC_RELAXED, __HIP_MEMORY_SCOPE_AGENT); } }
    }
};

template <class SchedT, class E0T, class E1T, class E2T>
__device__ __forceinline__ void gemm_stream(LAS unsigned char* lds, const SchedT& S, const E0T& E0, const E1T& E1, const E2T& E2, const int tid) {
    const int wid = __builtin_amdgcn_readfirstlane(tid >> 6), lane = tid & 63, wr = wid >> 2, wc = wid & 3, fr = lane & 15, fq = lane >> 4;
#define PG8_GEOM() int RA[2], CA[2], RB[2]; { int tq_ = tid; asm volatile("" : "+v"(tq_)); _Pragma("unroll") for (int i = 0; i < 2; ++i) { int R, C; stage_rc(tq_ * 16 + i * 8192, R, C); RA[i] = R; CA[i] = C; RB[i] = (R & ~31) + perm32(R & 31); } }
    const size_t kstep = (size_t)(BK * 2);
    const unsigned ldsw = (unsigned)wid * 1024u;
    const int aoff = lds_byte(wr * 64 + fr, fq * 8), boff = lds_byte(wc * 32 + fr, fq * 8);
#define PG8_SA(b, h) (((b) * 2 + (h)) * HTB)
#define PG8_SB(b, h) ((4 + (b) * 2 + (h)) * HTB)
#define PG8_STAGE2(bufoff, gbase, v0, v1) do { \
        __builtin_amdgcn_global_load_lds((const unsigned*)((const char*)(gbase) + (v0)), (LAS unsigned*)(lds + (bufoff) + ldsw), 16, 0, 0); \
        __builtin_amdgcn_global_load_lds((const unsigned*)((const char*)(gbase) + (v1)), (LAS unsigned*)(lds + (bufoff) + ldsw + 8192), 16, 0, 0); } while (0)
#define PG8_LDA(dst, b, h) do { _Pragma("unroll") for (int m = 0; m < 4; ++m) _Pragma("unroll") for (int k = 0; k < 2; ++k) dst[m][k] = *(const LAS bf16x8*)(lds + PG8_SA(b, h) + aoff + m * 2048 + k * 1024); } while (0)
#define PG8_LDB(dst, b, h) do { _Pragma("unroll") for (int n = 0; n < 2; ++n) _Pragma("unroll") for (int k = 0; k < 2; ++k) dst[n][k] = *(const LAS bf16x8*)(lds + PG8_SB(b, h) + boff + n * 2048 + k * 1024); } while (0)
#define PG8_MMA(ai, bj, At, Bt) do { __builtin_amdgcn_s_setprio(1); _Pragma("unroll") for (int m = 0; m < 4; ++m) _Pragma("unroll") for (int n = 0; n < 2; ++n) _Pragma("unroll") for (int k = 0; k < 2; ++k) \
        acc[ai][bj][m][n] = __builtin_amdgcn_mfma_f32_16x16x32_bf16(Bt[n][k], At[m][k], acc[ai][bj][m][n], 0, 0, 0); __builtin_amdgcn_s_setprio(0); } while (0)
#define PG8_WAIT_V(n) asm volatile("s_waitcnt vmcnt(" #n ")" ::: "memory")
#define PG8_WAIT_L(n) asm volatile("s_waitcnt lgkmcnt(" #n ")" ::: "memory")
#define PG8_BAR __builtin_amdgcn_s_barrier()
#define PG8_SCHED __builtin_amdgcn_sched_barrier(0)
    Unit2 cur, nxt; int ui = 0;
    if (!S.next(0, cur)) return;
    f32x4 acc[2][2][4][2];
#pragma unroll
    for (int a = 0; a < 2; ++a)
#pragma unroll
        for (int b = 0; b < 2; ++b)
#pragma unroll
            for (int m = 0; m < 4; ++m)
#pragma unroll
                for (int n = 0; n < 2; ++n) acc[a][b][m][n] = (f32x4){0.f, 0.f, 0.f, 0.f};
    bf16x8 At[4][2], B0[2][2], B1[2][2];
    const char* cA = S.a_base(cur); const char* cB = S.b_base(cur);
    int Kc = S.kdim(cur); int ntc = Kc / BK; size_t hbc = (size_t)HALF * Kc * 2;
    unsigned bc0, bc1, bn0, bn1, vc00, vc01, vc10, vc11, vn00, vn01, vn10, vn11;
    { PG8_GEOM();
      bc0 = (unsigned)((S.perm(cur) ? RB[0] : RA[0]) * Kc + CA[0]) * 2u; bc1 = (unsigned)((S.perm(cur) ? RB[1] : RA[1]) * Kc + CA[1]) * 2u;
      vc00 = S.a_off(cur, RA[0]) + CA[0] * 2; vc01 = S.a_off(cur, RA[1]) + CA[1] * 2; vc10 = S.a_off(cur, HALF + RA[0]) + CA[0] * 2; vc11 = S.a_off(cur, HALF + RA[1]) + CA[1] * 2; }
    S.a_ready(cur, tid);
    PG8_STAGE2(PG8_SB(0, 0), cB, bc0, bc1); PG8_STAGE2(PG8_SB(0, 1), cB + hbc, bc0, bc1); PG8_STAGE2(PG8_SA(0, 0), cA, vc00, vc01); PG8_STAGE2(PG8_SA(0, 1), cA, vc10, vc11);
    if (wr == 1) PG8_BAR;
    PG8_WAIT_V(2); PG8_BAR;
    PG8_STAGE2(PG8_SB(1, 0), cB + kstep, bc0, bc1); PG8_STAGE2(PG8_SA(1, 0), cA + kstep, vc00, vc01); PG8_STAGE2(PG8_SB(1, 1), cB + hbc + kstep, bc0, bc1);
    PG8_WAIT_V(6); PG8_BAR;
    for (;;) {
        const bool has_next = S.next(ui + 1, nxt);
        const char* nA = cA; const char* nB = cB; int Kn = Kc; size_t hbn = hbc;
        bn0 = bc0; bn1 = bc1; vn00 = vc00; vn01 = vc01; vn10 = vc10; vn11 = vc11;
        if (has_next) { nA = S.a_base(nxt); nB = S.b_base(nxt); Kn = S.kdim(nxt); hbn = (size_t)HALF * Kn * 2; PG8_GEOM();
            bn0 = (unsigned)((S.perm(nxt) ? RB[0] : RA[0]) * Kn + CA[0]) * 2u; bn1 = (unsigned)((S.perm(nxt) ? RB[1] : RA[1]) * Kn + CA[1]) * 2u;
            vn00 = S.a_off(nxt, RA[0]) + CA[0] * 2; vn01 = S.a_off(nxt, RA[1]) + CA[1] * 2; vn10 = S.a_off(nxt, HALF + RA[0]) + CA[0] * 2; vn11 = S.a_off(nxt, HALF + RA[1]) + CA[1] * 2; }
        for (int t = 0; t < ntc; t += 2) {
            const bool last = (t == ntc - 2);
            if (last && has_next) S.a_ready(nxt, tid);
            const char* a1 = cA + (size_t)(t + 1) * kstep;
            const char* a2 = last ? nA : cA + (size_t)(t + 2) * kstep; const char* b2 = last ? nB : cB + (size_t)(t + 2) * kstep;
            const char* a3 = a2 + kstep; const char* b3 = b2 + kstep;
            unsigned w00 = vc00, w01 = vc01, w10 = vc10, w11 = vc11, x0 = bc0, x1 = bc1; size_t hb = hbc;
            if (last) { w00 = vn00; w01 = vn01; w10 = vn10; w11 = vn11; x0 = bn0; x1 = bn1; hb = hbn; }
            PG8_LDB(B0, 0, 0); PG8_LDB(B1, 0, 1); PG8_SCHED; PG8_LDA(At, 0, 0); PG8_STAGE2(PG8_SA(1, 1), a1, vc10, vc11);
            PG8_WAIT_V(8); PG8_WAIT_L(0); PG8_BAR; PG8_MMA(0, 0, At, B0); PG8_MMA(0, 1, At, B1); PG8_BAR; PG8_SCHED;
            PG8_LDA(At, 0, 1); PG8_STAGE2(PG8_SB(0, 0), b2, x0, x1); PG8_STAGE2(PG8_SB(0, 1), b2 + hb, x0, x1); PG8_STAGE2(PG8_SA(0, 0), a2, w00, w01);
            PG8_WAIT_V(8); PG8_WAIT_L(0); PG8_BAR; PG8_MMA(1, 0, At, B0); PG8_MMA(1, 1, At, B1); PG8_BAR; PG8_SCHED;
            PG8_LDB(B0, 1, 0); PG8_LDB(B1, 1, 1); PG8_SCHED; PG8_LDA(At, 1, 0); PG8_STAGE2(PG8_SA(0, 1), a2, w10, w11);
            PG8_WAIT_V(8); PG8_WAIT_L(0); PG8_BAR; PG8_MMA(0, 0, At, B0); PG8_MMA(0, 1, At, B1); PG8_BAR; PG8_SCHED;
            PG8_LDA(At, 1, 1); PG8_STAGE2(PG8_SB(1, 0), b3, x0, x1); PG8_STAGE2(PG8_SB(1, 1), b3 + hb, x0, x1); PG8_STAGE2(PG8_SA(1, 0), a3, w00, w01);
            PG8_WAIT_V(8); PG8_WAIT_L(0); PG8_BAR; PG8_MMA(1, 0, At, B0); PG8_MMA(1, 1, At, B1); PG8_BAR; PG8_SCHED;
        }
        if (wr == 0) PG8_BAR;
        { int ln_; asm volatile("v_mbcnt_lo_u32_b32 %0, -1, 0\n\tv_mbcnt_hi_u32_b32 %0, -1, %0" : "=v"(ln_));
          const int ek = S.epi(cur);
          if (ek == 0) E0(acc, cur, S, wr, wc, ln_ & 15, ln_ >> 4); else if (ek == 1) E1(acc, cur, S, wr, wc, ln_ & 15, ln_ >> 4); else E2(acc, cur, S, wr, wc, ln_ & 15, ln_ >> 4);
          S.done(cur, ln_); }
        if (!has_next) break;
#pragma unroll
        for (int a = 0; a < 2; ++a)
#pragma unroll
            for (int b = 0; b < 2; ++b)
#pragma unroll
                for (int m = 0; m < 4; ++m)
#pragma unroll
                    for (int n = 0; n < 2; ++n) acc[a][b][m][n] = (f32x4){0.f, 0.f, 0.f, 0.f};
        cur = nxt; cA = nA; cB = nB; ++ui; vc00 = vn00; vc01 = vn01; vc10 = vn10; vc11 = vn11; bc0 = bn0; bc1 = bn1; Kc = Kn; ntc = Kc / BK; hbc = hbn;
        if (wr == 1) PG8_BAR;
    }
    PG8_WAIT_V(0);
    PG8_BAR;
#undef PG8_GEOM
#undef PG8_SA
#undef PG8_SB
#undef PG8_STAGE2
#undef PG8_LDA
#undef PG8_LDB
#undef PG8_MMA
#undef PG8_WAIT_V
#undef PG8_WAIT_L
#undef PG8_BAR
#undef PG8_SCHED
}
}


struct Args {
    const float* x; const float* w_in; const float* q_norm_g; const float* w_q_up; const float* kv_norm_g; const float* w_uk; const float* w_uv; const float* w_o;
    const float* ln1_g; const float* ln1_b; const float* router_w; const float* router_bias; const float* w_gate; const float* w_up; const float* w_down;
    const float* ln2_g; const float* ln2_b;
    float* out; unsigned char* ws; int ph_lo, ph_hi, dup_mask, pad;
};

__device__ __forceinline__ void conv_item(const float* srcp, int ldw, float cs, const float* kscale, bf16_t* dst, int Kdst, LAS float* scr, int lane) {
    const int kr = lane >> 4, j = lane & 15;
    f32x4 v[8];
#pragma unroll
    for (int i = 0; i < 8; ++i) v[i] = srcp ? *(const f32x4*)(srcp + (size_t)(kr + 4 * i) * ldw) : (f32x4){0.f, 0.f, 0.f, 0.f};
#pragma unroll
    for (int i = 0; i < 8; ++i) { const int k = kr + 4 * i; const float ks = kscale ? kscale[k] * cs : cs; LAS float* p = scr + k * 65 + 4 * j;
        p[0] = v[i][0] * ks; p[1] = v[i][1] * ks; p[2] = v[i][2] * ks; p[3] = v[i][3] * ks; }
    asm volatile("s_waitcnt lgkmcnt(0)" ::: "memory");
    const int kc = lane & 3;
#pragma unroll
    for (int q = 0; q < 4; ++q) { const int n = (lane >> 2) + 16 * q; const LAS float* sp = scr + (8 * kc) * 65 + n;
        u32x4 o; o.x = pk2(sp[0 * 65], sp[1 * 65]); o.y = pk2(sp[2 * 65], sp[3 * 65]); o.z = pk2(sp[4 * 65], sp[5 * 65]); o.w = pk2(sp[6 * 65], sp[7 * 65]);
        *(u32x4*)(dst + (size_t)n * Kdst + 8 * kc) = o; }
    asm volatile("s_waitcnt lgkmcnt(0)" ::: "memory");
}

__device__ __forceinline__ void p0_small_weights(const Args& a, LAS float* scr, int gw, int NGW, int lane) {
    unsigned char* ws = a.ws;
    constexpr int I_IN = 28 * 32, I_QUP = 12 * 12, I_KV = 16 * 8, I_O = 16 * 32, I_L = I_IN + I_QUP + I_KV + I_O;
    const int j4 = (lane & 15) * 4;
    for (int it = gw; it < DEPTH * I_L; it += NGW) {
        const int l = it / I_L; int r = it % I_L;
        if (r < I_IN) { const int kb = r / 28, nb = r % 28, n = nb * 64 + j4, k0 = kb * 32;
            const float* sp = n < IN_COLS ? a.w_in + (size_t)l * DM * IN_COLS + (size_t)k0 * IN_COLS + n : nullptr;
            const float cs = (n >= C_DQ && n < C_DK) ? DSA_QSCALE : 1.f;
            conv_item(sp, IN_COLS, cs, nullptr, (bf16_t*)(ws + WS_WIN) + (size_t)l * NPROJ * DM + (size_t)(nb * 64) * DM + k0, DM, scr, lane); continue; }
        r -= I_IN;
        if (r < I_QUP) { const int kb = r / 12, nb = r % 12, n = nb * 64 + j4, k0 = kb * 32;
            conv_item(a.w_q_up + (size_t)l * 384 * 768 + (size_t)k0 * 768 + n, 768, MLA_QSCALE, a.q_norm_g + l * 384 + k0, (bf16_t*)(ws + WS_WQUP) + (size_t)l * 768 * 384 + (size_t)(nb * 64) * 384 + k0, 384, scr, lane); continue; }
        r -= I_QUP;
        if (r < I_KV) { const int kb = r / 16, nb = r % 16, n = nb * 64 + j4, k0 = kb * 32;
            const float* sp = n < 512 ? a.w_uk + (size_t)l * 256 * 512 + (size_t)k0 * 512 + n : a.w_uv + (size_t)l * 256 * 512 + (size_t)k0 * 512 + (n - 512);
            conv_item(sp, 512, 1.f, a.kv_norm_g + l * 256 + k0, (bf16_t*)(ws + WS_WKV) + (size_t)l * 1024 * 256 + (size_t)(nb * 64) * 256 + k0, 256, scr, lane); continue; }
        r -= I_KV;
        { const int kb = r / 16, nb = r % 16, n = nb * 64 + j4, k0 = kb * 32;
            conv_item(a.w_o + (size_t)l * DM * DM + (size_t)k0 * DM + n, DM, 1.f, nullptr, (bf16_t*)(ws + WS_WO) + (size_t)l * DM * DM + (size_t)(nb * 64) * DM + k0, DM, scr, lane); }
    }
}
__device__ __forceinline__ void p0_expert_weights(const Args& a, int l, LAS float* scr, int gw, int NGW, int lane) {
    unsigned char* ws = a.ws;
    constexpr int I_GU = 16 * 32 * 16, I_D = 16 * 16 * 16;
    const int j4 = (lane & 15) * 4;
    for (int it = gw; it < I_GU + I_D; it += NGW) {
        int r = it;
        if (r < I_GU) { const int e = r / 512, rr = r % 512, kb = rr / 16, nb = rr % 16, c0 = nb * 64 + j4, k0 = kb * 32;
            const int f = 4 * (c0 >> 3); const float* W = (c0 & 4) ? a.w_up : a.w_gate;
            conv_item(W + ((size_t)(l * NEXP + e) * DM + k0) * DFF + f, DFF, 1.f, nullptr, (bf16_t*)(ws + WS_WGU) + (size_t)e * DM * DM + (size_t)(nb * 64) * DM + k0, DM, scr, lane); continue; }
        r -= I_GU;
        { const int e = r / 256, rr = r % 256, kb = rr / 16, nb = rr % 16, n = nb * 64 + j4, k0 = kb * 32;
            conv_item(a.w_down + ((size_t)(l * NEXP + e) * DFF + k0) * DM + n, DM, 1.f, nullptr, (bf16_t*)(ws + WS_WD) + (size_t)e * DM * DFF + (size_t)(nb * 64) * DFF + k0, DFF, scr, lane); }
    }
}
__device__ __forceinline__ void p0_misc(const Args& a, int gw, int NGW, int lane) {
    unsigned char* ws = a.ws;
    for (int m = gw; m < M; m += NGW) { const f32x4* xr = (const f32x4*)(a.x + (size_t)m * DM) + lane; u32x2* o = (u32x2*)((bf16_t*)(ws + WS_XB) + (size_t)m * DM) + lane;
#pragma unroll
        for (int j = 0; j < 4; ++j) { const f32x4 v = xr[64 * j]; u32x2 w; w.x = pk2(v[0], v[1]); w.y = pk2(v[2], v[3]); o[64 * j] = w; } }
    float* cs = (float*)(ws + WS_ROPE); float* sn = cs + SEQ * 16;
    for (int i = gw * 64 + lane; i < SEQ * 16; i += NGW * 64) { const int pos = i >> 4, k = i & 15; const float inv = powf(10000.0f, -(float)k / 16.0f); const float ang = (float)pos * inv; cs[i] = cosf(ang); sn[i] = sinf(ang); }
    if (gw == 0) for (int i = lane; i < 1024; i += 64) ((int*)(ws + WS_CTL))[i] = 0;
}

__device__ __forceinline__ void p1b_token_stats(const Args& a, int gw, int NGW, int lane) {
    unsigned char* ws = a.ws; const bf16_t* PROJ = (const bf16_t*)(ws + WS_PROJ); float* RS = (float*)(ws + WS_RS); bf16_t* KR = (bf16_t*)(ws + WS_KR);
    const float* cs = (const float*)(ws + WS_ROPE); const float* sn = cs + SEQ * 16;
    for (int m = gw; m < M; m += NGW) {
        const bf16_t* row = PROJ + (size_t)m * NPROJ;
        float sq = 0.f, sk = 0.f;
        if (lane < 48) { const u32x4 w = *(const u32x4*)(row + C_QA + lane * 8);
#pragma unroll
            for (int j = 0; j < 4; ++j) { const float lo = bf_lo(w[j]), hi = bf_hi(w[j]); sq += lo * lo + hi * hi; } }
        if (lane < 32) { const u32x4 w = *(const u32x4*)(row + C_KVA + lane * 8);
#pragma unroll
            for (int j = 0; j < 4; ++j) { const float lo = bf_lo(w[j]), hi = bf_hi(w[j]); sk += lo * lo + hi * hi; } }
        sq = wave_sum(sq); sk = wave_sum(sk);
        if (lane == 0) { RS[(size_t)m * 2] = 1.0f / sqrtf(sq * (1.f / 384.f) + RMS_EPS); RS[(size_t)m * 2 + 1] = 1.0f / sqrtf(sk * (1.f / 256.f) + RMS_EPS); }
        if (lane < 16) { const int pos = m & (SEQ - 1); const float x1 = bf2f(row[C_KR + lane]), x2 = bf2f(row[C_KR + 16 + lane]); const float c = cs[pos * 16 + lane], s = sn[pos * 16 + lane];
            const unsigned y1 = pk2(x1 * c - x2 * s, 0.f) & 0xffffu, y2 = pk2(x1 * s + x2 * c, 0.f) & 0xffffu;
            KR[(size_t)m * 32 + lane] = (bf16_t)y1; KR[(size_t)m * 32 + 16 + lane] = (bf16_t)y2; }
    }
}

__device__ __forceinline__ float max3f(float a, float b, float c) { float r; asm("v_max3_f32 %0, %1, %2, %3" : "=v"(r) : "v"(a), "v"(b), "v"(c)); return r; }
__device__ __forceinline__ int crow(int r, int hi) { return (r & 3) + 8 * (r >> 2) + 4 * hi; }
__device__ __forceinline__ s16x4 vtr(const LAS unsigned char* p) { typedef short v4i16_t __attribute__((ext_vector_type(4))); return __builtin_bit_cast(s16x4, __builtin_amdgcn_ds_read_tr16_b64_v4i16((LAS v4i16_t*)p)); }

template <bool DSA>
__device__ __forceinline__ void attn_qk(LAS unsigned char* lds, const int bo, const int t, const bf16x8 (&qf)[DSA ? 4 : 6], f32x16& p0, f32x16& p1,
                                        const int q0, const int lane, const float sl2, const float (&slc)[16], const LAS unsigned char* mrow) {
    constexpr int DQK = DSA ? 64 : 96;
    const int r32 = lane & 31, hi = lane >> 5;
    if (DSA) { const float b0 = -sl2 * (float)(q0 + r32 - 64 * t - 4 * hi);
#pragma unroll
        for (int r = 0; r < 16; ++r) { p0[r] = b0 + slc[r]; p1[r] = p0[r] + 32.f * sl2; } }
    else { p0 = f32x16{}; p1 = f32x16{}; }
    constexpr int KP = DQK * 2 + 16;
    const LAS unsigned char* kb = lds + bo + r32 * KP + hi * 16;
    bf16x8 kf0[DQK / 16], kf1[DQK / 16];
#pragma unroll
    for (int d0 = 0; d0 < DQK / 16; ++d0) { kf0[d0] = *(const LAS bf16x8*)(kb + d0 * 32); kf1[d0] = *(const LAS bf16x8*)(kb + d0 * 32 + 32 * KP); }
    __builtin_amdgcn_s_setprio(1);
#pragma unroll
    for (int d0 = 0; d0 < DQK / 16; ++d0) { p0 = __builtin_amdgcn_mfma_f32_32x32x16_bf16(kf0[d0], qf[d0], p0, 0, 0, 0); p1 = __builtin_amdgcn_mfma_f32_32x32x16_bf16(kf1[d0], qf[d0], p1, 0, 0, 0); }
    __builtin_amdgcn_s_setprio(0);
    if (DSA) { const u32x2 mw = *(const LAS u32x2*)(mrow + 8 * t); const unsigned w0 = mw.x >> (4 * hi), w1 = mw.y >> (4 * hi);
#pragma unroll
        for (int r = 0; r < 16; ++r) { const unsigned bit = 1u << ((r & 3) + 8 * (r >> 2)); if (!(w0 & bit)) p0[r] = -INFINITY; if (!(w1 & bit)) p1[r] = -INFINITY; } }
    else if (64 * t + 63 > q0) { const int qa = q0 + r32, kbase = 64 * t + 4 * hi;
#pragma unroll
        for (int r = 0; r < 16; ++r) { const int kv = kbase + (r & 3) + 8 * (r >> 2); if (kv > qa) p0[r] = -INFINITY; if (kv + 32 > qa) p1[r] = -INFINITY; } }
}
template <bool DSA>
__device__ __forceinline__ void attn_sm_pv(LAS unsigned char* lds, const int bo, f32x16& p0, f32x16& p1, f32x16 (&o)[2], float& mrun, float& lrun, const int lane, LAS float* wsf) {
    constexpr int DQK = DSA ? 64 : 96, KBYTES = 64 * (DQK * 2 + 16);
    const int r32 = lane & 31, hi = lane >> 5;
    float mx = max3f(p0[0], p1[0], p0[1]), mx2 = max3f(p1[1], p0[2], p1[2]);
#pragma unroll
    for (int r = 3; r < 15; r += 2) { mx = max3f(mx, p0[r], p1[r]); mx2 = max3f(mx2, p0[r + 1], p1[r + 1]); }
    mx = max3f(mx, mx2, fmaxf(p0[15], p1[15]));
    { auto rr = __builtin_amdgcn_permlane32_swap(__float_as_uint(mx), __float_as_uint(mx), false, false); mx = fmaxf(__uint_as_float(rr[0]), __uint_as_float(rr[1])); }
    const float mnew = fmaxf(mrun, mx); const float alpha = fast_exp2(mrun - mnew); mrun = mnew;
    float sum = 0.f;
#pragma unroll
    for (int r = 0; r < 16; ++r) { p0[r] = fast_exp2(p0[r] - mnew); p1[r] = fast_exp2(p1[r] - mnew); sum += p0[r] + p1[r]; }
    lrun = lrun * alpha + sum;
    if (__any(alpha != 1.f)) {
        if (hi == 0) wsf[r32] = alpha;
        asm volatile("s_waitcnt lgkmcnt(0)" ::: "memory");
#pragma unroll
        for (int g = 0; g < 4; ++g) { const f32x4 av = *(const LAS f32x4*)(wsf + 8 * g + 4 * hi);
#pragma unroll
            for (int j = 0; j < 4; ++j) { o[0][4 * g + j] *= av[j]; o[1][4 * g + j] *= av[j]; } }
        asm volatile("s_waitcnt lgkmcnt(0)" ::: "memory");
    }
    bf16x8 pf[4];
#pragma unroll
    for (int s = 0; s < 4; ++s) { u32x4 w;
        if (s < 2) { w.x = pk2(p0[8 * s + 0], p0[8 * s + 1]); w.y = pk2(p0[8 * s + 2], p0[8 * s + 3]); w.z = pk2(p0[8 * s + 4], p0[8 * s + 5]); w.w = pk2(p0[8 * s + 6], p0[8 * s + 7]); }
        else { const int s2 = s - 2; w.x = pk2(p1[8 * s2 + 0], p1[8 * s2 + 1]); w.y = pk2(p1[8 * s2 + 2], p1[8 * s2 + 3]); w.z = pk2(p1[8 * s2 + 4], p1[8 * s2 + 5]); w.w = pk2(p1[8 * s2 + 6], p1[8 * s2 + 7]); }
        pf[s] = __builtin_bit_cast(bf16x8, w); }
    const LAS unsigned char* vb = lds + bo + KBYTES + ((lane >> 4) & 1) * 32 + (lane & 3) * 8 + (4 * hi + ((lane & 15) >> 2)) * 64;
    __builtin_amdgcn_s_setprio(1);
#pragma unroll
    for (int d0 = 0; d0 < 2; ++d0)
#pragma unroll
        for (int ks = 0; ks < 4; ++ks) { const s16x4 lo = vtr(vb + d0 * 4096 + ks * 1024), hh = vtr(vb + d0 * 4096 + ks * 1024 + 512);
            const bf16x8 vf = (bf16x8){lo[0], lo[1], lo[2], lo[3], hh[0], hh[1], hh[2], hh[3]};
            o[d0] = __builtin_amdgcn_mfma_f32_32x32x16_bf16(pf[ks], vf, o[d0], 0, 0, 0); }
    __builtin_amdgcn_s_setprio(0);
}

template <bool DSA>
__device__ __forceinline__ void attn_unit(LAS unsigned char* lds, const Args& a, int b, int hq  , int qblk  , int tid) {
    asm volatile("" : "+v"(tid));
    constexpr int DQK = DSA ? 64 : 96, KP = DQK * 2 + 16, KBYTES = 64 * KP, BUFB = KBYTES + 8192;
    constexpr int WS_OFF = 3 * BUFB;
    unsigned char* ws = a.ws;
    const int lane = tid & 63, r32 = lane & 31, hi = lane >> 5; const int wid = __builtin_amdgcn_readfirstlane(tid >> 6);
    const size_t rowbase = (size_t)b * SEQ;
    const int q0 = DSA ? qblk * 32 : qblk * 256 + wid * 32;
    const int qlast_unit = DSA ? qblk * 32 + 31 : qblk * 256 + 255;
    const int NT = qlast_unit / 64 + 1;
    const int h = DSA ? wid : hq;
    const bf16_t* PROJ = (const bf16_t*)(ws + WS_PROJ); const bf16_t* KVU = (const bf16_t*)(ws + WS_KVU); const bf16_t* KR = (const bf16_t*)(ws + WS_KR); const bf16_t* Qb = (const bf16_t*)(ws + WS_Q);
    const int krow = tid >> 3, kch = tid & 7, krowB = (tid >> 2) & 63, kchB = tid & 3;
    const bf16_t* ksrcA; const bf16_t* ksrcB; const bf16_t* vsrc; size_t kstrideA, kstrideB, vstride;
    if (DSA) { ksrcA = PROJ + (rowbase + krow) * NPROJ + C_DK + kch * 8; kstrideA = (size_t)64 * NPROJ; ksrcB = ksrcA; kstrideB = 0;
               vsrc = PROJ + (rowbase + 16 * (wid & 3) + (lane >> 2)) * NPROJ + C_DV + (wid >> 2) * 32 + (lane & 3) * 8; vstride = (size_t)64 * NPROJ; }
    else { ksrcA = KVU + (rowbase + krow) * 1024 + h * 64 + kch * 8; kstrideA = (size_t)64 * 1024;
           ksrcB = KR + (rowbase + krowB) * 32 + kchB * 8; kstrideB = (size_t)64 * 32;
           vsrc = KVU + (rowbase + 16 * (wid & 3) + (lane >> 2)) * 1024 + 512 + h * 64 + (wid >> 2) * 32 + (lane & 3) * 8; vstride = (size_t)64 * 1024; }
    const bool hasB = (!DSA) && (tid < 256);
    const int kdstA = krow * KP + kch * 16, kdstB = krowB * KP + 128 + kchB * 16, vdst = KBYTES + wid * 1024 + lane * 16;
    bf16x8 qf[DQK / 16];
    { const bf16_t* qp = DSA ? PROJ + (rowbase + q0 + r32) * NPROJ + C_DQ + h * 64 + 8 * hi : Qb + (rowbase + q0 + r32) * 768 + h * 96 + 8 * hi;
#pragma unroll
      for (int d0 = 0; d0 < DQK / 16; ++d0) qf[d0] = *(const bf16x8*)(qp + d0 * 16); }
    constexpr int MOFF = WS_OFF + 2048, MPITCH = 264;
    if (DSA) { const u32x4 mv = *(const u32x4*)((const unsigned*)(ws + WS_MASK) + (rowbase + q0 + (tid >> 4)) * 64 + (tid & 15) * 4);
        LAS unsigned char* md = lds + MOFF + (tid >> 4) * MPITCH + (tid & 15) * 16; *(LAS u32x2*)md = (u32x2){mv.x, mv.y}; *(LAS u32x2*)(md + 8) = (u32x2){mv.z, mv.w}; }
    const LAS unsigned char* mrow = lds + MOFF + r32 * MPITCH;
    const float sl2 = DSA ? exp2f(-(float)(h + 1)) * LOG2E : 0.f;
    float slc[16];
#pragma unroll
    for (int r = 0; r < 16; ++r) slc[r] = sl2 * (float)((r & 3) + 8 * (r >> 2));
    LAS float* wsf = (LAS float*)(lds + WS_OFF) + wid * 64;
    float mrun = -1e30f, lrun = 0.f; f32x16 o[2]; o[0] = f32x16{}; o[1] = f32x16{};
#define AT_LOAD(KA, KB, VV, tt) do { const int tc_ = (tt) < NT ? (tt) : NT - 1; KA = *(const u32x4*)(ksrcA + (size_t)tc_ * kstrideA); if (!DSA) KB = *(const u32x4*)(ksrcB + (size_t)tc_ * kstrideB); \
        VV = *(const u32x4*)(vsrc + (size_t)tc_ * vstride); } while (0)
#define AT_WRITE(KA, KB, VV, bn) do { *(LAS u32x4*)(lds + (bn) + kdstA) = KA; if (hasB) *(LAS u32x4*)(lds + (bn) + kdstB) = KB; *(LAS u32x4*)(lds + (bn) + vdst) = VV; } while (0)
#define AT_ACTIVE(tt) (64 * (tt) <= q0 + 31)
#define AT_ROT() do { const int t_ = bc; bc = bn; bn = bw; bw = t_; } while (0)
    u32x4 kA0, kB0 = (u32x4){0, 0, 0, 0}, vv0, kA1, kB1 = (u32x4){0, 0, 0, 0}, vv1;
    AT_LOAD(kA0, kB0, vv0, 0); AT_LOAD(kA1, kB1, vv1, 1);
    AT_WRITE(kA0, kB0, vv0, 0); AT_WRITE(kA1, kB1, vv1, BUFB);
    AT_LOAD(kA0, kB0, vv0, 2); AT_LOAD(kA1, kB1, vv1, 3);
    __syncthreads();
    int bc = 0, bn = BUFB, bw = 2 * BUFB;
    f32x16 pA0, pA1, pB0, pB1;
    attn_qk<DSA>(lds, 0, 0, qf, pA0, pA1, q0, lane, sl2, slc, mrow);
    for (int t = 0; t < NT; t += 2) {
        if (t + 1 < NT && AT_ACTIVE(t + 1)) attn_qk<DSA>(lds, bn, t + 1, qf, pB0, pB1, q0, lane, sl2, slc, mrow);
        if (AT_ACTIVE(t)) attn_sm_pv<DSA>(lds, bc, pA0, pA1, o, mrun, lrun, lane, wsf);
        if (t + 2 < NT) AT_WRITE(kA0, kB0, vv0, bw);
        AT_LOAD(kA0, kB0, vv0, t + 4);
        __syncthreads(); AT_ROT();
        if (t + 1 >= NT) break;
        if (t + 2 < NT && AT_ACTIVE(t + 2)) attn_qk<DSA>(lds, bn, t + 2, qf, pA0, pA1, q0, lane, sl2, slc, mrow);
        if (AT_ACTIVE(t + 1)) attn_sm_pv<DSA>(lds, bc, pB0, pB1, o, mrun, lrun, lane, wsf);
        if (t + 3 < NT) AT_WRITE(kA1, kB1, vv1, bw);
        AT_LOAD(kA1, kB1, vv1, t + 5);
        __syncthreads(); AT_ROT();
    }
#undef AT_ROT
#undef AT_LOAD
#undef AT_WRITE
#undef AT_ACTIVE
    { auto rr = __builtin_amdgcn_permlane32_swap(__float_as_uint(lrun), __float_as_uint(lrun), false, false); lrun = __uint_as_float(rr[0]) + __uint_as_float(rr[1]); }
    if (hi == 0) wsf[r32] = 1.0f / lrun;
    asm volatile("s_waitcnt lgkmcnt(0)" ::: "memory");
    bf16_t* Ob = (bf16_t*)(ws + WS_CONCAT) + (rowbase + q0) * DM + (DSA ? 512 : 0) + h * 64 + r32;
#pragma unroll
    for (int g = 0; g < 4; ++g) { const f32x4 li = *(const LAS f32x4*)(wsf + 8 * g + 4 * hi);
#pragma unroll
        for (int j = 0; j < 4; ++j) { const int r = 4 * g + j; const int orow = crow(r, hi);
            Ob[(size_t)orow * DM] = (bf16_t)(pk2(o[0][r] * li[j], 0.f) & 0xffffu); Ob[(size_t)orow * DM + 32] = (bf16_t)(pk2(o[1][r] * li[j], 0.f) & 0xffffu); } }
    asm volatile("s_waitcnt lgkmcnt(0)" ::: "memory");
    __syncthreads();
}

__device__ __forceinline__ unsigned f2key(float s) { s = s + 0.0f; const unsigned u = __float_as_uint(s); return (u & 0x80000000u) ? ~u : (u | 0x80000000u); }
#define SBAR0() __builtin_amdgcn_sched_barrier(0)
#ifndef IDX_ITCAP
#define IDX_ITCAP 16
#endif
__device__ __forceinline__ void cnt_ge4(int& cnt, unsigned k0, unsigned k1, unsigned k2, unsigned k3, unsigned t) {
    unsigned long long m0, m1, m2, m3;
    asm("v_cmp_ge_u32_e64 %1, %5, %9\n\tv_cmp_ge_u32_e64 %2, %6, %9\n\tv_cmp_ge_u32_e64 %3, %7, %9\n\tv_cmp_ge_u32_e64 %4, %8, %9\n\t"
        "v_addc_co_u32_e64 %0, %1, %0, 0, %1\n\tv_addc_co_u32_e64 %0, %2, %0, 0, %2\n\tv_addc_co_u32_e64 %0, %3, %0, 0, %3\n\tv_addc_co_u32_e64 %0, %4, %0, 0, %4"
        : "+v"(cnt), "=&s"(m0), "=&s"(m1), "=&s"(m2), "=&s"(m3) : "v"(k0), "v"(k1), "v"(k2), "v"(k3), "v"(t));
}
__device__ __forceinline__ float relu1(float x) { return __builtin_amdgcn_fmed3f(x, 0.f, __builtin_inff()); }
__device__ __forceinline__ float key2f(unsigned k) { const unsigned u = (k & 0x80000000u) ? (k ^ 0x80000000u) : ~k; return __uint_as_float(u); }

__device__ __forceinline__ void idx_unit(LAS unsigned char* lds, const Args& a, int b, int qg, int tid) {
    asm volatile("" : "+v"(tid));
    unsigned char* ws = a.ws; const bf16_t* PROJ = (const bf16_t*)(ws + WS_PROJ); unsigned* MASK = (unsigned*)(ws + WS_MASK);
    const int lane = tid & 63; const int wid = __builtin_amdgcn_readfirstlane(tid >> 6);
    const size_t rowbase = (size_t)b * SEQ; const int hl = lane >> 5, c = lane & 31;
    const int nkeys = 32 * qg + 32;
    const int nstage = (nkeys + 511) & ~511;
    for (int i0 = tid; i0 < nstage * 4; i0 += 4 * NTHREADS) {
        u32x4 v[4];
#pragma unroll
        for (int q = 0; q < 4; ++q) { const int i = i0 + q * NTHREADS; v[q] = *(const u32x4*)(PROJ + (rowbase + (i >> 2)) * NPROJ + C_IK + (i & 3) * 8); }
#pragma unroll
        for (int q = 0; q < 4; ++q) { const int i = i0 + q * NTHREADS; const int r = i >> 2, ch = i & 3; *(LAS u32x4*)(lds + r * 64 + ((ch ^ ((r >> 2) & 3)) * 16)) = v[q]; }
    }
    __syncthreads();
    const int t0 = 32 * qg + 4 * wid;
    const int tqa = t0 + 2 * hl, tqb = tqa + 1; const int ntile = (t0 + 3) / 32 + 1;
    const int aq = 2 * ((c >> 2) & 1) + (c >> 4), ah = (c & 3) + 4 * ((c >> 3) & 1);
    const bf16_t* ap = PROJ + (rowbase + t0 + aq) * NPROJ + C_IQ + ah * 32 + 8 * hl;
    const bf16x8 a0 = *(const bf16x8*)ap, a1 = *(const bf16x8*)(ap + 16);
    float wa[8], wb[8];
    { const u32x4 wv = *(const u32x4*)(PROJ + (rowbase + tqa) * NPROJ + C_IW), wv2 = *(const u32x4*)(PROJ + (rowbase + tqb) * NPROJ + C_IW);
#pragma unroll
      for (int j = 0; j < 4; ++j) { wa[2 * j] = bf_lo(wv[j]); wa[2 * j + 1] = bf_hi(wv[j]); wb[2 * j] = bf_lo(wv2[j]); wb[2 * j + 1] = bf_hi(wv2[j]); } }
    unsigned keyA[64], keyB[64];
    const int sw = (c >> 2) & 3;
    const LAS unsigned char* kb0 = lds + c * 64 + ((hl ^ sw) * 16); const LAS unsigned char* kb1 = lds + c * 64 + (((2 + hl) ^ sw) * 16);
#pragma unroll
    for (int blk = 0; blk < 16; ++blk) {
        if (blk * 4 < ntile) {
#pragma unroll
            for (int j4 = 0; j4 < 4; ++j4) { const int i = blk * 4 + j4;
                if (i < ntile) {
                    const bf16x8 b0 = *(const LAS bf16x8*)(kb0 + i * 2048), b1 = *(const LAS bf16x8*)(kb1 + i * 2048);
                    f32x16 z = f32x16{};
                    z = __builtin_amdgcn_mfma_f32_32x32x16_bf16(a0, b0, z, 0, 0, 0); z = __builtin_amdgcn_mfma_f32_32x32x16_bf16(a1, b1, z, 0, 0, 0);
                    float sa = 0.f, sb = 0.f;
#pragma unroll
                    for (int r = 0; r < 8; ++r) { sa += wa[r] * relu1(z[r]); sb += wb[r] * relu1(z[8 + r]); }
                    const int kidx = 32 * i + c;
                    keyA[i] = (kidx <= tqa) ? f2key(sa) : 0u; keyB[i] = (kidx <= tqb) ? f2key(sb) : 0u;
                } else { keyA[i] = 0u; keyB[i] = 0u; } }
        } else {
#pragma unroll
            for (int j4 = 0; j4 < 4; ++j4) { keyA[blk * 4 + j4] = 0u; keyB[blk * 4 + j4] = 0u; }
        }
        SBAR0();
    }
    const int KqA = tqa + 1 < 256 ? tqa + 1 : 256, KqB = tqb + 1 < 256 ? tqb + 1 : 256;
    unsigned TA = 1u, TB = 1u; int cgeA = KqA, cgeB = KqB;
#define COUNT_GE(ta, tb, ca, cb) do { ca = 0; cb = 0; const unsigned ta_ = (ta), tb_ = (tb); _Pragma("unroll") for (int blk = 0; blk < 8; ++blk) { if (blk * 8 < ntile) { \
        cnt_ge4(ca, keyA[blk * 8 + 0], keyA[blk * 8 + 1], keyA[blk * 8 + 2], keyA[blk * 8 + 3], ta_); cnt_ge4(cb, keyB[blk * 8 + 0], keyB[blk * 8 + 1], keyB[blk * 8 + 2], keyB[blk * 8 + 3], tb_); \
        cnt_ge4(ca, keyA[blk * 8 + 4], keyA[blk * 8 + 5], keyA[blk * 8 + 6], keyA[blk * 8 + 7], ta_); cnt_ge4(cb, keyB[blk * 8 + 4], keyB[blk * 8 + 5], keyB[blk * 8 + 6], keyB[blk * 8 + 7], tb_); } SBAR0(); } \
        ca = half32_sum(ca); cb = half32_sum(cb); } while (0)
    if (t0 + 3 >= 256) {
        unsigned mxA = 0u, mxB = 0u, mnA = 0xffffffffu, mnB = 0xffffffffu;
#pragma unroll
        for (int i = 0; i < 64; ++i) { mxA = max(mxA, keyA[i]); mxB = max(mxB, keyB[i]); mnA = min(mnA, keyA[i] ? keyA[i] : 0xffffffffu); mnB = min(mnB, keyB[i] ? keyB[i] : 0xffffffffu); }
        unsigned loA = ~half32_max(~mnA), hiA = half32_max(mxA), loB = ~half32_max(~mnB), hiB = half32_max(mxB);
        int cloA = tqa + 1, cloB = tqb + 1;
        if (cloA == KqA) hiA = loA;
        if (cloB == KqB) hiB = loB;
        for (int it = 0; it < IDX_ITCAP; ++it) {
            if (__all(loA == hiA && loB == hiB)) break;
            unsigned gA = f2key(0.5f * key2f(loA) + 0.5f * key2f(hiA)), gB = f2key(0.5f * key2f(loB) + 0.5f * key2f(hiB));
            gA = gA <= loA ? loA + 1u : gA; gA = gA > hiA ? hiA : gA; gB = gB <= loB ? loB + 1u : gB; gB = gB > hiB ? hiB : gB;
            const unsigned midA = gA, midB = gB;
            int ca, cb; COUNT_GE(midA, midB, ca, cb);
            if (loA != hiA) { if (ca >= KqA) { loA = midA; cloA = ca; } else hiA = midA - 1u; if (ca == KqA) hiA = midA; }
            if (loB != hiB) { if (cb >= KqB) { loB = midB; cloB = cb; } else hiB = midB - 1u; if (cb == KqB) hiB = midB; }
        }
        for (int ms = 0; ms < 4096; ++ms) {
            if (__all(loA == hiA && loB == hiB)) break;
            unsigned mA = 0u, mB = 0u;
#pragma unroll
            for (int blk = 0; blk < 8; ++blk) { if (blk * 8 < ntile) {
#pragma unroll
                for (int j8 = 0; j8 < 8; ++j8) { const unsigned ka = keyA[blk * 8 + j8], kb = keyB[blk * 8 + j8]; mA = max(mA, ka <= hiA ? ka : 0u); mB = max(mB, kb <= hiB ? kb : 0u); } } SBAR0(); }
            mA = half32_max(mA); mB = half32_max(mB);
            int ca, cb; COUNT_GE(mA, mB, ca, cb);
            if (loA != hiA) { if (ca >= KqA) { loA = mA; hiA = mA; cloA = ca; } else hiA = mA - 1u; }
            if (loB != hiB) { if (cb >= KqB) { loB = mB; hiB = mB; cloB = cb; } else hiB = mB - 1u; }
        }
        TA = loA; TB = loB; cgeA = cloA; cgeB = cloB;
    }
    const bool ties = __any(cgeA != KqA || cgeB != KqB);
    int needA = 0, needB = 0, runA = 0, runB = 0;
    if (ties) { int ca, cb; COUNT_GE(TA + 1u, TB + 1u, ca, cb); needA = KqA - ca; needB = KqB - cb; }
    unsigned mw0 = 0u, mw1 = 0u, mw2 = 0u, mw3 = 0u;
#pragma unroll
    for (int blk = 0; blk < 16; ++blk) {
        if (blk * 4 < ntile) {
#pragma unroll
            for (int j4 = 0; j4 < 4; ++j4) { const int i = blk * 4 + j4;
                bool selA = keyA[i] >= TA && keyA[i] != 0u, selB = keyB[i] >= TB && keyB[i] != 0u;
                if (ties) {
                    const bool eqA = keyA[i] == TA && keyA[i] != 0u, eqB = keyB[i] == TB && keyB[i] != 0u;
                    const unsigned long long balA = __ballot(eqA), balB = __ballot(eqB);
                    const unsigned eA = hl ? (unsigned)(balA >> 32) : (unsigned)balA, eB = hl ? (unsigned)(balB >> 32) : (unsigned)balB;
                    const unsigned below = (1u << c) - 1u;
                    selA = (keyA[i] > TA) || (eqA && (runA + __popc(eA & below) < needA)); selB = (keyB[i] > TB) || (eqB && (runB + __popc(eB & below) < needB));
                    runA += __popc(eA); runB += __popc(eB);
                }
                const unsigned long long sA = __ballot(selA), sB = __ballot(selB);
                if (lane == i) { mw0 = (unsigned)sA; mw2 = (unsigned)(sA >> 32); mw1 = (unsigned)sB; mw3 = (unsigned)(sB >> 32); } }
        }
        SBAR0();
    }
#undef COUNT_GE
    unsigned* mrow = MASK + (rowbase + t0) * 64 + lane;
    mrow[0] = mw0; mrow[64] = mw1; mrow[128] = mw2; mrow[192] = mw3;
    __syncthreads();
}

__device__ __forceinline__ void ln_row(f32x4 (&v)[4], const float* gam, const float* bet, int lane) {
    float s = 0.f;
#pragma unroll
    for (int j = 0; j < 4; ++j) s += (v[j][0] + v[j][1]) + (v[j][2] + v[j][3]);
    const float mean = wave_sum(s) * (1.f / DM); float s2 = 0.f;
#pragma unroll
    for (int j = 0; j < 4; ++j) { v[j] = v[j] - mean; s2 += (v[j][0] * v[j][0] + v[j][1] * v[j][1]) + (v[j][2] * v[j][2] + v[j][3] * v[j][3]); }
    const float rstd = 1.0f / sqrtf(wave_sum(s2) * (1.f / DM) + LN_EPS);
#pragma unroll
    for (int j = 0; j < 4; ++j) { const f32x4 gg = *((const f32x4*)gam + lane + 64 * j), bb = *((const f32x4*)bet + lane + 64 * j); v[j] = v[j] * rstd * gg + bb; }
}

__device__ __forceinline__ void p6_ln1_router(LAS unsigned char* lds, const Args& a, int l, const int tid, const int nrep) {
    const int lane = tid & 63; const int wave = __builtin_amdgcn_readfirstlane(tid >> 6);
    unsigned char* ws = a.ws;
    constexpr int RP = 2064;
    LAS unsigned char* WL = lds;
    LAS unsigned char* XL = lds + 16 * RP + wave * (4 * RP);
    LAS int* ent_e = (LAS int*)(lds + 100352);
    LAS int* ent_p = ent_e + 128;
    LAS float* bias_l = (LAS float*)(ent_p + 128);
    { f32x4 rv[8];
#pragma unroll
      for (int q = 0; q < 8; ++q) rv[q] = *((const f32x4*)a.router_w + tid + q * NTHREADS);
#pragma unroll
      for (int q = 0; q < 8; ++q) { const int i4 = tid + q * NTHREADS, k = i4 >> 2, e0 = (i4 & 3) * 4;
#pragma unroll
          for (int c = 0; c < 4; ++c) *(LAS bf16_t*)(WL + (e0 + c) * RP + k * 2) = (bf16_t)(pk2(rv[q][c], 0.f) & 0xffffu); } }
    if (tid < 16) bias_l[tid] = a.router_bias[tid];
    if (tid < 128) { ent_e[tid] = -1; ent_p[tid] = 0; }
    __syncthreads();
    const bf16_t* MIX = (const bf16_t*)(ws + WS_MIX); const bf16_t* XBr = (const bf16_t*)(ws + WS_XB); bf16_t* X1B = (bf16_t*)(ws + WS_X1B); float* GATE = (float*)(ws + WS_GATE);
    const float* gam = a.ln1_g + l * DM; const float* bet = a.ln1_b + l * DM;
    const int G = gridDim.x;
    const int ntok = (M / (256 * 8)) * nrep;
    u32x2 xw[4], mw[4];
    { const int m0 = blockIdx.x * 8 + wave;
#pragma unroll
      for (int j = 0; j < 4; ++j) { xw[j] = *((const u32x2*)(XBr + (size_t)m0 * DM) + lane + 64 * j); mw[j] = *((const u32x2*)(MIX + (size_t)m0 * DM) + lane + 64 * j); } }
    const LAS unsigned char* afr = XL + (lane & 3) * RP + (lane >> 4) * 16; const LAS unsigned char* bfr = WL + (lane & 15) * RP + (lane >> 4) * 16;
    for (int it4 = 0; it4 < ntok; it4 += 4) {
#pragma unroll 1
        for (int tt = 0; tt < 4; ++tt) { const int it2 = it4 + tt, it = it2 & 7;
            const int m = (it * G + blockIdx.x) * 8 + wave;
            u32x2 nxw[4], nmw[4];
            { const int itn = (it2 + 1 < ntok ? it2 + 1 : it2) & 7; const int mn = (itn * G + blockIdx.x) * 8 + wave;
#pragma unroll
              for (int j = 0; j < 4; ++j) { nxw[j] = *((const u32x2*)(XBr + (size_t)mn * DM) + lane + 64 * j); nmw[j] = *((const u32x2*)(MIX + (size_t)mn * DM) + lane + 64 * j); } }
            f32x4 v[4];
#pragma unroll
            for (int j = 0; j < 4; ++j) { v[j][0] = ALPHA * bf_lo(xw[j].x) + bf_lo(mw[j].x); v[j][1] = ALPHA * bf_hi(xw[j].x) + bf_hi(mw[j].x); v[j][2] = ALPHA * bf_lo(xw[j].y) + bf_lo(mw[j].y); v[j][3] = ALPHA * bf_hi(xw[j].y) + bf_hi(mw[j].y); }
            ln_row(v, gam, bet, lane);
#pragma unroll
            for (int j = 0; j < 4; ++j) { u32x2 w; w.x = pk2(v[j][0], v[j][1]); w.y = pk2(v[j][2], v[j][3]); *((u32x2*)(X1B + (size_t)m * DM) + lane + 64 * j) = w;
                *(LAS u32x2*)(XL + tt * RP + (lane + 64 * j) * 8) = w; }
#pragma unroll
            for (int j = 0; j < 4; ++j) { xw[j] = nxw[j]; mw[j] = nmw[j]; }
        }
        asm volatile("s_waitcnt lgkmcnt(0)" ::: "memory");
        f32x4 lacc = {0.f, 0.f, 0.f, 0.f};
#pragma unroll 8
        for (int s = 0; s < 32; ++s) { const bf16x8 af = *(const LAS bf16x8*)(afr + s * 64), bf = *(const LAS bf16x8*)(bfr + s * 64); lacc = __builtin_amdgcn_mfma_f32_16x16x32_bf16(af, bf, lacc, 0, 0, 0); }
#pragma unroll
        for (int tt = 0; tt < 4; ++tt) { const int it = (it4 + tt) & 7; const int m = (it * G + blockIdx.x) * 8 + wave;
            float lg[16]; const int lb = (int)__float_as_uint(lacc[tt]);
#pragma unroll
            for (int e = 0; e < 16; ++e) lg[e] = __uint_as_float((unsigned)__builtin_amdgcn_readlane(lb, e));
            float best_gs = -INFINITY, be_a1 = 0.f, be_a2 = 0.f; int be1 = 0, be2 = 0;
#pragma unroll
            for (int gi = 0; gi < 4; ++gi) {
                float af[4], bs[4];
#pragma unroll
                for (int j = 0; j < 4; ++j) { af[j] = 1.0f / (1.0f + expf(-lg[gi * 4 + j])); bs[j] = af[j] + bias_l[gi * 4 + j]; }
                int i1 = 0; float m1 = bs[0], a1 = af[0];
#pragma unroll
                for (int j = 1; j < 4; ++j) if (bs[j] > m1) { m1 = bs[j]; a1 = af[j]; i1 = j; }
                int i2 = -1; float m2 = -INFINITY, a2 = 0.f;
#pragma unroll
                for (int j = 0; j < 4; ++j) if (j != i1 && bs[j] > m2) { m2 = bs[j]; a2 = af[j]; i2 = j; }
                const float gs = m1 + m2;
                if (gs > best_gs) { best_gs = gs; be1 = gi * 4 + i1; be2 = gi * 4 + i2; be_a1 = a1; be_a2 = a2; }
            }
            if (lane == 0) { const float inv = 1.0f / (be_a1 + be_a2); GATE[(size_t)m * 2] = be_a1 * inv; GATE[(size_t)m * 2 + 1] = be_a2 * inv;
                const int slot = (it * 8 + wave) * 2; ent_e[slot] = be1; ent_p[slot] = m * 2; ent_e[slot + 1] = be2; ent_p[slot + 1] = m * 2 + 1; }
        }
        asm volatile("s_waitcnt lgkmcnt(0)" ::: "memory");
    }
    __syncthreads();
    if (tid < 16) { const int e = tid; int cnt = 0;
        for (int i = 0; i < 128; ++i) cnt += (ent_e[i] == e) ? 1 : 0;
        if (cnt > 0) { int* ctr = (int*)(ws + WS_CTL) + l * 16 + e; int base = atomicAdd(ctr, cnt); int* el = (int*)(ws + WS_ELIST) + ((size_t)l * 16 + e) * 16384;
            for (int i = 0; i < 128; ++i) if (ent_e[i] == e) el[base++] = ent_p[i]; } }
    __syncthreads();
}

__device__ __forceinline__ void p9_ln2(const Args& a, int l, int gw, int NGW, int lane) {
    unsigned char* ws = a.ws; const bf16_t* X1B = (const bf16_t*)(ws + WS_X1B); const bf16_t* Y = (const bf16_t*)(ws + WS_Y); bf16_t* XB = (bf16_t*)(ws + WS_XB);
    const float* gam = a.ln2_g + l * DM; const float* bet = a.ln2_b + l * DM;
    u32x2 xw[4], y0[4], y1[4];
#pragma unroll
    for (int j = 0; j < 4; ++j) { xw[j] = *((const u32x2*)(X1B + (size_t)gw * DM) + lane + 64 * j); y0[j] = *((const u32x2*)(Y + (size_t)(2 * gw) * DM) + lane + 64 * j); y1[j] = *((const u32x2*)(Y + (size_t)(2 * gw + 1) * DM) + lane + 64 * j); }
    for (int m = gw; m < M; m += NGW) {
        u32x2 nxw[4], ny0[4], ny1[4];
        { const int mn = m + NGW < M ? m + NGW : m;
#pragma unroll
          for (int j = 0; j < 4; ++j) { nxw[j] = *((const u32x2*)(X1B + (size_t)mn * DM) + lane + 64 * j); ny0[j] = *((const u32x2*)(Y + (size_t)(2 * mn) * DM) + lane + 64 * j); ny1[j] = *((const u32x2*)(Y + (size_t)(2 * mn + 1) * DM) + lane + 64 * j); } }
        f32x4 v[4];
#pragma unroll
        for (int j = 0; j < 4; ++j) {
            v[j][0] = ALPHA * bf_lo(xw[j].x) + (bf_lo(y0[j].x) + bf_lo(y1[j].x)); v[j][1] = ALPHA * bf_hi(xw[j].x) + (bf_hi(y0[j].x) + bf_hi(y1[j].x));
            v[j][2] = ALPHA * bf_lo(xw[j].y) + (bf_lo(y0[j].y) + bf_lo(y1[j].y)); v[j][3] = ALPHA * bf_hi(xw[j].y) + (bf_hi(y0[j].y) + bf_hi(y1[j].y)); }
#pragma unroll
        for (int j = 0; j < 4; ++j) { xw[j] = nxw[j]; y0[j] = ny0[j]; y1[j] = ny1[j]; }
        ln_row(v, gam, bet, lane);
#pragma unroll
        for (int j = 0; j < 4; ++j) {
            if (l + 1 < DEPTH) { u32x2 w; w.x = pk2(v[j][0], v[j][1]); w.y = pk2(v[j][2], v[j][3]); *((u32x2*)(XB + (size_t)m * DM) + lane + 64 * j) = w; }
            else *((f32x4*)(a.out + (size_t)m * DM) + lane + 64 * j) = v[j]; }
    }
}


#define XB_TMO      128
#define XB_XCNT(j)  (256  + 64 * (j))
#define XB_XSUB(j)  (1280 + 64 * (j))
#define XB_XGEN(j)  (2304 + 64 * (j))
#define XB_TOP      3328
#define XB_TOPGEN   3392
#define XCD_BAR_WORDS 3456
#define XB_SPIN_CAP (1u << 18)
__device__ __forceinline__ unsigned xb_ld(unsigned* p)              { return __hip_atomic_load(p, __ATOMIC_RELAXED, __HIP_MEMORY_SCOPE_AGENT); }
__device__ __forceinline__ unsigned xb_add(unsigned* p, unsigned v) { return __hip_atomic_fetch_add(p, v, __ATOMIC_RELAXED, __HIP_MEMORY_SCOPE_AGENT); }
__device__ __forceinline__ unsigned xb_xcc_id() { return (unsigned)__builtin_amdgcn_s_getreg((3 << 11) | 20) & 0xFu; }
#define XB_SPIN(cond, bar) do { unsigned _sp = 0; while (cond) { __builtin_amdgcn_s_sleep(1); \
    if ((++_sp & 255u) == 0u) { if (xb_ld(&(bar)[XB_TMO])) break; if (_sp > XB_SPIN_CAP) { atomicAdd(&(bar)[XB_TMO], 1u); break; } } } } while (0)
struct XcdBarrier { unsigned* bar; unsigned x; volatile LAS unsigned* st; };
__device__ __forceinline__ XcdBarrier xcd_barrier_post(unsigned* bar, volatile LAS unsigned* st) {
    XcdBarrier b; b.bar = bar; b.x = xb_xcc_id(); b.st = st;
    if (threadIdx.x == 0) (void)xb_add(&bar[XB_XCNT(b.x)], 1u);
    return b;
}
__device__ __forceinline__ void xcd_barrier_complete(unsigned* bar, unsigned x, unsigned& nloc, unsigned& nx) {
    const unsigned G = gridDim.x * gridDim.y * gridDim.z;
    unsigned sum, cnt, mine, sp = 0u;
    for (;;) {
        sum = 0u; cnt = 0u; mine = 0u;
#pragma unroll
        for (unsigned j = 0; j < 16; ++j) { const unsigned c = xb_ld(&bar[XB_XCNT(j)]); sum += c; cnt += (c > 0u) ? 1u : 0u; mine = (j == x) ? c : mine; }
        if (sum == G) break;
        __builtin_amdgcn_s_sleep(1);
        if ((++sp & 255u) == 0u) { if (xb_ld(&bar[XB_TMO])) break; if (sp > XB_SPIN_CAP) { atomicAdd(&bar[XB_TMO], 1u); break; } }
    }
    nloc = mine > 0u ? mine : 1u; nx = cnt > 0u ? cnt : 1u;
}
__device__ __forceinline__ void xcd_barrier(const XcdBarrier& b) {
    asm volatile("s_waitcnt vmcnt(0)" ::: "memory");
    __syncthreads();
    if (threadIdx.x == 0) {
        unsigned* bar = b.bar;
        __builtin_amdgcn_s_waitcnt(0);
        unsigned nloc = b.st[0], nx = b.st[1];
        if (nloc == 0u) { xcd_barrier_complete(bar, b.x, nloc, nx); b.st[0] = nloc; b.st[1] = nx; }
        const unsigned old = xb_add(&bar[XB_XSUB(b.x)], 1u);
        const unsigned gen = old / nloc;
        if (old + 1u == (gen + 1u) * nloc) {
            __builtin_amdgcn_fence(__ATOMIC_RELEASE, "agent");
            asm volatile("s_waitcnt vmcnt(0)" ::: "memory");
            const unsigned og = xb_add(&bar[XB_TOP], 1u);
            const unsigned tg = og / nx;
            if (og + 1u == (tg + 1u) * nx) xb_add(&bar[XB_TOPGEN], 1u);
            else XB_SPIN(xb_ld(&bar[XB_TOPGEN]) == tg, bar);
            __builtin_amdgcn_fence(__ATOMIC_ACQUIRE, "agent");
            xb_add(&bar[XB_XGEN(b.x)], 1u);
            asm volatile("s_waitcnt vmcnt(0)" ::: "memory");
        } else {
            XB_SPIN(xb_ld(&bar[XB_XGEN(b.x)]) == gen, bar);
            __builtin_amdgcn_fence(__ATOMIC_ACQUIRE, "agent");
            asm volatile("s_waitcnt vmcnt(0)" ::: "memory");
        }
    }
    __syncthreads();
}

#ifndef PROJ_MERGED
#define PROJ_MERGED 0
#endif
#ifndef MOE_MERGED
#define MOE_MERGED 1
#endif
constexpr int N_PHASES = 1 + 10 * DEPTH;
#ifndef DUP_MASK
#define DUP_MASK 0
#endif
#define NREP(k) ((((DUP_MASK) >> (k)) & 1) ? (((a.dup_mask >> (k)) & 1) + 1) : 1)

__global__ void __launch_bounds__(NTHREADS, 2) mega_fwd(Args a_param) {
    extern __shared__ __attribute__((aligned(16))) unsigned char lds_raw[];
    LAS unsigned char* const lds0 = (LAS unsigned char*)lds_raw;
    cg::grid_group grid = cg::this_grid();
    const int wave0 = __builtin_amdgcn_readfirstlane((int)threadIdx.x >> 6);
    const int G0 = gridDim.x, bx0 = blockIdx.x;
    volatile LAS unsigned* bar_st = (volatile LAS unsigned*)(lds0 + MISC_OFF + 1024);
    if (threadIdx.x < 4) bar_st[threadIdx.x] = 0u;
    __syncthreads();
    (void)xcd_barrier_post((unsigned*)(a_param.ws + WS_BAR), bar_st);
    typedef const __attribute__((address_space(4))) Args* kargs_t;
#define PHASE_IDS() int G = G0, bx = bx0; unsigned ldsu_ = (unsigned)(uintptr_t)lds0; asm volatile("" : "+s"(G), "+s"(bx), "+s"(ldsu_)); LAS unsigned char* lds = (LAS unsigned char*)(uintptr_t)ldsu_; const int vcu = (G % 8 == 0) ? (bx % 8) * (G / 8) + bx / 8 : bx; const int NGW = G * NWAVES; (void)NGW; (void)vcu; \
        kargs_t ap_ = (kargs_t)__builtin_amdgcn_kernarg_segment_ptr(); asm volatile("" : "+s"(ap_)); Args a; __builtin_memcpy(&a, ap_, sizeof(Args)); unsigned char* ws = a.ws; (void)ws; int tid; asm volatile("v_mbcnt_lo_u32_b32 %0, -1, 0\n\tv_mbcnt_hi_u32_b32 %0, -1, %0" : "=v"(tid)); tid += wave0 * 64; const int lane = tid & 63; const int wave = __builtin_amdgcn_readfirstlane(tid >> 6); const int gw = vcu * NWAVES + wave; (void)lane; (void)gw; \
        LAS float* scr = (LAS float*)(lds + wave * 16384); (void)scr
    const int lo = a_param.ph_lo, hi = a_param.ph_hi;
    if (lo < 0) grid.sync();
#ifdef DBG_ONLY
#define IN(k) ((((k) - 1) % 10 + 1 == DBG_ONLY || ((k) == 0 && DBG_ONLY == 0)) && lo <= (k) && (k) < hi)
#else
#define IN(k) (lo <= (k) && (k) < hi)
#endif
#define SEAM_BAR() do { kargs_t bp_ = (kargs_t)__builtin_amdgcn_kernarg_segment_ptr(); asm volatile("" : "+s"(bp_)); \
        XcdBarrier xb_; xb_.bar = (unsigned*)(bp_->ws + WS_BAR); xb_.x = xb_xcc_id(); xb_.st = (volatile LAS unsigned*)(lds0 + MISC_OFF + 1024); xcd_barrier(xb_); } while (0)
#define SEAM(k) do { if (IN(k) && IN((k) + 1)) { { kargs_t bp_ = (kargs_t)__builtin_amdgcn_kernarg_segment_ptr(); asm volatile("" : "+s"(bp_)); \
        XcdBarrier xb_; xb_.bar = (unsigned*)(bp_->ws + WS_BAR); xb_.x = xb_xcc_id(); xb_.st = (volatile LAS unsigned*)(lds0 + MISC_OFF + 1024); xcd_barrier(xb_); if ((DUP_MASK) & 0x2000) xcd_barrier(xb_); } } } while (0)

    if (IN(0)) { PHASE_IDS(); for (int rep = 0; rep < NREP(10); ++rep) { p0_small_weights(a, scr, gw, NGW, lane); p0_expert_weights(a, 0, scr, gw, NGW, lane); p0_misc(a, gw, NGW, lane); } }
    SEAM(0);
    for (int l = 0; l < DEPTH; ++l) {
        const int P = 1 + 10 * l;
#if PROJ_MERGED
        if (IN(P + 0)) { PHASE_IDS();
            pg8::ProjSched S; S.XB = (const bf16_t*)(ws + WS_XB); S.PROJ = (const bf16_t*)(ws + WS_PROJ); S.WIN = (const bf16_t*)(ws + WS_WIN) + (size_t)l * NPROJ * DM;
            S.WQUP = (const bf16_t*)(ws + WS_WQUP) + (size_t)l * 768 * 384; S.WKV = (const bf16_t*)(ws + WS_WKV) + (size_t)l * 1024 * 256;
            S.c01 = (unsigned*)(ws + WS_CTL) + 768 + l * 128; S.c12 = S.c01 + 64; S.G = G; S.v = bx;
            pg8::EpiProj E0{(bf16_t*)(ws + WS_PROJ), NPROJ, (float*)(ws + WS_RS), (bf16_t*)(ws + WS_KR), (const float*)(ws + WS_ROPE), (const float*)(ws + WS_ROPE) + SEQ * 16, true};
            pg8::EpiQRope E1{(bf16_t*)(ws + WS_Q), 768, (const float*)(ws + WS_RS), (const float*)(ws + WS_ROPE), (const float*)(ws + WS_ROPE) + SEQ * 16};
            pg8::EpiBf16 E2{(bf16_t*)(ws + WS_KVU), 1024, (const float*)(ws + WS_RS), 12, 2, 1.f / 256.f};
            pg8::gemm_stream(lds, S, E0, E1, E2, tid);
        }
        if (IN(P + 0) && IN(P + 3)) SEAM_BAR();
#else
        if (IN(P + 0)) { PHASE_IDS();
            pg8::DenseSched S; S.A = (const bf16_t*)(ws + WS_XB); S.Bt = (const bf16_t*)(ws + WS_WIN) + (size_t)l * NPROJ * DM; S.lda = DM; S.K = DM; S.so.init(M, NPROJ, G, bx, NREP(0));
            pg8::EpiProj E{(bf16_t*)(ws + WS_PROJ), NPROJ, (float*)(ws + WS_RS), (bf16_t*)(ws + WS_KR), (const float*)(ws + WS_ROPE), (const float*)(ws + WS_ROPE) + SEQ * 16, false};
            pg8::gemm_phase(lds, S, E, tid);
        }
        if (IN(P + 0) && IN(P + 2)) SEAM_BAR();
        if (IN(P + 2)) { PHASE_IDS();
            { pg8::DenseSched S; S.A = (const bf16_t*)(ws + WS_PROJ) + C_QA; S.Bt = (const bf16_t*)(ws + WS_WQUP) + (size_t)l * 768 * 384; S.lda = NPROJ; S.K = 384; S.so.init(M, 768, G, bx - 64, NREP(2));
              pg8::EpiQRope E{(bf16_t*)(ws + WS_Q), 768, (const float*)(ws + WS_RS), (const float*)(ws + WS_ROPE), (const float*)(ws + WS_ROPE) + SEQ * 16};
              pg8::gemm_phase(lds, S, E, tid); }
            { pg8::DenseSched S; S.A = (const bf16_t*)(ws + WS_PROJ) + C_KVA; S.Bt = (const bf16_t*)(ws + WS_WKV) + (size_t)l * 1024 * 256; S.lda = NPROJ; S.K = 256; S.so.init(M, 1024, G, bx, NREP(2));
              pg8::EpiBf16 E{(bf16_t*)(ws + WS_KVU), 1024, (const float*)(ws + WS_RS), 12, 2, 1.f / 256.f};
              pg8::gemm_phase(lds, S, E, tid); }
            for (int uu = vcu; uu < 256 * NREP(11); uu += G) { const int u = uu & 255; const int b = u >> 5, s = u & 31;
                for (int k = 0; k < 2; ++k) idx_unit(lds, a, b, k ? s : 63 - s, tid); }
        }
        SEAM(P + 2);
#endif
        if (IN(P + 3)) { PHASE_IDS();
#ifndef DBG_NOMLA
            for (int rep = 0; rep < NREP(3); ++rep)
            for (int u = vcu; u < 256; u += G) { const int bh = u >> 2, s = u & 3;
                for (int k = 0; k < 2; ++k) attn_unit<false>(lds, a, bh >> 3, bh & 7, k ? s : 7 - s, tid); }
#endif
            for (int uu = vcu; uu < 256 * NREP(4); uu += G) { const int u = uu & 255; const int b = u >> 5, s = u & 31;
                for (int k = 0; k < 2; ++k) attn_unit<true>(lds, a, b, 0, k ? s : 63 - s, tid); }
        }
        if (IN(P + 3) && IN(P + 5)) SEAM_BAR();
        if (IN(P + 5)) { PHASE_IDS();
            pg8::DenseSched S; S.A = (const bf16_t*)(ws + WS_CONCAT); S.Bt = (const bf16_t*)(ws + WS_WO) + (size_t)l * DM * DM; S.lda = DM; S.K = DM; S.so.init(M, DM, G, bx, NREP(5));
            pg8::EpiBf16 E{(bf16_t*)(ws + WS_MIX), DM, nullptr, 0, 0, 0.f};
            pg8::gemm_phase(lds, S, E, tid);
        }
        SEAM(P + 5);
        if (IN(P + 6)) { PHASE_IDS(); p6_ln1_router(lds, a, l, tid, NREP(6)); }
        SEAM(P + 6);
        if (IN(P + 7) || IN(P + 8)) { PHASE_IDS();
            LAS int* tstart = (LAS int*)(lds + MISC_OFF); LAS int* ecnt = tstart + 32;
            if (tid < 16) ecnt[tid] = __hip_atomic_load((const int*)(ws + WS_CTL) + l * 16 + tid, __ATOMIC_RELAXED, __HIP_MEMORY_SCOPE_AGENT);
            __syncthreads();
            if (tid == 0) { int acc = 0;
                for (int e = 0; e < 16; ++e) { tstart[e] = acc; acc += (ecnt[e] + 255) >> 8; }
                tstart[16] = acc; }
            __syncthreads();
#if MOE_MERGED
            { pg8::Moe12Sched S; S.X1B = (const bf16_t*)(ws + WS_X1B); S.H = (const bf16_t*)(ws + WS_H); S.WGU = (const bf16_t*)(ws + WS_WGU); S.WD = (const bf16_t*)(ws + WS_WD);
              S.elist = (const int*)(ws + WS_ELIST) + (size_t)l * 16 * 16384; S.tstart = tstart; S.ecnt = ecnt; S.ready = (unsigned*)(ws + WS_CTL) + 256 + l * 256; S.G = G; S.v = vcu;
              pg8::EpiMoe1 E1{(bf16_t*)(ws + WS_H), (const float*)(ws + WS_GATE)}; pg8::EpiMoe2 E2{(bf16_t*)(ws + WS_Y)};
              pg8::gemm_stream(lds, S, E1, E2, E2, tid); }
#else
            if (IN(P + 7)) {
                pg8::MoeSched S; S.A = (const bf16_t*)(ws + WS_X1B); S.Bt = (const bf16_t*)(ws + WS_WGU); S.lda = DM; S.K = DM; S.b_estride = (size_t)DM * DM * 2; S.elist = (const int*)(ws + WS_ELIST) + (size_t)l * 16 * 16384; S.rsh = 1;
                S.tstart = tstart; S.ecnt = ecnt; S.G = G; S.v = vcu; S.nrep = NREP(7);
                pg8::EpiMoe1 E{(bf16_t*)(ws + WS_H), (const float*)(ws + WS_GATE)};
                pg8::gemm_phase(lds, S, E, tid);
            }
            SEAM(P + 7);
            if (IN(P + 8)) {
                pg8::MoeSched S; S.A = (const bf16_t*)(ws + WS_H); S.Bt = (const bf16_t*)(ws + WS_WD); S.lda = DFF; S.K = DFF; S.b_estride = (size_t)DM * DFF * 2; S.elist = (const int*)(ws + WS_ELIST) + (size_t)l * 16 * 16384; S.rsh = 0;
                S.tstart = tstart; S.ecnt = ecnt; S.G = G; S.v = vcu; S.nrep = NREP(8);
                pg8::EpiMoe2 E{(bf16_t*)(ws + WS_Y)};
                pg8::gemm_phase(lds, S, E, tid);
            }
#endif
        } else { SEAM(P + 7); }
        SEAM(P + 8);
        if (IN(P + 9)) { PHASE_IDS(); for (int rep = 0; rep < NREP(9); ++rep) p9_ln2(a, l, gw, NGW, lane); if (l + 1 < DEPTH) for (int rep = 0; rep < NREP(12); ++rep) p0_expert_weights(a, l + 1, scr, gw, NGW, lane); }
        SEAM(P + 9);
    }
#undef IN
#undef SEAM
}

#ifndef MK_PER_PHASE
#define MK_PER_PHASE 0
#endif
extern "C" void kernel_launch(void* const* d_in, const int* in_sizes, int n_in, void* d_out, int out_size, void* d_ws, size_t ws_size, hipStream_t stream) {
    static int grid_blocks = 0;
    if (grid_blocks == 0) {
        if (n_in != 17 || in_sizes[0] != M * DM || out_size != M * DM || ws_size < WS_END) { fprintf(stderr, "kernel_launch: unexpected shapes / workspace (n_in %d, in0 %d, out %d, ws %zu); nothing launched\n", n_in, n_in > 0 ? in_sizes[0] : -1, out_size, ws_size); grid_blocks = -1; return; }
        int dev = 0, cus = 0, per_cu = 0;
        (void)hipGetDevice(&dev);
        (void)hipDeviceGetAttribute(&cus, hipDeviceAttributeMultiprocessorCount, dev);
        (void)hipFuncSetAttribute((const void*)mega_fwd, hipFuncAttributeMaxDynamicSharedMemorySize, LDS_BYTES);
        (void)hipOccupancyMaxActiveBlocksPerMultiprocessor(&per_cu, (const void*)mega_fwd, NTHREADS, LDS_BYTES);
        fprintf(stderr, "kernel_launch: cus %d per_cu %d ws_size %zu\n", cus, per_cu, ws_size);
        if (per_cu < 1 || cus < 1) { grid_blocks = -1; return; }
        grid_blocks = cus > 256 ? 256 : cus;
    }
    if (grid_blocks < 0) return;
    (void)hipMemsetAsync((unsigned char*)d_ws + WS_BAR, 0, XCD_BAR_WORDS * 4, stream);
    Args a{};
    a.x = (const float*)d_in[0]; a.w_in = (const float*)d_in[1]; a.q_norm_g = (const float*)d_in[2]; a.w_q_up = (const float*)d_in[3]; a.kv_norm_g = (const float*)d_in[4];
    a.w_uk = (const float*)d_in[5]; a.w_uv = (const float*)d_in[6]; a.w_o = (const float*)d_in[7]; a.ln1_g = (const float*)d_in[8]; a.ln1_b = (const float*)d_in[9];
    a.router_w = (const float*)d_in[10]; a.router_bias = (const float*)d_in[11]; a.w_gate = (const float*)d_in[12]; a.w_up = (const float*)d_in[13]; a.w_down = (const float*)d_in[14];
    a.ln2_g = (const float*)d_in[15]; a.ln2_b = (const float*)d_in[16];
    a.out = (float*)d_out; a.ws = (unsigned char*)d_ws;
#if MK_PER_PHASE
    for (int p = 0; p < N_PHASES; ++p) { a.ph_lo = p; a.ph_hi = p + 1; void* args[] = {&a};
        hipError_t e = hipLaunchCooperativeKernel((const void*)mega_fwd, dim3(grid_blocks), dim3(NTHREADS), args, LDS_BYTES, stream);
        if (e != hipSuccess) { fprintf(stderr, "launch %d failed: %s\n", p, hipGetErrorString(e)); break; } }
#else
    a.ph_lo = 0; a.ph_hi = N_PHASES; a.dup_mask = DUP_MASK; void* args[] = {&a};
    hipError_t e = hipLaunchCooperativeKernel((const void*)mega_fwd, dim3(grid_blocks), dim3(NTHREADS), args, LDS_BYTES, stream);
    if (e != hipSuccess) fprintf(stderr, "cooperative launch failed: %s (grid %d)\n", hipGetErrorString(e), grid_blocks);
#endif
}
```
